# Optimizing an MI355X kernel written in HIP

```python
import math
import jax, jax.numpy as jnp
from jax import lax
import numpy as np

D_MODEL = 1024
BATCH = 2
SEQ = 8192
DEPTH = 2

HEAD_DIM = 64
ROPE_DIM = HEAD_DIM // 4
ROPE_THETA = 500000.0
Q_BLOCK = 128
NSA_HEADS = (D_MODEL // 2) // HEAD_DIM
NSA_KV_GROUPS = 2
CMP_BLOCK = 32
CMP_STRIDE = 16
CMP_HIDDEN = 4 * HEAD_DIM
SLC_BLOCK = 64
N_SELECT = 16
WINDOW = 512
SB_HEADS = (D_MODEL // 2) // HEAD_DIM
DIFF_HEADS = D_MODEL // (2 * HEAD_DIM)
D_FF = ((8 * D_MODEL // 3 + 255) // 256) * 256
CONV_WIDTH = 3
N_EVEN = (DEPTH + 1) // 2
N_ODD = DEPTH // 2
NSA_Q_W = NSA_HEADS * HEAD_DIM
NSA_KV_W = NSA_KV_GROUPS * HEAD_DIM
SB_W = SB_HEADS * HEAD_DIM
HYB_IN_SIZES = (NSA_Q_W,) + (NSA_KV_W,) * 6 + (3 * NSA_HEADS,) + (SB_W,) * 3
HYB_IN_W = sum(HYB_IN_SIZES)
HYB_OUT_W = NSA_Q_W + SB_W
DIFF_W = 2 * DIFF_HEADS * HEAD_DIM
RMS_EPS = 1e-6
NEG_INF = -1e30
FORCE = 1e9

kernel_name = 'hybrid_nsa_stickbreak_diffattn_convffn'


def rms_norm(x, g):
    xf = x.astype(jnp.float32)
    y = xf * lax.rsqrt(jnp.mean(xf * xf, axis=-1, keepdims=True) + RMS_EPS) * g.astype(jnp.float32)
    return y.astype(x.dtype)


def modulate(h, shift, scale):
    return h * (1.0 + scale[:, None, :]) + shift[:, None, :]


def rope_partial(x, pos):
    inv = ROPE_THETA ** (-jnp.arange(0, ROPE_DIM, 2, dtype=jnp.float32) / ROPE_DIM)
    ang = pos.astype(jnp.float32)[..., None] * inv
    cos = jnp.cos(ang)[:, :, None, :]
    sin = jnp.sin(ang)[:, :, None, :]
    half = ROPE_DIM // 2
    xf = x.astype(jnp.float32)
    x1, x2 = xf[..., :half], xf[..., half:ROPE_DIM]
    out = jnp.concatenate([x1 * cos - x2 * sin, x2 * cos + x1 * sin, xf[..., ROPE_DIM:]], axis=-1)
    return out.astype(x.dtype)


def masked_softmax(s, mask):
    p = jax.nn.softmax(jnp.where(mask, s, NEG_INF), axis=-1)
    return jnp.where(mask, p, 0.0)


def split_cols(a, sizes):
    out, start = [], 0
    for s in sizes:
        out.append(a[..., start:start + s])
        start += s
    return out


def compress(kv, pos_emb, w1, w2):
    B, T, G, dk = kv.shape
    nc = (T - CMP_BLOCK) // CMP_STRIDE + 1
    idx = (jnp.arange(nc) * CMP_STRIDE)[:, None] + jnp.arange(CMP_BLOCK)[None, :]
    blk = kv[:, idx] + pos_emb[None, None, :, None, :]
    blk = jnp.moveaxis(blk, 3, 2).reshape(B, nc, G, CMP_BLOCK * dk)
    return jax.nn.silu(blk @ w1) @ w2


def nsa_attention(q, k_c, v_c, k_s, v_s, k_w, v_w, gates):
    B, T, H, dk = q.shape
    G = NSA_KV_GROUPS
    R = H // G
    nc = k_c.shape[1]
    ns = T // SLC_BLOCK
    n_sel = min(N_SELECT, ns)
    scale = dk ** -0.5
    qg = q.reshape(B, T, G, R, dk)
    gg = gates.reshape(B, T, G, R, 3)
    cmp_start = jnp.arange(nc) * CMP_STRIDE
    cmp_end = cmp_start + CMP_BLOCK - 1
    slc_start = jnp.arange(ns) * SLC_BLOCK
    overlap = ((cmp_start[:, None] < slc_start[None, :] + SLC_BLOCK)
               & (cmp_start[:, None] + CMP_BLOCK > slc_start[None, :])).astype(jnp.float32)
    ks_blocks = k_s.reshape(B, ns, SLC_BLOCK, G, dk).transpose(0, 3, 1, 2, 4)
    vs_blocks = v_s.reshape(B, ns, SLC_BLOCK, G, dk).transpose(0, 3, 1, 2, 4)
    kw_pad = jnp.pad(k_w, ((0, 0), (WINDOW, 0), (0, 0), (0, 0)))
    vw_pad = jnp.pad(v_w, ((0, 0), (WINDOW, 0), (0, 0), (0, 0)))
    b_ix = jnp.arange(B)[:, None, None, None]
    g_ix = jnp.arange(G)[None, :, None, None]
    blk_ids = jnp.arange(ns)

    def block(qb):
        q0 = qb * Q_BLOCK
        t = q0 + jnp.arange(Q_BLOCK)
        qc = lax.dynamic_slice_in_dim(qg, q0, Q_BLOCK, axis=1)
        s_c = jnp.einsum('bqgrd,bcgd->bgrqc', qc, k_c).astype(jnp.float32) * scale
        p_c = masked_softmax(s_c, cmp_end[None, :] <= t[:, None])
        o_c = jnp.einsum('bgrqc,bcgd->bqgrd', p_c.astype(v_c.dtype), v_c)
        imp = jnp.einsum('bgrqc,cn->bgqn', p_c, overlap)
        cur = t // SLC_BLOCK
        forced = (blk_ids[None, :] == 0) | (blk_ids[None, :] == cur[:, None]) | (blk_ids[None, :] == cur[:, None] - 1)
        valid = blk_ids[None, :] <= cur[:, None]
        score = jnp.where(forced, FORCE, jnp.where(valid, imp, -FORCE))
        _, sel = lax.top_k(score, n_sel)
        k_sel = ks_blocks[b_ix, g_ix, sel]
        v_sel = vs_blocks[b_ix, g_ix, sel]
        tok = sel[..., None] * SLC_BLOCK + jnp.arange(SLC_BLOCK)
        m_s = (tok <= t[None, None, :, None, None]).reshape(B, G, 1, Q_BLOCK, n_sel * SLC_BLOCK)
        s_s = jnp.einsum('bqgrd,bgqnkd->bgrqnk', qc, k_sel).astype(jnp.float32) * scale
        p_s = masked_softmax(s_s.reshape(B, G, R, Q_BLOCK, n_sel * SLC_BLOCK), m_s)
        p_s = p_s.reshape(B, G, R, Q_BLOCK, n_sel, SLC_BLOCK)
        o_s = jnp.einsum('bgrqnk,bgqnkd->bqgrd', p_s.astype(v_sel.dtype), v_sel)
        kw = lax.dynamic_slice_in_dim(kw_pad, q0, Q_BLOCK + WINDOW, axis=1)
        vw = lax.dynamic_slice_in_dim(vw_pad, q0, Q_BLOCK + WINDOW, axis=1)
        kp = q0 - WINDOW + jnp.arange(Q_BLOCK + WINDOW)
        m_w = (kp[None, :] <= t[:, None]) & (kp[None, :] > t[:, None] - WINDOW) & (kp[None, :] >= 0)
        s_w = jnp.einsum('bqgrd,bkgd->bgrqk', qc, kw).astype(jnp.float32) * scale
        p_w = masked_softmax(s_w, m_w)
        o_w = jnp.einsum('bgrqk,bkgd->bqgrd', p_w.astype(vw.dtype), vw)
        g = jax.nn.sigmoid(lax.dynamic_slice_in_dim(gg, q0, Q_BLOCK, axis=1).astype(jnp.float32))
        o = g[..., 0:1] * o_c + g[..., 1:2] * o_s + g[..., 2:3] * o_w
        return o.astype(q.dtype).reshape(B, Q_BLOCK, H * dk)

    out = lax.map(block, jnp.arange(T // Q_BLOCK))
    return jnp.moveaxis(out, 0, 1).reshape(B, T, H * dk)


def stick_breaking_attention(q, k, v):
    B, T, H, dk = q.shape
    scale = dk ** -0.5
    key_pos = jnp.arange(T)

    def block(qb):
        q0 = qb * Q_BLOCK
        t = q0 + jnp.arange(Q_BLOCK)
        qc = lax.dynamic_slice_in_dim(q, q0, Q_BLOCK, axis=1)
        z = jnp.einsum('bqhd,bkhd->bhqk', qc, k).astype(jnp.float32) * scale
        m = key_pos[None, :] < t[:, None]
        log_keep = jnp.where(m, jax.nn.log_sigmoid(-z), 0.0)
        log_later = lax.cumsum(log_keep, axis=3, reverse=True) - log_keep
        a = jnp.where(m, jnp.exp(jax.nn.log_sigmoid(z) + log_later), 0.0)
        return jnp.einsum('bhqk,bkhd->bqhd', a.astype(v.dtype), v)

    out = lax.map(block, jnp.arange(T // Q_BLOCK))
    return jnp.moveaxis(out, 0, 1).reshape(B, T, H * dk)


def diff_attention(q1, q2, k1, k2, v, lam):
    B, T, H, dk = q1.shape
    scale = dk ** -0.5
    key_pos = jnp.arange(T)

    def block(qb):
        q0 = qb * Q_BLOCK
        t = q0 + jnp.arange(Q_BLOCK)
        m = key_pos[None, :] <= t[:, None]
        q1c = lax.dynamic_slice_in_dim(q1, q0, Q_BLOCK, axis=1)
        q2c = lax.dynamic_slice_in_dim(q2, q0, Q_BLOCK, axis=1)
        p1 = masked_softmax(jnp.einsum('bqhd,bkhd->bhqk', q1c, k1).astype(jnp.float32) * scale, m)
        p2 = masked_softmax(jnp.einsum('bqhd,bkhd->bhqk', q2c, k2).astype(jnp.float32) * scale, m)
        w = p1 - lam * p2
        return jnp.einsum('bhqk,bkhe->bqhe', w.astype(v.dtype), v)

    out = lax.map(block, jnp.arange(T // Q_BLOCK))
    return jnp.moveaxis(out, 0, 1).reshape(B, T, H, 2 * dk)


def hybrid_nsa_sb_mixer(h, positions, w_in, pos_k, pos_v, ck_w1, ck_w2, cv_w1, cv_w2, w_out):
    B, T, _ = h.shape
    G = NSA_KV_GROUPS
    (q_n, kc, vc, ks, vs, kw, vw, gl, q_s, k_s, v_s) = split_cols(h @ w_in, HYB_IN_SIZES)
    hd = lambda a, n: a.reshape(B, T, n, HEAD_DIM)
    q_n = rope_partial(hd(q_n, NSA_HEADS), positions)
    ks = rope_partial(hd(ks, G), positions)
    kw = rope_partial(hd(kw, G), positions)
    k_cmp = compress(hd(kc, G), pos_k, ck_w1, ck_w2)
    v_cmp = compress(hd(vc, G), pos_v, cv_w1, cv_w2)
    nc = k_cmp.shape[1]
    cmp_end = jnp.arange(nc) * CMP_STRIDE + CMP_BLOCK - 1
    k_cmp = rope_partial(k_cmp, positions[:, cmp_end])
    o_nsa = nsa_attention(q_n, k_cmp, v_cmp, ks, hd(vs, G), kw, hd(vw, G),
                          gl.reshape(B, T, NSA_HEADS, 3))
    o_sb = stick_breaking_attention(hd(q_s, SB_HEADS), hd(k_s, SB_HEADS), hd(v_s, SB_HEADS))
    return jnp.concatenate([o_nsa, o_sb], axis=-1) @ w_out


def diff_mixer(h, positions, w_qkv, lq1, lk1, lq2, lk2, subln, w_out, layer_idx):
    B, T, _ = h.shape
    H = DIFF_HEADS
    q, k, v = jnp.split(h @ w_qkv, 3, axis=-1)
    q = rope_partial(q.reshape(B, T, 2 * H, HEAD_DIM), positions).reshape(B, T, H, 2, HEAD_DIM)
    k = rope_partial(k.reshape(B, T, 2 * H, HEAD_DIM), positions).reshape(B, T, H, 2, HEAD_DIM)
    v = v.reshape(B, T, H, 2 * HEAD_DIM)
    lambda_init = 0.8 - 0.6 * math.exp(-0.3 * layer_idx)
    lam = (jnp.exp(jnp.sum(lq1.astype(jnp.float32) * lk1.astype(jnp.float32)))
           - jnp.exp(jnp.sum(lq2.astype(jnp.float32) * lk2.astype(jnp.float32))) + lambda_init)
    o = diff_attention(q[..., 0, :], q[..., 1, :], k[..., 0, :], k[..., 1, :], v, lam)
    o = rms_norm(o, subln) * (1.0 - lambda_init)
    return o.reshape(B, T, DIFF_W) @ w_out


def conv_ffn(h, w_gate, w_up, conv_w, conv_b, w_down):
    g = h @ w_gate
    g = lax.conv_general_dilated(g, conv_w[:, None, :].astype(g.dtype), window_strides=(1,),
                                 padding=[(CONV_WIDTH - 1, 0)],
                                 dimension_numbers=('NWC', 'WIO', 'NWC'),
                                 feature_group_count=g.shape[-1]) + conv_b
    return (jax.nn.silu(g) * (h @ w_up)) @ w_down


def setup_inputs(seed: int = 0) -> dict:
    key = jax.random.key(seed)
    ks = iter(jax.random.split(key, 32))
    D = D_MODEL

    def nrm(shape, scale):
        return scale * jax.random.normal(next(ks), shape, jnp.float32)

    def gain(shape):
        return 1.0 + 0.05 * jax.random.normal(next(ks), shape, jnp.float32)

    x = nrm((BATCH, SEQ, D), 1.0)
    c = nrm((BATCH, D), 1.0)
    positions = (jax.random.randint(next(ks), (BATCH, 1), 0, 1024, jnp.int32)
                 + jnp.arange(SEQ, dtype=jnp.int32)[None, :])
    return {
        'x': x, 'c': c, 'positions': positions,
        'mod_w': nrm((DEPTH, D, 6 * D), D ** -0.5),
        'mod_b': nrm((DEPTH, 6 * D), 0.02),
        'norm_mix': gain((DEPTH, D)),
        'norm_ffn': gain((DEPTH, D)),
        'ffn_w_gate': nrm((DEPTH, D, D_FF), D ** -0.5),
        'ffn_w_up': nrm((DEPTH, D, D_FF), D ** -0.5),
        'ffn_conv_w': nrm((DEPTH, CONV_WIDTH, D_FF), CONV_WIDTH ** -0.5),
        'ffn_conv_b': nrm((DEPTH, D_FF), 0.02),
        'ffn_w_down': nrm((DEPTH, D_FF, D), D_FF ** -0.5),
        'hyb_w_in': nrm((N_EVEN, D, HYB_IN_W), D ** -0.5),
        'nsa_pos_k': nrm((N_EVEN, CMP_BLOCK, HEAD_DIM), 0.1),
        'nsa_pos_v': nrm((N_EVEN, CMP_BLOCK, HEAD_DIM), 0.1),
        'nsa_ck_w1': nrm((N_EVEN, CMP_BLOCK * HEAD_DIM, CMP_HIDDEN), (CMP_BLOCK * HEAD_DIM) ** -0.5),
        'nsa_ck_w2': nrm((N_EVEN, CMP_HIDDEN, HEAD_DIM), CMP_HIDDEN ** -0.5),
        'nsa_cv_w1': nrm((N_EVEN, CMP_BLOCK * HEAD_DIM, CMP_HIDDEN), (CMP_BLOCK * HEAD_DIM) ** -0.5),
        'nsa_cv_w2': nrm((N_EVEN, CMP_HIDDEN, HEAD_DIM), CMP_HIDDEN ** -0.5),
        'hyb_w_out': nrm((N_EVEN, HYB_OUT_W, D), HYB_OUT_W ** -0.5),
        'diff_w_qkv': nrm((N_ODD, D, 3 * DIFF_W), D ** -0.5),
        'diff_lq1': nrm((N_ODD, HEAD_DIM), 0.1),
        'diff_lk1': nrm((N_ODD, HEAD_DIM), 0.1),
        'diff_lq2': nrm((N_ODD, HEAD_DIM), 0.1),
        'diff_lk2': nrm((N_ODD, HEAD_DIM), 0.1),
        'diff_subln': gain((N_ODD, 2 * HEAD_DIM)),
        'diff_w_out': nrm((N_ODD, DIFF_W, D), DIFF_W ** -0.5),
        'norm_f': gain((D,)),
    }


def reference(x, c, positions, mod_w, mod_b, norm_mix, norm_ffn, ffn_w_gate, ffn_w_up,
              ffn_conv_w, ffn_conv_b, ffn_w_down, hyb_w_in, nsa_pos_k, nsa_pos_v,
              nsa_ck_w1, nsa_ck_w2, nsa_cv_w1, nsa_cv_w2, hyb_w_out, diff_w_qkv,
              diff_lq1, diff_lk1, diff_lq2, diff_lk2, diff_subln, diff_w_out, norm_f):
    cond = jax.nn.silu(c)
    for i in range(DEPTH):
        mod = cond @ mod_w[i] + mod_b[i]
        sh_m, sc_m, g_m, sh_f, sc_f, g_f = jnp.split(mod, 6, axis=-1)
        h = modulate(rms_norm(x, norm_mix[i]), sh_m, sc_m)
        if i % 2 == 0:
            j = i // 2
            y = hybrid_nsa_sb_mixer(h, positions, hyb_w_in[j], nsa_pos_k[j], nsa_pos_v[j],
                                    nsa_ck_w1[j], nsa_ck_w2[j], nsa_cv_w1[j], nsa_cv_w2[j],
                                    hyb_w_out[j])
        else:
            j = i // 2
            y = diff_mixer(h, positions, diff_w_qkv[j], diff_lq1[j], diff_lk1[j], diff_lq2[j],
                           diff_lk2[j], diff_subln[j], diff_w_out[j], i)
        x = x + g_m[:, None, :] * y
        h = modulate(rms_norm(x, norm_ffn[i]), sh_f, sc_f)
        x = x + g_f[:, None, :] * conv_ffn(h, ffn_w_gate[i], ffn_w_up[i], ffn_conv_w[i],
                                           ffn_conv_b[i], ffn_w_down[i])
    return rms_norm(x, norm_f)
```

```cpp
#include <hip/hip_runtime.h>
#include <hip/hip_bf16.h>
#include <cstdio>
#include <cstdint>
#include <cmath>
namespace pg8 {
#define PG8_LAS __attribute__((address_space(3)))
typedef unsigned short bf16_t;
typedef short bf16x8 __attribute__((ext_vector_type(8)));
typedef float f32x4 __attribute__((ext_vector_type(4)));
typedef unsigned u32x4 __attribute__((ext_vector_type(4)));
constexpr int BM = 256, BK = 64, HALF = 128, HTB = HALF * BK * 2  , STAGE_BYTES = 8 * HTB, NXCD = 8, WGM = 8;

__host__ __device__ __forceinline__ int lds_byte(int r, int c) { const int st = (r >> 4) * 2 + (c >> 5), rr = r & 15, cc = c & 31, ob = rr * 64 + cc * 2; return st * 1024 + (ob ^ (((ob >> 9) & 1) << 5)); }
__host__ __device__ __forceinline__ void stage_rc(int b, int& R, int& C) { const int st = b / 1024, sb = b % 1024, swz = sb ^ (((sb >> 9) & 1) << 5); R = (st >> 1) * 16 + swz / 64; C = (st & 1) * 32 + (swz % 64) / 2; }
__host__ __device__ __forceinline__ int perm32(int rho) { const int n = rho >> 4, i = rho & 15; return 8 * (i >> 2) + 4 * n + (i & 3); }

struct Unit { int pm, pn; };
struct Gemm { const bf16_t* A; const bf16_t* Bt; int M, N, K; };

struct StaticOrder {
    int nM, nN, nwg, G, c;
    __host__ __device__ void init(int M, int N, int G_, int c_) { nM = M / BM; nN = N / BM; nwg = nM * nN; G = G_; c = c_; }
    __host__ __device__ bool next(int i, Unit& u) const {
        const long L = (long)i * G + c; if (L >= nwg) return false;
        int wgid = (int)L; { const int q = nwg / NXCD, r = nwg % NXCD, xcd = wgid % NXCD, off = wgid / NXCD; wgid = (xcd < r ? xcd * (q + 1) : r * (q + 1) + (xcd - r) * q) + off; }
        const int nig = WGM * nN, gid = wgid / nig, fm = gid * WGM, gsz = (nM - fm) < WGM ? (nM - fm) : WGM;
        u.pm = fm + ((wgid % nig) % gsz); u.pn = (wgid % nig) / gsz; return true;
    }
    __device__ __forceinline__ void a_ready(const Unit&) const {}
    __device__ __forceinline__ void done(const Unit&) const {}
};

__device__ __forceinline__ unsigned cvt_pk_bf16(float lo, float hi) { unsigned r; asm volatile("v_cvt_pk_bf16_f32 %0, %1, %2" : "=v"(r) : "v"(lo), "v"(hi)); return r; }
typedef float f32x2 __attribute__((ext_vector_type(2)));
__device__ __forceinline__ float bflo(unsigned w) { return __uint_as_float(w << 16); }
__device__ __forceinline__ float bfhi(unsigned w) { return __uint_as_float(w & 0xffff0000u); }
struct EpiProj {
    static constexpr bool PERM = true, AFTER_DRAIN = false;
    bf16_t* O; int ldc; const float* cs; unsigned ropemask, scalemask; float qscale;
    __device__ __forceinline__ void operator()(const f32x4 (&acc)[2][2][4][2], const Unit& u, int wr, int wc, int fr, int fq) const {
        const int row0 = u.pm * BM + wr * 64 + fr, col0 = u.pn * BM + wc * 32 + 8 * fq;
#pragma unroll
        for (int bj = 0; bj < 2; ++bj) {
            const unsigned bit = 1u << (2 * u.pn + bj);
            const float sc = (scalemask & bit) ? qscale : 1.f;
            const bool rope = ((ropemask & bit) != 0u) && ((wc & 1) == 0);
#pragma unroll
            for (int ai = 0; ai < 2; ++ai)
#pragma unroll
                for (int m = 0; m < 4; ++m) {
                    const int row = row0 + ai * HALF + m * 16;
                    f32x4 v0 = acc[ai][bj][m][0] * sc, v1 = acc[ai][bj][m][1] * sc;
                    if (rope) {
                        const float* t = cs + (size_t)row * 16;
                        const f32x4 c0 = *(const f32x4*)t, c1 = *(const f32x4*)(t + 4), s0 = *(const f32x4*)(t + 8), s1 = *(const f32x4*)(t + 12);
                        f32x4 p0, p1;
#pragma unroll
                        for (int j = 0; j < 4; ++j) { p0[j] = __shfl_xor(v0[j], 16); p1[j] = __shfl_xor(v1[j], 16); }
                        if (fq < 2) { const float sg = (fq == 0) ? -1.f : 1.f; v0 = v0 * c0 + p0 * s0 * sg; v1 = v1 * c1 + p1 * s1 * sg; }
                    }
                    u32x4 w; w.x = cvt_pk_bf16(v0[0], v0[1]); w.y = cvt_pk_bf16(v0[2], v0[3]); w.z = cvt_pk_bf16(v1[0], v1[1]); w.w = cvt_pk_bf16(v1[2], v1[3]);
                    *(u32x4*)(O + (size_t)row * ldc + col0 + bj * HALF) = w;
                }
        }
    }
};
struct EpiAct {
    static constexpr bool PERM = true, AFTER_DRAIN = false;
    bf16_t* O; const bf16_t* G; int ldc; const float* cw; const float* cb;
    __device__ __forceinline__ void operator()(const f32x4 (&acc)[2][2][4][2], const Unit& u, int wr, int wc, int fr, int fq) const {
        const int row0 = u.pm * BM + wr * 64 + fr, col0 = u.pn * BM + wc * 32 + 8 * fq;
#pragma unroll
        for (int bj = 0; bj < 2; ++bj) {
            const int col = col0 + bj * HALF;
            f32x4 k0[2], k1[2], k2[2], bb[2];
#pragma unroll
            for (int n = 0; n < 2; ++n) { k0[n] = *(const f32x4*)(cw + col + 4 * n); k1[n] = *(const f32x4*)(cw + ldc + col + 4 * n); k2[n] = *(const f32x4*)(cw + 2 * ldc + col + 4 * n); bb[n] = *(const f32x4*)(cb + col + 4 * n); }
#pragma unroll
            for (int ai = 0; ai < 2; ++ai)
#pragma unroll
                for (int m = 0; m < 4; ++m) {
                    const int row = row0 + ai * HALF + m * 16, t = row & 8191;
                    const bf16_t* gp = G + (size_t)row * ldc + col;
                    const u32x4 g2 = *(const u32x4*)gp;
                    u32x4 g1 = (u32x4){0u, 0u, 0u, 0u}, g0 = (u32x4){0u, 0u, 0u, 0u};
                    if (t >= 1) g1 = *(const u32x4*)(gp - ldc);
                    if (t >= 2) g0 = *(const u32x4*)(gp - 2 * ldc);
                    f32x4 r[2];
#pragma unroll
                    for (int n = 0; n < 2; ++n) {
                        const unsigned a0 = n ? g0.z : g0.x, a1 = n ? g0.w : g0.y, b0 = n ? g1.z : g1.x, b1 = n ? g1.w : g1.y, c0 = n ? g2.z : g2.x, c1 = n ? g2.w : g2.y;
                        f32x4 x0 = (f32x4){bflo(a0), bfhi(a0), bflo(a1), bfhi(a1)}, x1 = (f32x4){bflo(b0), bfhi(b0), bflo(b1), bfhi(b1)}, x2 = (f32x4){bflo(c0), bfhi(c0), bflo(c1), bfhi(c1)};
                        f32x4 cv = k0[n] * x0 + k1[n] * x1 + k2[n] * x2 + bb[n];
#pragma unroll
                        for (int j = 0; j < 4; ++j) { const float e = __builtin_amdgcn_exp2f(-1.4426950408889634f * cv[j]); cv[j] = cv[j] * __builtin_amdgcn_rcpf(1.f + e); }
                        r[n] = cv * acc[ai][bj][m][n];
                    }
                    u32x4 w; w.x = cvt_pk_bf16(r[0][0], r[0][1]); w.y = cvt_pk_bf16(r[0][2], r[0][3]); w.z = cvt_pk_bf16(r[1][0], r[1][1]); w.w = cvt_pk_bf16(r[1][2], r[1][3]);
                    *(u32x4*)(O + (size_t)row * ldc + col) = w;
                }
        }
    }
};
struct EpiRes {
    static constexpr bool PERM = false, AFTER_DRAIN = false;
    const float* base; float* out; int ldc; const float* gate; int gstride;
    __device__ __forceinline__ void operator()(const f32x4 (&acc)[2][2][4][2], const Unit& u, int wr, int wc, int fr, int fq) const {
        const int col0 = u.pn * BM + wc * 32 + 4 * fq; const float* gp = gate + (size_t)((u.pm * BM) >> 13) * gstride;
        f32x4 gv[2][2];
#pragma unroll
        for (int bj = 0; bj < 2; ++bj)
#pragma unroll
            for (int n = 0; n < 2; ++n) gv[bj][n] = *(const f32x4*)(gp + col0 + bj * HALF + n * 16);
#pragma unroll
        for (int ai = 0; ai < 2; ++ai)
#pragma unroll
            for (int m = 0; m < 4; ++m) { const size_t off = (size_t)(u.pm * BM + ai * HALF + wr * 64 + m * 16 + fr) * ldc + col0;
#pragma unroll
                for (int bj = 0; bj < 2; ++bj)
#pragma unroll
                    for (int n = 0; n < 2; ++n) { const f32x4 bs = *(const f32x4*)(base + off + bj * HALF + n * 16); *(f32x4*)(out + off + bj * HALF + n * 16) = bs + gv[bj][n] * acc[ai][bj][m][n]; }
                if (m & 1) asm volatile("" ::: "memory"); }
    }
};
template <class Epi, class Sched, bool ALIGN_EPI = false, bool SP2 = false>
__device__ __forceinline__ void gemm_phase(PG8_LAS unsigned char* lds, const Gemm g, const Sched& S, const Epi& E) {
    const int tid = threadIdx.x, wid = __builtin_amdgcn_readfirstlane(tid >> 6), lane = tid & 63, wr = wid >> 2, wc = wid & 3, fr = lane & 15, fq = lane >> 4;
    const int K = g.K, nt = K / BK;
    unsigned voffA[2], voffB[2];
#pragma unroll
    for (int i = 0; i < 2; ++i) { int R, C; stage_rc(tid * 16 + i * 8192, R, C); const int Rb = Epi::PERM ? ((R & ~31) + perm32(R & 31)) : R;
        voffA[i] = (unsigned)(R * K + C) * 2u; voffB[i] = (unsigned)(Rb * K + C) * 2u; }
    const size_t kstep = (size_t)(BK * 2);
    const size_t hstep = (size_t)HALF * K * 2;
    const size_t tstep = 2 * hstep;
    const unsigned ldsw = (unsigned)wid * 1024u;
    const int aoff = lds_byte(wr * 64 + fr, fq * 8), boff = lds_byte(wc * 32 + fr, fq * 8);
#define PG8_SA(b, h) (((b) * 2 + (h)) * HTB)
#define PG8_SB(b, h) ((4 + (b) * 2 + (h)) * HTB)
#define PG8_STAGE(bufoff, gbase, voff) do { _Pragma("unroll") for (int _i = 0; _i < 2; ++_i) \
        __builtin_amdgcn_global_load_lds((const unsigned*)((const char*)(gbase) + (voff)[_i]), (PG8_LAS unsigned*)(lds + (bufoff) + ldsw + _i * 8192), 16, 0, 0); } while (0)
#define PG8_LDA(dst, b, h) do { _Pragma("unroll") for (int m = 0; m < 4; ++m) _Pragma("unroll") for (int k = 0; k < 2; ++k) dst[m][k] = *(const PG8_LAS bf16x8*)(lds + PG8_SA(b, h) + aoff + m * 2048 + k * 1024); } while (0)
#define PG8_LDB(dst, b, h) do { _Pragma("unroll") for (int n = 0; n < 2; ++n) _Pragma("unroll") for (int k = 0; k < 2; ++k) dst[n][k] = *(const PG8_LAS bf16x8*)(lds + PG8_SB(b, h) + boff + n * 2048 + k * 1024); } while (0)
#define PG8_MMA(ai, bj, At, Bt) do { __builtin_amdgcn_s_setprio(1); _Pragma("unroll") for (int m = 0; m < 4; ++m) _Pragma("unroll") for (int n = 0; n < 2; ++n) _Pragma("unroll") for (int k = 0; k < 2; ++k) \
        acc[ai][bj][m][n] = __builtin_amdgcn_mfma_f32_16x16x32_bf16(Bt[n][k], At[m][k], acc[ai][bj][m][n], 0, 0, 0); __builtin_amdgcn_s_setprio(0); } while (0)
#define PG8_WAIT_V(n) asm volatile("s_waitcnt vmcnt(" #n ")" ::: "memory")
#define PG8_WAIT_L(n) asm volatile("s_waitcnt lgkmcnt(" #n ")" ::: "memory")
#define PG8_BAR __builtin_amdgcn_s_barrier()
#define PG8_SCHED __builtin_amdgcn_sched_barrier(0)
    Unit cur, nxt; int ui = 0;
    if (!S.next(0, cur)) return;
    f32x4 acc[2][2][4][2];
#pragma unroll
    for (int a = 0; a < 2; ++a)
#pragma unroll
        for (int b = 0; b < 2; ++b)
#pragma unroll
            for (int m = 0; m < 4; ++m)
#pragma unroll
                for (int n = 0; n < 2; ++n) acc[a][b][m][n] = (f32x4){0.f, 0.f, 0.f, 0.f};
    bf16x8 At[4][2], B0[2][2], B1[2][2];
    const char* cA = (const char*)g.A + (size_t)cur.pm * tstep; const char* cB = (const char*)g.Bt + (size_t)cur.pn * tstep;
    S.a_ready(cur);
    if constexpr (SP2) {
        PG8_STAGE(PG8_SB(0, 0), cB, voffB); PG8_STAGE(PG8_SB(0, 1), cB + hstep, voffB); PG8_STAGE(PG8_SA(0, 0), cA, voffA); PG8_STAGE(PG8_SA(0, 1), cA + hstep, voffA);
        if (wr == 1) PG8_BAR;
        PG8_WAIT_V(2); PG8_BAR;
        PG8_STAGE(PG8_SB(1, 0), cB + kstep, voffB); PG8_STAGE(PG8_SA(1, 0), cA + kstep, voffA); PG8_STAGE(PG8_SB(1, 1), cB + hstep + kstep, voffB);
        PG8_WAIT_V(6); PG8_BAR;
    } else {
        PG8_STAGE(PG8_SB(0, 0), cB, voffB); PG8_STAGE(PG8_SA(0, 0), cA, voffA); PG8_STAGE(PG8_SB(0, 1), cB + hstep, voffB); PG8_STAGE(PG8_SA(0, 1), cA + hstep, voffA);
        if (wr == 1) PG8_BAR;
        PG8_WAIT_V(4); PG8_BAR;
        PG8_STAGE(PG8_SB(1, 0), cB + kstep, voffB); PG8_STAGE(PG8_SA(1, 0), cA + kstep, voffA); PG8_STAGE(PG8_SB(1, 1), cB + hstep + kstep, voffB);
        PG8_WAIT_V(6); PG8_BAR;
    }
    for (;;) {
        const bool has_next = S.next(ui + 1, nxt);
        const char* nA = has_next ? (const char*)g.A + (size_t)nxt.pm * tstep : cA; const char* nB = has_next ? (const char*)g.Bt + (size_t)nxt.pn * tstep : cB;
        for (int t = 0; t < nt; t += 2) {
            const bool last = (t == nt - 2);
            const char* a1 = cA + (size_t)(t + 1) * kstep;
            const char* a2 = last ? nA : cA + (size_t)(t + 2) * kstep; const char* b2 = last ? nB : cB + (size_t)(t + 2) * kstep;
            const char* a3 = a2 + kstep; const char* b3 = b2 + kstep;
            if (last && has_next) S.a_ready(nxt);
            if constexpr (SP2) {
            PG8_LDB(B0, 0, 0); PG8_LDB(B1, 0, 1); PG8_SCHED; PG8_LDA(At, 0, 0); PG8_STAGE(PG8_SA(1, 1), a1 + hstep, voffA);
            PG8_WAIT_V(8); PG8_WAIT_L(0); PG8_BAR; PG8_MMA(0, 0, At, B0); PG8_MMA(0, 1, At, B1); PG8_BAR; PG8_SCHED;
            PG8_LDA(At, 0, 1); PG8_STAGE(PG8_SB(0, 0), b2, voffB); PG8_STAGE(PG8_SB(0, 1), b2 + hstep, voffB); PG8_STAGE(PG8_SA(0, 0), a2, voffA);
            PG8_WAIT_V(8); PG8_WAIT_L(0); PG8_BAR; PG8_MMA(1, 0, At, B0); PG8_MMA(1, 1, At, B1); PG8_BAR; PG8_SCHED;
            PG8_LDB(B0, 1, 0); PG8_LDB(B1, 1, 1); PG8_SCHED; PG8_LDA(At, 1, 0); PG8_STAGE(PG8_SA(0, 1), a2 + hstep, voffA);
            PG8_WAIT_V(8); PG8_WAIT_L(0); PG8_BAR; PG8_MMA(0, 0, At, B0); PG8_MMA(0, 1, At, B1); PG8_BAR; PG8_SCHED;
            PG8_LDA(At, 1, 1); PG8_STAGE(PG8_SB(1, 0), b3, voffB); PG8_STAGE(PG8_SB(1, 1), b3 + hstep, voffB); PG8_STAGE(PG8_SA(1, 0), a3, voffA);
            PG8_WAIT_V(8); PG8_WAIT_L(0); PG8_BAR; PG8_MMA(1, 0, At, B0); PG8_MMA(1, 1, At, B1); PG8_BAR; PG8_SCHED;
            } else {
            PG8_LDB(B0, 0, 0); PG8_SCHED; PG8_LDA(At, 0, 0); PG8_STAGE(PG8_SA(1, 1), a1 + hstep, voffA);
            PG8_WAIT_L(8); PG8_BAR; PG8_WAIT_L(0); PG8_MMA(0, 0, At, B0); PG8_BAR; PG8_SCHED;
            PG8_LDB(B1, 0, 1); PG8_STAGE(PG8_SB(0, 0), b2, voffB);
            PG8_BAR; PG8_WAIT_L(0); PG8_MMA(0, 1, At, B1); PG8_BAR;
            PG8_LDA(At, 0, 1); PG8_STAGE(PG8_SA(0, 0), a2, voffA);
            PG8_BAR; PG8_WAIT_L(0); PG8_MMA(1, 0, At, B0); PG8_BAR; PG8_SCHED;
            PG8_STAGE(PG8_SB(0, 1), b2 + hstep, voffB);
            PG8_WAIT_V(6); PG8_BAR; PG8_MMA(1, 1, At, B1); PG8_BAR;
            PG8_LDB(B0, 1, 0); PG8_SCHED; PG8_LDA(At, 1, 0); PG8_STAGE(PG8_SA(0, 1), a2 + hstep, voffA);
            PG8_WAIT_L(8); PG8_BAR; PG8_WAIT_L(0); PG8_MMA(0, 0, At, B0); PG8_BAR; PG8_SCHED;
            PG8_LDB(B1, 1, 1); PG8_STAGE(PG8_SB(1, 0), b3, voffB);
            PG8_BAR; PG8_WAIT_L(0); PG8_MMA(0, 1, At, B1); PG8_BAR;
            PG8_LDA(At, 1, 1); PG8_STAGE(PG8_SA(1, 0), a3, voffA);
            PG8_BAR; PG8_WAIT_L(0); PG8_MMA(1, 0, At, B0); PG8_BAR; PG8_SCHED;
            PG8_STAGE(PG8_SB(1, 1), b3 + hstep, voffB);
            PG8_WAIT_V(6); PG8_BAR; PG8_MMA(1, 1, At, B1); PG8_BAR;
            }
        }
        if constexpr (ALIGN_EPI) { if (wr == 0) PG8_BAR; }
        if constexpr (!Epi::AFTER_DRAIN) { E(acc, cur, wr, wc, fr, fq); S.done(cur); }
        if (!has_next) break;
#pragma unroll
        for (int a = 0; a < 2; ++a)
#pragma unroll
            for (int b = 0; b < 2; ++b)
#pragma unroll
                for (int m = 0; m < 4; ++m)
#pragma unroll
                    for (int n = 0; n < 2; ++n) acc[a][b][m][n] = (f32x4){0.f, 0.f, 0.f, 0.f};
        cur = nxt; cA = nA; cB = nB; ++ui;
        if constexpr (ALIGN_EPI) { if (wr == 1) PG8_BAR; }
    }
    PG8_WAIT_V(0);
    if constexpr (!ALIGN_EPI) { if (wr == 0) PG8_BAR; }
    PG8_BAR;
    if constexpr (Epi::AFTER_DRAIN) { E.fused(acc, cur, wr, wc, fr, fq, lds, wid, lane); S.done(cur); }
#undef PG8_SA
#undef PG8_SB
#undef PG8_STAGE
#undef PG8_LDA
#undef PG8_LDB
#undef PG8_MMA
#undef PG8_WAIT_V
#undef PG8_WAIT_L
#undef PG8_BAR
#undef PG8_SCHED
}
}
#include <hip/hip_bf16.h>
#include <cmath>
namespace attn_body {
using bf16=__hip_bfloat16;
using bf16x8=__attribute__((ext_vector_type(8)))short;
using s16x4=__attribute__((ext_vector_type(4)))short;
using f32x16=__attribute__((ext_vector_type(16)))float;
using u32x4=__attribute__((ext_vector_type(4)))unsigned;
constexpr int SEQ=8192,D=64;
constexpr int NW=8,QBLK=32,QB=QBLK*NW,KVBLK=64,NQB=SEQ/QB;
constexpr int ATTN_UNIT_ROWS=QB;
__device__ __forceinline__ int crow(int r,int hi){return (r&3)+8*(r>>2)+4*hi;}
#define SBAR() __builtin_amdgcn_sched_barrier(0)
__device__ __forceinline__ void cmask(f32x16&p0,f32x16&p1,int jb,int qrel,int hi){
  const float NEG=-INFINITY; int kb=64*jb+4*hi;
  #pragma unroll
  for(int r=0;r<16;++r){int kv=kb+(r&3)+8*(r>>2); if(kv>qrel)p0[r]=NEG; if(kv+32>qrel)p1[r]=NEG;}
}

constexpr int NSLOT=3, SLOTB=8192;
constexpr int LDS_K=0, LDS_V=NSLOT*SLOTB, LDS_WS=2*NSLOT*SLOTB, LDS_OST=LDS_WS+NW*64*4, LDS_BYTES=LDS_OST+NW*4096;
constexpr float C2=0.125f*1.4426950408889634f;
__device__ __forceinline__ void glds16(const void*gsrc,unsigned lds_dst){unsigned keep;
  asm volatile("s_mov_b32 %0, m0\n\ts_mov_b32 m0, %2\n\ts_nop 0\n\tglobal_load_lds_dwordx4 %1, off\n\ts_mov_b32 m0, %0":"=&s"(keep):"v"(gsrc),"s"(lds_dst):"memory");}
__device__ __forceinline__ float max3f(float a,float b,float c){float r;asm("v_max3_f32 %0, %1, %2, %3":"=v"(r):"v"(a),"v"(b),"v"(c));return r;}
__device__ __forceinline__ float max2f(float a,float b){float r;asm("v_max_f32_e32 %0, %1, %2":"=v"(r):"v"(a),"v"(b));return r;}
__device__ __forceinline__ float fadd_s(float a,float b){float r;asm("v_add_f32_e32 %0, %1, %2":"=v"(r):"v"(a),"v"(b));return r;}
__device__ __forceinline__ float fsub_s(float a,float b){float r;asm("v_sub_f32_e32 %0, %1, %2":"=v"(r):"v"(a),"v"(b));return r;}
typedef float f32x2_t __attribute__((ext_vector_type(2))); typedef __bf16 bf16x2_t __attribute__((ext_vector_type(2)));
__device__ __forceinline__ unsigned cvtpk_s(float lo,float hi){f32x2_t v={lo,hi};bf16x2_t b=__builtin_convertvector(v,bf16x2_t);return __builtin_bit_cast(unsigned,b);}
#define WAIT_BAR(N) asm volatile("s_waitcnt vmcnt(" #N ") lgkmcnt(0)\n\ts_barrier":::"memory")

__device__ __forceinline__ void qkt(f32x16&p0,f32x16&p1,const char*Kslot,const bf16x8*qr,const f32x16&negm,int r32,int hi){
  const char*kb=Kslot+hi*1024+r32*16;
  #pragma unroll
  for(int d0=0;d0<4;++d0){
    const bf16x8 b0=*reinterpret_cast<const bf16x8*>(kb+d0*2048);
    const bf16x8 b1=*reinterpret_cast<const bf16x8*>(kb+d0*2048+512);
    if(d0==0){p0=__builtin_amdgcn_mfma_f32_32x32x16_bf16(b0,qr[0],negm,0,0,0);p1=__builtin_amdgcn_mfma_f32_32x32x16_bf16(b1,qr[0],negm,0,0,0);}
    else{p0=__builtin_amdgcn_mfma_f32_32x32x16_bf16(b0,qr[d0],p0,0,0,0);p1=__builtin_amdgcn_mfma_f32_32x32x16_bf16(b1,qr[d0],p1,0,0,0);}}
}
typedef __attribute__((address_space(3))) const char* lds_cptr;
typedef short v4i16_t __attribute__((ext_vector_type(4)));
__device__ __forceinline__ void kload8(bf16x8*kf,lds_cptr kp){
  kf[0]=*(const __attribute__((address_space(3))) bf16x8*)(kp);      kf[1]=*(const __attribute__((address_space(3))) bf16x8*)(kp+512);
  kf[2]=*(const __attribute__((address_space(3))) bf16x8*)(kp+2048); kf[3]=*(const __attribute__((address_space(3))) bf16x8*)(kp+2560);
  kf[4]=*(const __attribute__((address_space(3))) bf16x8*)(kp+4096); kf[5]=*(const __attribute__((address_space(3))) bf16x8*)(kp+4608);
  kf[6]=*(const __attribute__((address_space(3))) bf16x8*)(kp+6144); kf[7]=*(const __attribute__((address_space(3))) bf16x8*)(kp+6656);
}
__device__ __forceinline__ void kload2(bf16x8*kf,lds_cptr kp,int j){ kf[2*j]=*(const __attribute__((address_space(3))) bf16x8*)(kp+j*2048); kf[2*j+1]=*(const __attribute__((address_space(3))) bf16x8*)(kp+j*2048+512); }
__device__ __forceinline__ s16x4 vtr(lds_cptr p){ return __builtin_bit_cast(s16x4,__builtin_amdgcn_ds_read_tr16_b64_v4i16((__attribute__((address_space(3))) v4i16_t*)p)); }
__device__ __forceinline__ float rowmax(const f32x16&p0,const f32x16&p1){
  float a=max3f(p0[0],p0[1],p1[0]),b=max3f(p0[2],p0[3],p1[1]);a=max3f(a,p1[2],p1[3]);
  #pragma unroll
  for(int r=4;r<16;r+=4){a=max3f(a,p0[r],p0[r+1]);b=max3f(b,p0[r+2],p0[r+3]);a=max3f(a,p1[r],p1[r+1]);b=max3f(b,p1[r+2],p1[r+3]);}
  const float m=max2f(a,b);
  auto rr=__builtin_amdgcn_permlane32_swap(__float_as_uint(m),__float_as_uint(m),false,false);
  return max2f(__uint_as_float(rr[0]),__uint_as_float(rr[1]));
}
__device__ __forceinline__ void pv(f32x16*o,int vb,bf16x8 pa0,bf16x8 pa1,bf16x8 pa2,bf16x8 pa3){
  #pragma unroll
  for(int d0=0;d0<2;++d0){s16x4 lo[4],hi[4];
    #pragma unroll
    for(int ks=0;ks<4;++ks){
      asm volatile("ds_read_b64_tr_b16 %0,%1 offset:%c2":"=&v"(lo[ks]):"v"(vb),"i"(d0*4096+ks*1024):"memory");
      asm volatile("ds_read_b64_tr_b16 %0,%1 offset:%c2":"=&v"(hi[ks]):"v"(vb),"i"(d0*4096+ks*1024+512):"memory");}
    asm volatile("s_waitcnt lgkmcnt(0)":::"memory");SBAR();
    #define PK(k) (bf16x8){lo[k][0],lo[k][1],lo[k][2],lo[k][3],hi[k][0],hi[k][1],hi[k][2],hi[k][3]}
    o[d0]=__builtin_amdgcn_mfma_f32_32x32x16_bf16(pa0,PK(0),o[d0],0,0,0);
    o[d0]=__builtin_amdgcn_mfma_f32_32x32x16_bf16(pa1,PK(1),o[d0],0,0,0);
    o[d0]=__builtin_amdgcn_mfma_f32_32x32x16_bf16(pa2,PK(2),o[d0],0,0,0);
    o[d0]=__builtin_amdgcn_mfma_f32_32x32x16_bf16(pa3,PK(3),o[d0],0,0,0);
    #undef PK
  }
}

#ifndef ATTN_STORE16
#define ATTN_STORE16(p,v) (*(u32x4*)(p)=(v))
#endif
template<int THRL,int PIN,int POUT> __device__ __forceinline__ void attn_unit(int b,int h,int qb,const bf16*Q,const bf16*__restrict__ K,const bf16*__restrict__ V,bf16*O,char*shm){
  const int tid=threadIdx.x,lane=tid&63,r32=lane&31,hi=lane>>5; const int wid=__builtin_amdgcn_readfirstlane(tid>>6);
  const long rowbase=(long)b*SEQ; const int q0=qb*QB;
  const bf16*Qw=Q+(rowbase+q0+wid*QBLK)*PIN+h*D;
  const bf16*Kh=K+rowbase*PIN+h*D,*Vh=V+rowbase*PIN+h*D;
  const unsigned lds0=(unsigned)(uintptr_t)shm;
  float*wsf=(float*)(shm+LDS_WS)+wid*64;
  const bf16*ksrc=Kh+(long)lane*PIN+wid*8;
  const bf16*vsrc=Vh+(long)(16*(wid&3)+(lane>>2))*PIN+(wid>>2)*32+(lane&3)*8;
  const unsigned kdst=lds0+LDS_K+wid*1024, vdst=lds0+LDS_V+wid*1024;
  #define DMA_K(t,slot) glds16(ksrc+(long)(t)*KVBLK*PIN,(unsigned)__builtin_amdgcn_readfirstlane(kdst+(slot)))
  #define DMA_V(t,slot) glds16(vsrc+(long)(t)*KVBLK*PIN,(unsigned)__builtin_amdgcn_readfirstlane(vdst+(slot)))
  const int vb0=(int)(lds0+LDS_V)+((lane>>4)&1)*32+(lane&3)*8+(4*hi+((lane&15)>>2))*64;
  const char*Kbase=shm+LDS_K; bf16x8 kf[8];
  const lds_cptr shm3=(lds_cptr)shm; const lds_cptr kp0=shm3+LDS_K+hi*1024+r32*16; const lds_cptr vp0=shm3+LDS_V+((lane>>4)&1)*32+(lane&3)*8+(4*hi+((lane&15)>>2))*64;
  const int NT=(q0+QB)/KVBLK;
  DMA_K(0,0);DMA_V(0,0);DMA_K(1,SLOTB);
  bf16x8 qr[4];
  #pragma unroll
  for(int d0=0;d0<4;++d0)qr[d0]=*reinterpret_cast<const bf16x8*>(&Qw[(long)r32*PIN+d0*16+hi*8]);
  float mhat=0.f,l_reg=0.f;f32x16 o[2];o[0]=f32x16{};o[1]=f32x16{};f32x16 negm=f32x16{};asm volatile("":"+v"(negm));
  const int qrel=wid*QBLK+r32;
  #define CMASK(P0,P1,t) do{int jb_=(t)-(NT-4); if(jb_>=0)cmask(P0,P1,jb_,qrel,hi);}while(0)
  bool resc=false;
  #define START(P0,P1) do{ const float rm=rowmax(P0,P1); resc=false; \
    { const float dl=rm; mhat=fadd_s(mhat,dl); \
      _Pragma("unroll") for(int r=0;r<16;++r){P0[r]=fsub_s(P0[r],dl);P1[r]=fsub_s(P1[r],dl);} \
      _Pragma("unroll") for(int r=0;r<16;++r)negm[r]=-mhat; asm volatile("":"+v"(negm)); } \
    _Pragma("unroll") for(int r=0;r<16;++r)P0[r]=__builtin_amdgcn_exp2f(P0[r]); }while(0)
  #define RESC() do{ if(resc){ asm volatile("s_waitcnt lgkmcnt(0)":::"memory"); \
      _Pragma("unroll") for(int d_=0;d_<2;++d_) _Pragma("unroll") for(int r=0;r<16;++r)o[d_][r]*=wsf[crow(r,hi)]; } }while(0)
  f32x16 pA0,pA1,pB0,pB1;
  int sl_prev=0,sl_cur=0,sl_next=SLOTB;
  #define ROT() do{sl_prev=sl_cur;sl_cur=sl_next;sl_next=(sl_next==(NSLOT-1)*SLOTB)?0:sl_next+SLOTB;}while(0)
  DMA_K(2,2*SLOTB);
  WAIT_BAR(3);
  qkt(pA0,pA1,Kbase,qr,negm,r32,hi);asm volatile("s_nop 15\n\ts_nop 7":"+v"(pA0),"+v"(pA1));CMASK(pA0,pA1,0);
  START(pA0,pA1);
  _Pragma("unroll") for(int r=0;r<16;++r)pA1[r]=__builtin_amdgcn_exp2f(pA1[r]);
  WAIT_BAR(0);
  DMA_K(3,0);DMA_V(1,SLOTB);
  ROT();
  kload8(kf,kp0+sl_cur);
  WAIT_BAR(2);
  s16x4 vlo[8],vhi[8]; u32x4 pw0,pw1,pw2,pw3;
  #define PKW(P,B) cvtpk_s(P[B],P[B+1])
  #define PAF(k) __builtin_bit_cast(bf16x8,pw##k)
  #define VFR(i) (bf16x8){vlo[i][0],vlo[i][1],vlo[i][2],vlo[i][3],vhi[i][0],vhi[i][1],vhi[i][2],vhi[i][3]}
  #define PIN(x) asm volatile("":"+v"(x))
  #define MX3(a,b,c) __builtin_fmaxf(__builtin_fmaxf((a),(b)),(c))
  #define GAPA(MF,A0,A1,A2,A3,W0,W1,PW) do{ MF; sacc+=A0; sacc+=A1; sacc+=A2; sacc+=A3; PIN(sacc); W0; W1; PIN(PW); SBAR(); }while(0)
  #define EX(v) __builtin_amdgcn_exp2f(v)
  #define GAPB(MF,X,B) do{ MF; X[B]=EX(X[B]); X[B+1]=EX(X[B+1]); X[B+2]=EX(X[B+2]); X[B+3]=EX(X[B+3]); PIN(X); SBAR(); }while(0)
  #define VRD(i) do{ vlo[i]=vtr(vp_+(((i)>>2)*4096+((i)&3)*1024)); vhi[i]=vtr(vp_+(((i)>>2)*4096+((i)&3)*1024+512)); }while(0)
  #define KRD(G,j) do{ if(G){ kload2(kf,kp0+sl_next,j); SBAR(); } }while(0)
  #define STEP(C0,C1,P0,P1,t,GK,GV,GL) do{ SBAR(); \
    const lds_cptr vp_=vp0+sl_prev; \
    VRD(0); SBAR(); float sacc=(P0[0]+P0[1]); \
    GAPA(C0=__builtin_amdgcn_mfma_f32_32x32x16_bf16(kf[0],qr[0],negm,0,0,0), P0[2],P0[3],P0[4],P0[5],     pw0[0]=PKW(P0,0), pw0[1]=PKW(P0,2), pw0); \
    VRD(4); SBAR(); GAPA(C1=__builtin_amdgcn_mfma_f32_32x32x16_bf16(kf[1],qr[0],negm,0,0,0), P0[6],P0[7],P0[8],P0[9],     pw0[2]=PKW(P0,4), pw0[3]=PKW(P0,6), pw0); \
    VRD(1); SBAR(); GAPA(C0=__builtin_amdgcn_mfma_f32_32x32x16_bf16(kf[2],qr[1],C0,0,0,0),   P0[10],P0[11],P0[12],P0[13], pw1[0]=PKW(P0,8), pw1[1]=PKW(P0,10), pw1); \
    VRD(5); SBAR(); GAPA(C1=__builtin_amdgcn_mfma_f32_32x32x16_bf16(kf[3],qr[1],C1,0,0,0),   P0[14],P0[15],P1[0],P1[1],   pw1[2]=PKW(P0,12),pw1[3]=PKW(P0,14), pw1); \
    VRD(2); SBAR(); GAPA(C0=__builtin_amdgcn_mfma_f32_32x32x16_bf16(kf[4],qr[2],C0,0,0,0),   P1[2],P1[3],P1[4],P1[5],     pw2[0]=PKW(P1,0), pw2[1]=PKW(P1,2), pw2); \
    VRD(6); SBAR(); GAPA(C1=__builtin_amdgcn_mfma_f32_32x32x16_bf16(kf[5],qr[2],C1,0,0,0),   P1[6],P1[7],P1[8],P1[9],     pw2[2]=PKW(P1,4), pw2[3]=PKW(P1,6), pw2); \
    VRD(3); SBAR(); GAPA(C0=__builtin_amdgcn_mfma_f32_32x32x16_bf16(kf[6],qr[3],C0,0,0,0),   P1[10],P1[11],P1[12],P1[13], pw3[0]=PKW(P1,8), pw3[1]=PKW(P1,10), pw3); \
    VRD(7); SBAR(); GAPA(C1=__builtin_amdgcn_mfma_f32_32x32x16_bf16(kf[7],qr[3],C1,0,0,0),   P1[14],P1[15],0.f,0.f,       pw3[2]=PKW(P1,12),pw3[3]=PKW(P1,14), pw3); \
    l_reg+=sacc; \
    if(GK){DMA_K((t)+3,sl_cur);} if(GV){DMA_V((t)+1,sl_next);} \
    CMASK(C0,C1,t); \
    { float a=MX3(C0[0],C0[1],C1[0]),b=MX3(C0[2],C0[3],C1[1]); a=MX3(a,C1[2],C1[3]); \
      _Pragma("unroll") for(int r=4;r<16;r+=4){a=MX3(a,C0[r],C0[r+1]);b=MX3(b,C0[r+2],C0[r+3]);a=MX3(a,C1[r],C1[r+1]);b=MX3(b,C1[r+2],C1[r+3]);} \
      float rm=__builtin_fmaxf(a,b); { auto rr=__builtin_amdgcn_permlane32_swap(__float_as_uint(rm),__float_as_uint(rm),false,false); rm=__builtin_fmaxf(__uint_as_float(rr[0]),__uint_as_float(rr[1])); } \
      resc=false; \
      if(__builtin_expect(__any(rm>(float)THRL),0)){ const float dl=__builtin_fmaxf(rm,0.f); mhat+=dl; \
        _Pragma("unroll") for(int r=0;r<16;++r){C0[r]-=dl;C1[r]-=dl;} \
        _Pragma("unroll") for(int r=0;r<16;++r)negm[r]=-mhat; asm volatile("":"+v"(negm)); \
        const float f=__builtin_amdgcn_exp2f(-dl); l_reg*=f; if(hi==0)wsf[r32]=f; resc=true; } } \
    SBAR(); \
    GAPB(o[0]=__builtin_amdgcn_mfma_f32_32x32x16_bf16(PAF(0),VFR(0),o[0],0,0,0), C0,0); \
    GAPB(o[1]=__builtin_amdgcn_mfma_f32_32x32x16_bf16(PAF(0),VFR(4),o[1],0,0,0), C0,4); \
    KRD(GL,0); GAPB(o[0]=__builtin_amdgcn_mfma_f32_32x32x16_bf16(PAF(1),VFR(1),o[0],0,0,0), C0,8); \
    KRD(GL,1); GAPB(o[1]=__builtin_amdgcn_mfma_f32_32x32x16_bf16(PAF(1),VFR(5),o[1],0,0,0), C0,12); \
    KRD(GL,2); GAPB(o[0]=__builtin_amdgcn_mfma_f32_32x32x16_bf16(PAF(2),VFR(2),o[0],0,0,0), C1,0); \
    KRD(GL,3); GAPB(o[1]=__builtin_amdgcn_mfma_f32_32x32x16_bf16(PAF(2),VFR(6),o[1],0,0,0), C1,4); \
    GAPB(o[0]=__builtin_amdgcn_mfma_f32_32x32x16_bf16(PAF(3),VFR(3),o[0],0,0,0), C1,8); \
    GAPB(o[1]=__builtin_amdgcn_mfma_f32_32x32x16_bf16(PAF(3),VFR(7),o[1],0,0,0), C1,12); \
    }while(0)
  int t=1;
  #undef CMASK
  #define CMASK(P0,P1,t) do{}while(0)
  for(;t+5<NT;t+=2){
    STEP(pB0,pB1,pA0,pA1,t,true,true,true);     WAIT_BAR(2); RESC(); ROT();
    STEP(pA0,pA1,pB0,pB1,t+1,true,true,true);   WAIT_BAR(2); RESC(); ROT();
  }
  #undef CMASK
  #define CMASK(P0,P1,t) do{int jb_=(t)-(NT-4); if(jb_>=0)cmask(P0,P1,jb_,qrel,hi);}while(0)
  #define ENDW(tt) do{ if((tt)+3<NT){WAIT_BAR(2);} else if((tt)+2<NT){WAIT_BAR(1);} else {WAIT_BAR(0);} }while(0)
  for(;t+1<NT;t+=2){
    STEP(pB0,pB1,pA0,pA1,t,(t+3<NT),(t+1<NT),(t+1<NT));       ENDW(t);   RESC(); ROT();
    STEP(pA0,pA1,pB0,pB1,t+1,(t+4<NT),(t+2<NT),(t+2<NT));     ENDW(t+1); RESC(); ROT();
  }
  STEP(pB0,pB1,pA0,pA1,NT-1,false,false,false); RESC();
  { float sacc=pB0[0]+pB0[1]; _Pragma("unroll") for(int r=2;r<16;++r)sacc+=pB0[r]; _Pragma("unroll") for(int r=0;r<16;++r)sacc+=pB1[r]; l_reg+=sacc;
    pw0=(u32x4){PKW(pB0,0),PKW(pB0,2),PKW(pB0,4),PKW(pB0,6)};pw1=(u32x4){PKW(pB0,8),PKW(pB0,10),PKW(pB0,12),PKW(pB0,14)};pw2=(u32x4){PKW(pB1,0),PKW(pB1,2),PKW(pB1,4),PKW(pB1,6)};pw3=(u32x4){PKW(pB1,8),PKW(pB1,10),PKW(pB1,12),PKW(pB1,14)};
    SBAR(); pv(o,vb0+sl_cur,PAF(0),PAF(1),PAF(2),PAF(3)); }
  #undef PKW
  #undef PAF
  #undef VFR
  #undef PIN
  #undef MX3
  #undef GAPA
  #undef GAPB
  #undef EX
  #undef VRD
  #undef KRD
  #undef STEP
  #undef ENDW
  {auto rr=__builtin_amdgcn_permlane32_swap(__float_as_uint(l_reg),__float_as_uint(l_reg),false,false);l_reg=__uint_as_float(rr[0])+__uint_as_float(rr[1]);}
  if(hi==0)wsf[32+r32]=l_reg;asm volatile("s_waitcnt lgkmcnt(0)":::"memory");
  float rli[16];
  #pragma unroll
  for(int r=0;r<16;++r)rli[r]=__builtin_amdgcn_rcpf(wsf[32+crow(r,hi)]);
  bf16*Ow=O+(rowbase+q0+wid*QBLK)*POUT+h*D;
  { bf16*stg=(bf16*)(shm+LDS_OST)+wid*2048;
    #pragma unroll
    for(int r=0;r<16;++r){const int orow=crow(r,hi);
      #pragma unroll
      for(int d0=0;d0<2;++d0)stg[orow*64+d0*32+r32]=__float2bfloat16(o[d0][r]*rli[r]);}
    asm volatile("s_waitcnt lgkmcnt(0)":::"memory");
    #pragma unroll
    for(int i=0;i<4;++i){const int row=i*8+(lane>>3),ch=lane&7; const u32x4 v=*(const u32x4*)(stg+row*64+ch*8); ATTN_STORE16(Ow+(long)row*POUT+ch*8,v);} }
  asm volatile("s_waitcnt lgkmcnt(0)\n\ts_barrier":::"memory");
  #undef DMA_K
  #undef DMA_V
  #undef CMASK
  #undef START
  #undef RESC
  #undef ROT
}
constexpr int ATTN_LDS_BYTES=LDS_BYTES;
struct AttnUnit { int bh; int qb; };
struct StaticOrder {
  int vcu;
  __device__ __forceinline__ explicit StaticOrder(int v):vcu(v){}
  __device__ __forceinline__ bool next(int i,AttnUnit&u)const{ if(i>=8)return false; const int s=vcu&7; u.bh=(vcu>>3)+32*(i>>2); const int ii=i&3; u.qb=(ii==0)?s:(ii==1)?15-s:(ii==2)?16+s:31-s; return true; }
};
template<int PIN,int POUT,int THRL=8> __device__ __forceinline__ void diff_attn_phase(char*lds,const bf16*PRJ,bf16*O1,bf16*O2,const StaticOrder&S){
  AttnUnit u;
  _Pragma("unroll 1") for(int i=0;S.next(i,u);++i){ const int rest=u.bh%32, h=rest>>2, wi=(rest>>1)&1, half=rest&1;
    attn_unit<THRL,PIN,POUT>(u.bh/32,0,u.qb,PRJ+(2*h+wi)*64,PRJ+1024+(2*h+wi)*64,PRJ+2048+h*128+half*64,(wi?O2:O1)+h*128+half*64,lds); }
}
#undef SBAR
#undef WAIT_BAR
}
constexpr int NWAVES = 8, NTHREADS = NWAVES * 64;
constexpr int BATCH = 2, T = 8192, D = 1024, M = BATCH * T, DFF = 2816, NPROJ = 3072;
constexpr float RMS_EPS = 1e-6f;
constexpr float QSCALE = 0.18033688011112042f;
constexpr float LAMBDA_INIT = 0.35550906759096934f;
constexpr int C_QN = 0, C_KC = 512, C_VC = 640, C_KS = 768, C_VS = 896, C_KW = 1024, C_VW = 1152, C_QS = 1280, C_KSB = 1792, C_VSB = 2304, C_GL = 2816;
constexpr int C1_Q = 0, C1_K = 1024, C1_V = 2048;

constexpr size_t MiB = 1u << 20, KiB = 1u << 10;
constexpr size_t WS_CTL = 0, CTL_ZERO_BYTES = 64 * KiB;
constexpr size_t WS_MODV = 1 * MiB;
constexpr size_t WS_CB1  = 1 * MiB + 128 * KiB;
constexpr size_t WS_KCMP = 1 * MiB + 256 * KiB;
constexpr size_t WS_VCMP = 1 * MiB + 512 * KiB;
constexpr size_t WS_CW2T = 1 * MiB + 768 * KiB;
constexpr size_t WS_CS   = 2 * MiB;
constexpr size_t WS_WQKV1 = 4 * MiB, WS_WOUT1 = 10 * MiB, WS_WG1 = 12 * MiB, WS_WU1 = WS_WG1 + 5632 * KiB, WS_WD1 = WS_WU1 + 5632 * KiB;
constexpr size_t WS_WG0 = WS_WD1 + 5632 * KiB, WS_WU0 = WS_WG0 + 5632 * KiB, WS_WD0 = WS_WU0 + 5632 * KiB;
constexpr size_t WS_XN = 45 * MiB;
constexpr size_t WS_R = 77 * MiB;
constexpr size_t WS_WIN0 = WS_R, WS_WOUT0 = WS_R + 6 * MiB, WS_CW1T = WS_R + 8 * MiB  , WS_PR = WS_R + 11 * MiB  , WS_OCAT = WS_PR + 96 * MiB;
constexpr size_t WS_G = WS_R, WS_ACT = WS_R + 88 * MiB;
constexpr size_t WS_PR1 = WS_R, WS_O1 = WS_R + 96 * MiB, WS_O2 = WS_O1 + 32 * MiB;
constexpr size_t WS_END = WS_ACT + 88 * MiB;
static_assert(WS_WD0 + 5632 * KiB == WS_XN && WS_OCAT + 32 * MiB <= WS_END && WS_O2 + 32 * MiB <= WS_END && WS_END <= 256 * MiB, "d_ws map");
constexpr int CW_BAR = 4096;

constexpr int LDS_BYTES = 163840;
constexpr int MISC_OFF = LDS_BYTES - 256;
constexpr int WAVE_LDS = 18432;
static_assert(NWAVES * WAVE_LDS <= MISC_OFF, "LDS map");
#define GAS __attribute__((address_space(1)))
#define LAS __attribute__((address_space(3)))
typedef unsigned short bf16;
typedef unsigned v4u __attribute__((ext_vector_type(4)));
typedef float f32x4 __attribute__((ext_vector_type(4)));
typedef short bf16x8 __attribute__((ext_vector_type(8)));
typedef GAS unsigned gu32;
typedef GAS unsigned long long gu64;
#define RLX_AGENT __ATOMIC_RELAXED, __HIP_MEMORY_SCOPE_AGENT
#define LDS_WAIT() asm volatile("s_waitcnt lgkmcnt(0)" ::: "memory")
#define VM_WAIT() asm volatile("s_waitcnt vmcnt(0)" ::: "memory")
__device__ __forceinline__ unsigned long long rt() { return __builtin_amdgcn_s_memrealtime(); }
__device__ __forceinline__ unsigned f2bf(float f) { unsigned u = __builtin_bit_cast(unsigned, f); return (u + 0x7fffu + ((u >> 16) & 1u)) >> 16; }
__device__ __forceinline__ unsigned pk2(float lo, float hi) { return f2bf(lo) | (f2bf(hi) << 16); }

#define XB_TMO      128
#define XB_XCNT(j)  (256  + 64 * (j))
#define XB_XSUB(j)  (1280 + 64 * (j))
#define XB_XGEN(j)  (2304 + 64 * (j))
#define XB_TOP      3328
#define XB_TOPGEN   3392
#define XCD_BAR_WORDS 3456
#define XB_SPIN_CAP (1u << 18)

__device__ __forceinline__ unsigned xb_ld(unsigned* p)              { return __hip_atomic_load(p, __ATOMIC_RELAXED, __HIP_MEMORY_SCOPE_AGENT); }
__device__ __forceinline__ unsigned xb_add(unsigned* p, unsigned v) { return __hip_atomic_fetch_add(p, v, __ATOMIC_RELAXED, __HIP_MEMORY_SCOPE_AGENT); }
__device__ __forceinline__ unsigned xb_xcc_id() { return (unsigned)__builtin_amdgcn_s_getreg((3 << 11) | 20) & 0xFu; }
#define XB_SPIN(cond, bar) do { unsigned _sp = 0; while (cond) { __builtin_amdgcn_s_sleep(1); \
    if ((++_sp & 255u) == 0u) { if (xb_ld(&(bar)[XB_TMO])) break; if (_sp > XB_SPIN_CAP) { atomicAdd(&(bar)[XB_TMO], 1u); break; } } } } while (0)

struct XcdBarrier {
    unsigned* bar; unsigned x;
    volatile LAS unsigned* st;
};

__device__ __forceinline__ XcdBarrier xcd_barrier_post(unsigned* bar, volatile LAS unsigned* st) {
    XcdBarrier b; b.bar = bar; b.x = xb_xcc_id(); b.st = st;
    if (threadIdx.x == 0) (void)xb_add(&bar[XB_XCNT(b.x)], 1u);
    return b;
}
__device__ __forceinline__ void xcd_barrier_complete(unsigned* bar, unsigned x, unsigned& nloc, unsigned& nx) {
    const unsigned G = gridDim.x * gridDim.y * gridDim.z;
    unsigned sum, cnt, mine, sp = 0u;
    for (;;) {
        sum = 0u; cnt = 0u; mine = 0u;
#pragma unroll
        for (unsigned j = 0; j < 16; ++j) { const unsigned c = xb_ld(&bar[XB_XCNT(j)]); sum += c; cnt += (c > 0u) ? 1u : 0u; mine = (j == x) ? c : mine; }
        if (sum == G) break;
        __builtin_amdgcn_s_sleep(1);
        if ((++sp & 255u) == 0u) { if (xb_ld(&bar[XB_TMO])) break; if (sp > XB_SPIN_CAP) { atomicAdd(&bar[XB_TMO], 1u); break; } }
    }
    nloc = mine > 0u ? mine : 1u; nx = cnt > 0u ? cnt : 1u;
}

__device__ __forceinline__ void xcd_barrier(const XcdBarrier& b) {
    asm volatile("s_waitcnt vmcnt(0)" ::: "memory");
    __syncthreads();
    if (threadIdx.x == 0) {
        unsigned* bar = b.bar;
        __builtin_amdgcn_s_waitcnt(0);
        unsigned nloc = b.st[0], nx = b.st[1];
        if (nloc == 0u) { xcd_barrier_complete(bar, b.x, nloc, nx); b.st[0] = nloc; b.st[1] = nx; }
        const unsigned old = xb_add(&bar[XB_XSUB(b.x)], 1u);
        const unsigned gen = old / nloc;
        if (old + 1u == (gen + 1u) * nloc) {
            __builtin_amdgcn_fence(__ATOMIC_RELEASE, "agent");
            asm volatile("s_waitcnt vmcnt(0)" ::: "memory");
            const unsigned og = xb_add(&bar[XB_TOP], 1u);
            const unsigned tg = og / nx;
            if (og + 1u == (tg + 1u) * nx) xb_add(&bar[XB_TOPGEN], 1u);
            else XB_SPIN(xb_ld(&bar[XB_TOPGEN]) == tg, bar);
            __builtin_amdgcn_fence(__ATOMIC_ACQUIRE, "agent");
            xb_add(&bar[XB_XGEN(b.x)], 1u);
            asm volatile("s_waitcnt vmcnt(0)" ::: "memory");
        } else {
            XB_SPIN(xb_ld(&bar[XB_XGEN(b.x)]) == gen, bar);
            __builtin_amdgcn_fence(__ATOMIC_ACQUIRE, "agent");
            asm volatile("s_waitcnt vmcnt(0)" ::: "memory");
        }
    }
    __syncthreads();
}
struct Ctx {
    LAS unsigned char* lds; int tid, lane, wave, vcu, G;
    const float *x, *c; const int* positions; const float *mod_w, *mod_b, *norm_mix, *norm_ffn, *w_gate, *w_up, *conv_w, *conv_b, *w_down, *hyb_w_in, *pos_k, *pos_v, *ck_w1, *ck_w2, *cv_w1, *cv_w2, *hyb_w_out,
        *diff_w_qkv, *lq1, *lk1, *lq2, *lk2, *subln, *diff_w_out, *norm_f;
    float* out; unsigned char* ws;
};
__device__ __forceinline__ float wave_sum(float v) {
#pragma unroll
    for (int o = 1; o < 64; o <<= 1) v += __shfl_xor(v, o);
    return v;
}
__device__ __forceinline__ float wave_max(float v) {
#pragma unroll
    for (int o = 1; o < 64; o <<= 1) v = fmaxf(v, __shfl_xor(v, o));
    return v;
}
__device__ __forceinline__ float bf2f(bf16 h) { return __uint_as_float((unsigned)h << 16); }
__device__ __forceinline__ float dot2(unsigned k, unsigned q, float acc) { typedef __bf16 bf16x2_t __attribute__((ext_vector_type(2))); return __builtin_amdgcn_fdot2_f32_bf16(__builtin_bit_cast(bf16x2_t, k), __builtin_bit_cast(bf16x2_t, q), acc, false); }
#define CFENCE() asm volatile("" ::: "memory")

__device__ __forceinline__ void p0_transpose_item(const float* W, int K, int N, int c0, int w, bf16* WT, int row_off, LAS float* scr, int item, int lane) {
    const int nblk = (w + 31) / 32, kb = item / nblk, nb = item % nblk, k0 = 64 * kb, n0 = 32 * nb;
    const bool okc = (n0 + (lane & 31)) < w;
#pragma unroll 8
    for (int i = 0; i < 32; ++i) { const int kk = 2 * i + (lane >> 5); scr[kk * 33 + (lane & 31)] = okc ? W[(size_t)(k0 + kk) * N + c0 + n0 + (lane & 31)] : 0.f; }
    LDS_WAIT(); CFENCE();
    const int c = lane & 7;
#pragma unroll
    for (int j = 0; j < 4; ++j) { const int n = (lane >> 3) + 8 * j; const LAS float* s = scr + (8 * c) * 33 + n;
        v4u o; o.x = pk2(s[0 * 33], s[1 * 33]); o.y = pk2(s[2 * 33], s[3 * 33]); o.z = pk2(s[4 * 33], s[5 * 33]); o.w = pk2(s[6 * 33], s[7 * 33]);
        if (n0 + n < w) *(GAS v4u*)(WT + (size_t)(row_off + n0 + n) * K + k0 + 8 * c) = o; }
    LDS_WAIT(); CFENCE();
}
constexpr int tj_items(int K, int w) { return (K / 64) * ((w + 31) / 32); }
__device__ __forceinline__ void p0_prologue(const Ctx& C) {
    unsigned char* ws = C.ws;
    {
        LAS float* cond = (LAS float*)C.lds;
        LAS float* part = (LAS float*)(C.lds + 8192);
        LAS float* posl = (LAS float*)(C.lds + 16384);
        for (int i = C.tid; i < 2048; i += NTHREADS) { const float v = C.c[i]; cond[i] = v / (1.f + __expf(-v)); }
        __syncthreads();
        for (int tk = blockIdx.x; tk < 392; tk += C.G) {
            float acc = 0.f;
            if (tk < 384) {
                const int layer = tk / 192, cg = tk % 192, col = 32 * cg + (C.lane & 31), bb = C.lane >> 5;
                const float* wp = C.mod_w + (size_t)layer * D * 6144 + (size_t)(128 * C.wave) * 6144 + col; const LAS float* cp = cond + bb * 1024 + 128 * C.wave;
#pragma unroll 16
                for (int k = 0; k < 128; ++k) acc += cp[k] * wp[(size_t)k * 6144];
            } else {
                const int which = (tk - 384) >> 2, n = 64 * ((tk - 384) & 3) + C.lane; const float* pe = which ? C.pos_v : C.pos_k; const float* w1 = which ? C.cv_w1 : C.ck_w1;
                for (int i = C.tid; i < 2048; i += NTHREADS) posl[i] = pe[i];
                __syncthreads();
                const float* wp = w1 + (size_t)(256 * C.wave) * 256 + n; const LAS float* pp = posl + 256 * C.wave;
#pragma unroll 16
                for (int k = 0; k < 256; ++k) acc += pp[k] * wp[(size_t)k * 256];
            }
            part[C.wave * 64 + C.lane] = acc;
            __syncthreads();
            if (C.wave == 0) {
                float s = 0.f;
#pragma unroll
                for (int w = 0; w < 8; ++w) s += part[w * 64 + C.lane];
                if (tk < 384) { const int layer = tk / 192, cg = tk % 192, col = 32 * cg + (C.lane & 31), bb = C.lane >> 5;
                    ((float*)(ws + WS_MODV))[(size_t)(layer * 2 + bb) * 6144 + col] = s + C.mod_b[layer * 6144 + col]; }
                else { const int which = (tk - 384) >> 2, n = 64 * ((tk - 384) & 3) + C.lane; ((float*)(ws + WS_CB1))[which * 256 + n] = s; }
            }
            __syncthreads();
        }
    }
    LAS float* scr = (LAS float*)(C.lds + C.wave * 16384);
    const int gw = C.vcu * NWAVES + C.wave, NGW = C.G * NWAVES;
    constexpr int NITEMS = tj_items(D, 1280) + tj_items(D, 1536) + tj_items(D, 24) + tj_items(D, D) + 2 * tj_items(D, DFF) + tj_items(DFF, D) + tj_items(D, 3072) + tj_items(D, D) + 2 * tj_items(D, DFF) + tj_items(DFF, D)
        + 2 * tj_items(2048, 256) + 2 * tj_items(256, 64);
    __syncthreads();
    for (int it = gw; it < NITEMS; it += NGW) {
        int r = it;
#define TJ(Wp, K_, N_, c0_, w_, WT_, r0_) { constexpr int cnt_ = tj_items(K_, w_); if (r < cnt_) { p0_transpose_item(Wp, K_, N_, c0_, w_, (bf16*)(WT_), r0_, scr, r, C.lane); continue; } r -= cnt_; }
        TJ(C.hyb_w_in, D, 2840, 0, 1280, ws + WS_WIN0, 0)
        TJ(C.hyb_w_in, D, 2840, 1304, 1536, ws + WS_WIN0, 1280)
        TJ(C.hyb_w_in, D, 2840, 1280, 24, ws + WS_WIN0, 2816)
        TJ(C.hyb_w_out, D, D, 0, D, ws + WS_WOUT0, 0)
        TJ(C.w_gate, D, DFF, 0, DFF, ws + WS_WG0, 0)
        TJ(C.w_up, D, DFF, 0, DFF, ws + WS_WU0, 0)
        TJ(C.w_down, DFF, D, 0, D, ws + WS_WD0, 0)
        TJ(C.diff_w_qkv, D, 3072, 0, 3072, ws + WS_WQKV1, 0)
        TJ(C.diff_w_out, D, D, 0, D, ws + WS_WOUT1, 0)
        TJ(C.w_gate + (size_t)D * DFF, D, DFF, 0, DFF, ws + WS_WG1, 0)
        TJ(C.w_up + (size_t)D * DFF, D, DFF, 0, DFF, ws + WS_WU1, 0)
        TJ(C.w_down + (size_t)D * DFF, DFF, D, 0, D, ws + WS_WD1, 0)
        TJ(C.ck_w1, 2048, 256, 0, 256, ws + WS_CW1T, 0)
        TJ(C.cv_w1, 2048, 256, 0, 256, ws + WS_CW1T + 1 * MiB, 0)
        TJ(C.ck_w2, 256, 64, 0, 64, ws + WS_CW2T, 0)
        TJ(C.cv_w2, 256, 64, 0, 64, ws + WS_CW2T + 32 * KiB, 0)
#undef TJ
    }
    { GAS v4u* z = (GAS v4u*)(ws + WS_WIN0 + (size_t)2840 * D * 2); const int n16 = (3072 - 2840) * D * 2 / 16;
      for (int i = C.vcu * NTHREADS + C.tid; i < n16; i += C.G * NTHREADS) z[i] = (v4u){0u, 0u, 0u, 0u}; }
    { float* cs = (float*)(ws + WS_CS);
      for (int e = C.vcu * NTHREADS + C.tid; e < M * 8; e += C.G * NTHREADS) {
          const int m = e >> 3, i = e & 7;
          const double inv = (i == 0) ? 1.0 : (i == 1) ? 0.19392274474868576 : (i == 2) ? 0.03760603093086393 : (i == 3) ? 0.007292664737217109 : (i == 4) ? 0.001414213562373095 : (i == 5) ? 0.0002742481756762073
                              : (i == 6) ? 5.318295896944988e-05 : 1.031338537721246e-05;
          const double rev = (double)C.positions[m] * inv * 0.15915494309189535; const float fr = (float)(rev - floor(rev));
          cs[(size_t)m * 16 + i] = __builtin_amdgcn_cosf(fr); cs[(size_t)m * 16 + 8 + i] = __builtin_amdgcn_sinf(fr); } }
}

__device__ __forceinline__ void norm_mod_rows(const Ctx& C, const float* X, const float* gain, const float* shv, const float* scv, bf16* XN) {
    const int gw = C.vcu * NWAVES + C.wave, NGW = C.G * NWAVES;
    for (int m = gw; m < M; m += NGW) {
        const int b = m >> 13; const GAS f32x4* xr = (const GAS f32x4*)(X + (size_t)m * D) + C.lane;
        f32x4 v[4]; float s = 0.f;
#pragma unroll
        for (int j = 0; j < 4; ++j) { v[j] = xr[64 * j]; s += (v[j].x * v[j].x + v[j].y * v[j].y) + (v[j].z * v[j].z + v[j].w * v[j].w); }
        const float rs = 1.0f / sqrtf(wave_sum(s) * (1.f / D) + RMS_EPS);
        GAS unsigned long long* o8 = (GAS unsigned long long*)(XN + (size_t)m * D) + C.lane;
#pragma unroll
        for (int j = 0; j < 4; ++j) { const int col = 4 * (64 * j + C.lane);
            const f32x4 g4 = *(const GAS f32x4*)(gain + col), sh4 = *(const GAS f32x4*)(shv + (size_t)b * 6144 + col), sc4 = *(const GAS f32x4*)(scv + (size_t)b * 6144 + col);
            const f32x4 h = v[j] * rs * g4 * (sc4 + 1.0f) + sh4;
            o8[64 * j] = (unsigned long long)pk2(h.x, h.y) | ((unsigned long long)pk2(h.z, h.w) << 32); }
    }
}
__device__ __forceinline__ void final_norm_rows(const Ctx& C, float* X, const float* gain) {
    const int gw = C.vcu * NWAVES + C.wave, NGW = C.G * NWAVES;
    for (int m = gw; m < M; m += NGW) {
        GAS f32x4* xr = (GAS f32x4*)(X + (size_t)m * D) + C.lane;
        f32x4 v[4]; float s = 0.f;
#pragma unroll
        for (int j = 0; j < 4; ++j) { v[j] = xr[64 * j]; s += (v[j].x * v[j].x + v[j].y * v[j].y) + (v[j].z * v[j].z + v[j].w * v[j].w); }
        const float rs = 1.0f / sqrtf(wave_sum(s) * (1.f / D) + RMS_EPS);
#pragma unroll
        for (int j = 0; j < 4; ++j) { const f32x4 g4 = *(const GAS f32x4*)(gain + 4 * (64 * j + C.lane)); xr[64 * j] = v[j] * rs * g4; }
    }
}
__device__ __forceinline__ void diff_combine_rows(const Ctx& C, const bf16* O1, const bf16* O2, bf16* OC) {
    const int gw = C.vcu * NWAVES + C.wave, NGW = C.G * NWAVES;
    const float lam = __expf(wave_sum(C.lq1[C.lane] * C.lk1[C.lane])) - __expf(wave_sum(C.lq2[C.lane] * C.lk2[C.lane])) + LAMBDA_INIT;
    float sl[16];
#pragma unroll
    for (int i = 0; i < 16; ++i) sl[i] = C.subln[(16 * C.lane + i) & 127] * (1.0f - LAMBDA_INIT);
    for (int m = gw; m < M; m += NGW) {
        const GAS v4u* p1 = (const GAS v4u*)(O1 + (size_t)m * D + 16 * C.lane); const GAS v4u* p2 = (const GAS v4u*)(O2 + (size_t)m * D + 16 * C.lane);
        float o[16]; float ss = 0.f;
#pragma unroll
        for (int h = 0; h < 2; ++h) { const v4u a = p1[h], bq = p2[h];
#pragma unroll
            for (int e = 0; e < 4; ++e) { const unsigned ua = e == 0 ? a.x : e == 1 ? a.y : e == 2 ? a.z : a.w, ub = e == 0 ? bq.x : e == 1 ? bq.y : e == 2 ? bq.z : bq.w;
                o[8 * h + 2 * e] = __uint_as_float(ua << 16) - lam * __uint_as_float(ub << 16); o[8 * h + 2 * e + 1] = __uint_as_float(ua & 0xffff0000u) - lam * __uint_as_float(ub & 0xffff0000u); } }
#pragma unroll
        for (int i = 0; i < 16; ++i) ss += o[i] * o[i];
        ss += __shfl_xor(ss, 1); ss += __shfl_xor(ss, 2); ss += __shfl_xor(ss, 4);
        const float rs = 1.0f / sqrtf(ss * (1.f / 128.f) + RMS_EPS);
        v4u w0, w1;
        w0.x = pk2(o[0] * rs * sl[0], o[1] * rs * sl[1]); w0.y = pk2(o[2] * rs * sl[2], o[3] * rs * sl[3]); w0.z = pk2(o[4] * rs * sl[4], o[5] * rs * sl[5]); w0.w = pk2(o[6] * rs * sl[6], o[7] * rs * sl[7]);
        w1.x = pk2(o[8] * rs * sl[8], o[9] * rs * sl[9]); w1.y = pk2(o[10] * rs * sl[10], o[11] * rs * sl[11]); w1.z = pk2(o[12] * rs * sl[12], o[13] * rs * sl[13]); w1.w = pk2(o[14] * rs * sl[14], o[15] * rs * sl[15]);
        GAS v4u* q = (GAS v4u*)(OC + (size_t)m * D + 16 * C.lane); q[0] = w0; q[1] = w1;
    }
}

__device__ __forceinline__ void compress_unit(const Ctx& C, int unit) {
    typedef float f32x16 __attribute__((ext_vector_type(16)));
    const int which = unit >> 6, b = (unit >> 5) & 1, g = (unit >> 4) & 1, cb = unit & 15;
    const int lane = C.lane, n = lane & 31, hi = lane >> 5, w = C.wave;
    const bf16* PR = (const bf16*)(C.ws + WS_PR); const bf16* W1T = (const bf16*)(C.ws + WS_CW1T + (size_t)which * MiB); const bf16* W2T = (const bf16*)(C.ws + WS_CW2T + (size_t)which * 32 * KiB);
    const float* cb1 = (const float*)(C.ws + WS_CB1) + which * 256;
    LAS bf16* H = (LAS bf16*)C.lds;
    int c = 32 * cb + n; if (c > 510) c = 510;
    const bf16* ap = PR + ((size_t)(b * T + 16 * c)) * NPROJ + (which ? C_VC : C_KC) + g * 64 + 8 * hi;
    const bf16* bp = W1T + (size_t)(32 * w + n) * 2048 + 8 * hi;
    f32x16 acc = {};
#pragma unroll 4
    for (int ks = 0; ks < 128; ++ks) {
        const bf16x8 a = *(const GAS bf16x8*)(ap + (size_t)(ks >> 2) * NPROJ + (ks & 3) * 16);
        const bf16x8 bb = *(const GAS bf16x8*)(bp + ks * 16);
        acc = __builtin_amdgcn_mfma_f32_32x32x16_bf16(a, bb, acc, 0, 0, 0);
    }
    { const float bias = cb1[32 * w + n];
#pragma unroll
      for (int r = 0; r < 16; ++r) { const int row = (r & 3) + 8 * (r >> 2) + 4 * hi; float v = acc[r] + bias; v = v / (1.f + __expf(-v)); H[row * 256 + 32 * w + n] = (bf16)f2bf(v); } }
    __syncthreads();
    if (w < 2) {
        f32x16 a2 = {};
#pragma unroll
        for (int ks = 0; ks < 16; ++ks) {
            const bf16x8 a = *(const LAS bf16x8*)(H + n * 256 + ks * 16 + 8 * hi);
            const bf16x8 bb = *(const GAS bf16x8*)(W2T + (size_t)(32 * w + n) * 256 + ks * 16 + 8 * hi);
            a2 = __builtin_amdgcn_mfma_f32_32x32x16_bf16(a, bb, a2, 0, 0, 0);
        }
        bf16* OUT = (bf16*)(C.ws + (which ? WS_VCMP : WS_KCMP)) + (size_t)((b * 2 + g) * 512) * 64;
        const float* cs = (const float*)(C.ws + WS_CS);
#pragma unroll
        for (int r = 0; r < 16; ++r) {
            const int row = (r & 3) + 8 * (r >> 2) + 4 * hi, cc = 32 * cb + row;
            float v = a2[r];
            if (which == 0 && w == 0) {
                const float pv = __shfl_xor(v, 8);
                if (n < 16) { const int cq = cc > 510 ? 510 : cc; const float* t = cs + ((size_t)(b * T + 16 * cq + 31)) * 16; const float co = t[n & 7], si = t[8 + (n & 7)];
                    v = (n < 8) ? (v * co - pv * si) : (v * co + pv * si); }
            }
            if (cc > 510) v = 0.f;
            OUT[(size_t)cc * 64 + 32 * w + n] = (bf16)f2bf(v);
        }
    }
    __syncthreads();
}

__device__ __forceinline__ void score4(const unsigned (&q)[4][32], const bf16* kp, float& s0, float& s1, float& s2, float& s3) {
    s0 = s1 = s2 = s3 = 0.f;
#pragma unroll
    for (int cch = 0; cch < 8; ++cch) { const v4u kv = ((const GAS v4u*)kp)[cch];
#pragma unroll
        for (int e = 0; e < 4; ++e) { const unsigned kw = e == 0 ? kv.x : e == 1 ? kv.y : e == 2 ? kv.z : kv.w;
            s0 = dot2(kw, q[0][4 * cch + e], s0); s1 = dot2(kw, q[1][4 * cch + e], s1); s2 = dot2(kw, q[2][4 * cch + e], s2); s3 = dot2(kw, q[3][4 * cch + e], s3); } }
}
__device__ __forceinline__ void nsa_query(const Ctx& C, int b, int t, int g, LAS unsigned char* wl) {
    const int lane = C.lane; const bf16* PR = (const bf16*)(C.ws + WS_PR); const size_t row = (size_t)b * T + t;
    LAS f32x4* sc = (LAS f32x4*)wl; LAS unsigned* qd = (LAS unsigned*)(wl + 16384);
    { const GAS unsigned* qsrc = (const GAS unsigned*)(PR + row * NPROJ + C_QN + g * 256); qd[lane] = qsrc[lane]; qd[lane + 64] = qsrc[lane + 64]; }
    CFENCE();
    unsigned q[4][32];
#pragma unroll
    for (int h = 0; h < 4; ++h)
#pragma unroll
        for (int i = 0; i < 8; ++i) { const v4u tq = ((const LAS v4u*)qd)[h * 8 + i]; q[h][4 * i] = tq.x; q[h][4 * i + 1] = tq.y; q[h][4 * i + 2] = tq.z; q[h][4 * i + 3] = tq.w; }
    float gate; { float glv = 0.f; if (lane < 12) glv = bf2f(PR[row * NPROJ + C_GL + g * 12 + lane]); gate = 1.f / (1.f + __expf(-glv)); }
    float oacc[4] = {0.f, 0.f, 0.f, 0.f};
    const int cur = t >> 6;
    const int nvalid = (t >= 31) ? (((t - 31) >> 4) + 1) : 0;
    float imp0 = 0.f, imp1 = 0.f;
    if (nvalid > 0) {
        const bf16* KC = (const bf16*)(C.ws + WS_KCMP) + (size_t)((b * 2 + g) * 512) * 64; const bf16* VC = (const bf16*)(C.ws + WS_VCMP) + (size_t)((b * 2 + g) * 512) * 64;
        float m0 = -1e30f, m1 = -1e30f, m2 = -1e30f, m3 = -1e30f;
        for (int cc = lane; cc < nvalid; cc += 64) { float s0, s1, s2, s3; score4(q, KC + (size_t)cc * 64, s0, s1, s2, s3); sc[cc] = (f32x4){s0, s1, s2, s3}; m0 = fmaxf(m0, s0); m1 = fmaxf(m1, s1); m2 = fmaxf(m2, s2); m3 = fmaxf(m3, s3); }
        m0 = wave_max(m0); m1 = wave_max(m1); m2 = wave_max(m2); m3 = wave_max(m3);
        float l0 = 0.f, l1 = 0.f, l2 = 0.f, l3 = 0.f;
        for (int cc = lane; cc < nvalid; cc += 64) { f32x4 s = sc[cc]; s.x = __builtin_amdgcn_exp2f(s.x - m0); s.y = __builtin_amdgcn_exp2f(s.y - m1); s.z = __builtin_amdgcn_exp2f(s.z - m2); s.w = __builtin_amdgcn_exp2f(s.w - m3); sc[cc] = s; l0 += s.x; l1 += s.y; l2 += s.z; l3 += s.w; }
        const float i0 = 1.f / wave_sum(l0), i1 = 1.f / wave_sum(l1), i2 = 1.f / wave_sum(l2), i3 = 1.f / wave_sum(l3);
        CFENCE();
#pragma unroll
        for (int half = 0; half < 2; ++half) { const int nb = lane + 64 * half; float a = 0.f;
            for (int cc = 4 * nb - 1; cc <= 4 * nb + 3; ++cc) if (cc >= 0 && cc < nvalid) { const f32x4 p = sc[cc]; a += p.x * i0 + p.y * i1 + p.z * i2 + p.w * i3; }
            if (half == 0) imp0 = a; else imp1 = a; }
        float a0 = 0.f, a1 = 0.f, a2 = 0.f, a3 = 0.f;
        for (int cc = 0; cc < nvalid; ++cc) { const f32x4 p = sc[cc]; const float v = bf2f(VC[(size_t)cc * 64 + lane]); a0 += p.x * v; a1 += p.y * v; a2 += p.z * v; a3 += p.w * v; }
        oacc[0] += __shfl(gate, 0) * a0 * i0; oacc[1] += __shfl(gate, 3) * a1 * i1; oacc[2] += __shfl(gate, 6) * a2 * i2; oacc[3] += __shfl(gate, 9) * a3 * i3;
        CFENCE();
    }
    int sel[16];
    {
        float v0, v1;
        { const int nb = lane; const bool forced = (nb == 0) || (nb == cur) || (nb == cur - 1); v0 = forced ? 1e9f : (nb <= cur ? imp0 : -1e9f); }
        { const int nb = lane + 64; const bool forced = (nb == cur) || (nb == cur - 1); v1 = forced ? 1e9f : (nb <= cur ? imp1 : -1e9f); }
#pragma unroll
        for (int i = 0; i < 16; ++i) {
            float bv; int bi; if (v0 >= v1) { bv = v0; bi = lane; } else { bv = v1; bi = lane + 64; }
#pragma unroll
            for (int off = 32; off >= 1; off >>= 1) { const float ov = __shfl_xor(bv, off); const int oi = __shfl_xor(bi, off); if (ov > bv || (ov == bv && oi < bi)) { bv = ov; bi = oi; } }
            sel[i] = bi; if (bi == lane) v0 = -3e38f; if (bi == lane + 64) v1 = -3e38f;
        }
    }
    {
        float m0 = -1e30f, m1 = -1e30f, m2 = -1e30f, m3 = -1e30f;
#pragma unroll
        for (int i = 0; i < 16; ++i) {
            const int blk = __builtin_amdgcn_readfirstlane(sel[i]);
            if (blk <= cur) { const int tok = blk * 64 + lane; float s0, s1, s2, s3; score4(q, PR + ((size_t)b * T + tok) * NPROJ + C_KS + g * 64, s0, s1, s2, s3);
                if (tok <= t) { m0 = fmaxf(m0, s0); m1 = fmaxf(m1, s1); m2 = fmaxf(m2, s2); m3 = fmaxf(m3, s3); } else { s0 = s1 = s2 = s3 = -1e30f; }
                sc[i * 64 + lane] = (f32x4){s0, s1, s2, s3}; }
        }
        m0 = wave_max(m0); m1 = wave_max(m1); m2 = wave_max(m2); m3 = wave_max(m3);
        float l0 = 0.f, l1 = 0.f, l2 = 0.f, l3 = 0.f;
#pragma unroll
        for (int i = 0; i < 16; ++i) {
            const int blk = __builtin_amdgcn_readfirstlane(sel[i]);
            if (blk <= cur) { f32x4 s = sc[i * 64 + lane]; const bool ok = (blk * 64 + lane) <= t;
                s.x = ok ? __builtin_amdgcn_exp2f(s.x - m0) : 0.f; s.y = ok ? __builtin_amdgcn_exp2f(s.y - m1) : 0.f; s.z = ok ? __builtin_amdgcn_exp2f(s.z - m2) : 0.f; s.w = ok ? __builtin_amdgcn_exp2f(s.w - m3) : 0.f;
                sc[i * 64 + lane] = s; l0 += s.x; l1 += s.y; l2 += s.z; l3 += s.w; }
        }
        const float i0 = 1.f / wave_sum(l0), i1 = 1.f / wave_sum(l1), i2 = 1.f / wave_sum(l2), i3 = 1.f / wave_sum(l3);
        CFENCE();
        float a0 = 0.f, a1 = 0.f, a2 = 0.f, a3 = 0.f;
#pragma unroll
        for (int i = 0; i < 16; ++i) {
            const int blk = __builtin_amdgcn_readfirstlane(sel[i]);
            if (blk <= cur) { int nj = t - blk * 64 + 1; if (nj > 64) nj = 64; const bf16* vp = PR + ((size_t)b * T + blk * 64) * NPROJ + C_VS + g * 64 + lane;
                for (int j = 0; j < nj; ++j) { const f32x4 p = sc[i * 64 + j]; const float v = bf2f(vp[(size_t)j * NPROJ]); a0 += p.x * v; a1 += p.y * v; a2 += p.z * v; a3 += p.w * v; } }
        }
        oacc[0] += __shfl(gate, 1) * a0 * i0; oacc[1] += __shfl(gate, 4) * a1 * i1; oacc[2] += __shfl(gate, 7) * a2 * i2; oacc[3] += __shfl(gate, 10) * a3 * i3;
        CFENCE();
    }
    {
        float m0 = -1e30f, m1 = -1e30f, m2 = -1e30f, m3 = -1e30f;
#pragma unroll
        for (int i = 0; i < 8; ++i) { const int j = lane + 64 * i, kp = t - 511 + j;
            float s0 = -1e30f, s1 = -1e30f, s2 = -1e30f, s3 = -1e30f;
            if (kp >= 0) { score4(q, PR + ((size_t)b * T + kp) * NPROJ + C_KW + g * 64, s0, s1, s2, s3); m0 = fmaxf(m0, s0); m1 = fmaxf(m1, s1); m2 = fmaxf(m2, s2); m3 = fmaxf(m3, s3); }
            sc[j] = (f32x4){s0, s1, s2, s3}; }
        m0 = wave_max(m0); m1 = wave_max(m1); m2 = wave_max(m2); m3 = wave_max(m3);
        float l0 = 0.f, l1 = 0.f, l2 = 0.f, l3 = 0.f;
#pragma unroll
        for (int i = 0; i < 8; ++i) { const int j = lane + 64 * i; const bool ok = (t - 511 + j) >= 0; f32x4 s = sc[j];
            s.x = ok ? __builtin_amdgcn_exp2f(s.x - m0) : 0.f; s.y = ok ? __builtin_amdgcn_exp2f(s.y - m1) : 0.f; s.z = ok ? __builtin_amdgcn_exp2f(s.z - m2) : 0.f; s.w = ok ? __builtin_amdgcn_exp2f(s.w - m3) : 0.f;
            sc[j] = s; l0 += s.x; l1 += s.y; l2 += s.z; l3 += s.w; }
        const float i0 = 1.f / wave_sum(l0), i1 = 1.f / wave_sum(l1), i2 = 1.f / wave_sum(l2), i3 = 1.f / wave_sum(l3);
        CFENCE();
        float a0 = 0.f, a1 = 0.f, a2 = 0.f, a3 = 0.f;
        const int j0 = (t >= 511) ? 0 : (511 - t); const bf16* vp = PR + ((size_t)b * T + (t - 511)) * NPROJ + C_VW + g * 64 + lane;
        for (int j = j0; j < 512; ++j) { const f32x4 p = sc[j]; const float v = bf2f(vp[(ptrdiff_t)j * NPROJ]); a0 += p.x * v; a1 += p.y * v; a2 += p.z * v; a3 += p.w * v; }
        oacc[0] += __shfl(gate, 2) * a0 * i0; oacc[1] += __shfl(gate, 5) * a1 * i1; oacc[2] += __shfl(gate, 8) * a2 * i2; oacc[3] += __shfl(gate, 11) * a3 * i3;
        CFENCE();
    }
    bf16* OC = (bf16*)(C.ws + WS_OCAT) + row * D + g * 256 + lane;
#pragma unroll
    for (int h = 0; h < 4; ++h) OC[h * 64] = (bf16)f2bf(oacc[h]);
}
__device__ __forceinline__ void sb_query(const Ctx& C, int b, int t, int h, LAS unsigned char* wl) {
    const int lane = C.lane; const bf16* PR = (const bf16*)(C.ws + WS_PR); const size_t row = (size_t)b * T + t;
    LAS float* ab = (LAS float*)wl; LAS unsigned* qd = (LAS unsigned*)(wl + 16384);
    { const GAS unsigned* qsrc = (const GAS unsigned*)(PR + row * NPROJ + C_QS + h * 64); if (lane < 32) qd[lane] = qsrc[lane]; }
    CFENCE();
    unsigned q[32];
#pragma unroll
    for (int i = 0; i < 8; ++i) { const v4u tq = ((const LAS v4u*)qd)[i]; q[4 * i] = tq.x; q[4 * i + 1] = tq.y; q[4 * i + 2] = tq.z; q[4 * i + 3] = tq.w; }
    float o = 0.f, carry = 0.f;
    for (int base = t - 1; base >= 0; base -= 64) {
        const int key = base - lane; const bool valid = key >= 0; const int kc = valid ? key : 0;
        const bf16* kp = PR + ((size_t)b * T + kc) * NPROJ + C_KSB + h * 64;
        float z = 0.f;
#pragma unroll
        for (int cch = 0; cch < 8; ++cch) { const v4u kv = ((const GAS v4u*)kp)[cch]; z = dot2(kv.x, q[4 * cch], z); z = dot2(kv.y, q[4 * cch + 1], z); z = dot2(kv.z, q[4 * cch + 2], z); z = dot2(kv.w, q[4 * cch + 3], z); }
        const float L = __builtin_amdgcn_logf(1.f + __builtin_amdgcn_exp2f(-fabsf(z)));
        const float lk = valid ? -(fmaxf(z, 0.f) + L) : 0.f;
        const float ls = fminf(z, 0.f) - L;
        float inc = lk;
#pragma unroll
        for (int d = 1; d < 64; d <<= 1) { const float tv = __shfl_up(inc, d); if (lane >= d) inc += tv; }
        const float a = valid ? __builtin_amdgcn_exp2f(ls + carry + (inc - lk)) : 0.f;
        CFENCE(); ab[lane] = a; CFENCE();
        const int nv = (base + 1 < 64) ? (base + 1) : 64; const bf16* vp = PR + ((size_t)b * T + base) * NPROJ + C_VSB + h * 64 + lane;
        for (int j = 0; j < nv; ++j) o += ab[j] * bf2f(vp[-(ptrdiff_t)j * NPROJ]);
        carry += __shfl(inc, 63);
        if (carry < -60.f) break;
    }
    ((bf16*)(C.ws + WS_OCAT))[row * D + 512 + h * 64 + lane] = (bf16)f2bf(o);
}
__device__ __forceinline__ void hybrid_attention_phase(const Ctx& C) {
    LAS unsigned char* wl = C.lds + C.wave * WAVE_LDS;
    const int gw = C.vcu * NWAVES + C.wave, NGW = C.G * NWAVES;
    for (int tk = gw; tk < BATCH * 2 * T; tk += NGW) { const int t = tk & (T - 1), g = (tk >> 13) & 1, b = tk >> 14; nsa_query(C, b, t, g, wl); }
    for (int tk = gw; tk < BATCH * 8 * T; tk += NGW) { const int t = tk & (T - 1), h = (tk >> 13) & 7, b = tk >> 16; sb_query(C, b, t, h, wl); }
}
#ifndef PH_MASK
#define PH_MASK 0xFFFFFFu
#endif
struct Args { const void* in[28]; float* out; unsigned char* ws; int ph_lo, ph_hi; };
enum Phase { P_PROLOG = 0, P_NORM0A, P_INPROJ, P_CMP, P_ATT0, P_OUT0, P_NORM0B, P_GATE0, P_UP0, P_DOWN0, P_NORM1A, P_QKV1, P_ATT1, P_COMB1, P_OUT1, P_NORM1B, P_GATE1, P_UP1, P_DOWN1, P_FINAL, N_PHASES };

__global__ void __launch_bounds__(NTHREADS, 2) mega_fwd(Args args) {
    extern __shared__ __attribute__((aligned(16))) unsigned char lds[];
    Ctx C;
    C.lds = (LAS unsigned char*)lds; C.tid = threadIdx.x; C.lane = C.tid & 63; C.wave = __builtin_amdgcn_readfirstlane(C.tid >> 6);
    C.G = gridDim.x; { const int bx = blockIdx.x; C.vcu = (C.G % 8 == 0) ? (bx % 8) * (C.G / 8) + bx / 8 : bx; }
    C.x = (const float*)args.in[0]; C.c = (const float*)args.in[1]; C.positions = (const int*)args.in[2]; C.mod_w = (const float*)args.in[3]; C.mod_b = (const float*)args.in[4];
    C.norm_mix = (const float*)args.in[5]; C.norm_ffn = (const float*)args.in[6]; C.w_gate = (const float*)args.in[7]; C.w_up = (const float*)args.in[8]; C.conv_w = (const float*)args.in[9];
    C.conv_b = (const float*)args.in[10]; C.w_down = (const float*)args.in[11]; C.hyb_w_in = (const float*)args.in[12]; C.pos_k = (const float*)args.in[13]; C.pos_v = (const float*)args.in[14];
    C.ck_w1 = (const float*)args.in[15]; C.ck_w2 = (const float*)args.in[16]; C.cv_w1 = (const float*)args.in[17]; C.cv_w2 = (const float*)args.in[18]; C.hyb_w_out = (const float*)args.in[19];
    C.diff_w_qkv = (const float*)args.in[20]; C.lq1 = (const float*)args.in[21]; C.lk1 = (const float*)args.in[22]; C.lq2 = (const float*)args.in[23]; C.lk2 = (const float*)args.in[24];
    C.subln = (const float*)args.in[25]; C.diff_w_out = (const float*)args.in[26]; C.norm_f = (const float*)args.in[27];
    C.out = args.out; C.ws = args.ws;
    unsigned char* ws = args.ws;
    volatile LAS unsigned* MISC = (volatile LAS unsigned*)(C.lds + MISC_OFF);
    for (int u = C.tid; u < 64; u += NTHREADS) MISC[u] = 0u;
    __syncthreads();
    const int lo = args.ph_lo, hi = args.ph_hi;
    const bool one_launch = (hi - lo) > 1;
    XcdBarrier bar; bar.bar = (unsigned*)(ws + WS_CTL) + CW_BAR; bar.x = 0; bar.st = nullptr;
    if (one_launch) bar = xcd_barrier_post((unsigned*)(ws + WS_CTL) + CW_BAR, MISC + 8);
#define IN(k) (((PH_MASK >> (k)) & 1u) && lo <= (k) && (k) < hi)
#define SEAM(k) do { if (IN(k) && IN((k) + 1)) xcd_barrier(bar); } while (0)
    const float* MODV = (const float*)(ws + WS_MODV);
    const float* CS = (const float*)(ws + WS_CS);
    bf16* XN = (bf16*)(ws + WS_XN);

    if (IN(P_PROLOG)) { p0_prologue(C); } SEAM(P_PROLOG);
    if (IN(P_NORM0A)) { norm_mod_rows(C, C.x, C.norm_mix, MODV + 0, MODV + 1024, XN); } SEAM(P_NORM0A);
    if (IN(P_INPROJ)) {
        pg8::Gemm g{XN, (const bf16*)(ws + WS_WIN0), M, NPROJ, D}; pg8::StaticOrder S; S.init(M, NPROJ, C.G, (int)blockIdx.x);
        pg8::EpiProj E{(bf16*)(ws + WS_PR), NPROJ, CS, 0xFu | (1u << 6) | (1u << 8), 0xFu | (0xFu << 10), QSCALE};
        pg8::gemm_phase<pg8::EpiProj, pg8::StaticOrder, true, true>(C.lds, g, S, E);
    } SEAM(P_INPROJ);
    if (IN(P_CMP)) { for (int u = blockIdx.x; u < 128; u += C.G) compress_unit(C, u); } SEAM(P_CMP);
    if (IN(P_ATT0)) { hybrid_attention_phase(C); } SEAM(P_ATT0);
    if (IN(P_OUT0)) {
        pg8::Gemm g{(const bf16*)(ws + WS_OCAT), (const bf16*)(ws + WS_WOUT0), M, D, D}; pg8::StaticOrder S; S.init(M, D, C.G, (int)blockIdx.x);
        pg8::EpiRes E{C.x, C.out, D, MODV + 2048, 6144};
        pg8::gemm_phase<pg8::EpiRes, pg8::StaticOrder, true, true>(C.lds, g, S, E);
    } SEAM(P_OUT0);
    if (IN(P_NORM0B)) { norm_mod_rows(C, C.out, C.norm_ffn, MODV + 3072, MODV + 4096, XN); } SEAM(P_NORM0B);
    if (IN(P_GATE0)) {
        pg8::Gemm g{XN, (const bf16*)(ws + WS_WG0), M, DFF, D}; pg8::StaticOrder S; S.init(M, DFF, C.G, (int)blockIdx.x);
        pg8::EpiProj E{(bf16*)(ws + WS_G), DFF, CS, 0u, 0u, 1.f};
        pg8::gemm_phase<pg8::EpiProj, pg8::StaticOrder, true, true>(C.lds, g, S, E);
    } SEAM(P_GATE0);
    if (IN(P_UP0)) {
        pg8::Gemm g{XN, (const bf16*)(ws + WS_WU0), M, DFF, D}; pg8::StaticOrder S; S.init(M, DFF, C.G, (int)blockIdx.x);
        pg8::EpiAct E{(bf16*)(ws + WS_ACT), (const bf16*)(ws + WS_G), DFF, C.conv_w, C.conv_b};
        pg8::gemm_phase<pg8::EpiAct, pg8::StaticOrder, true, true>(C.lds, g, S, E);
    } SEAM(P_UP0);
    if (IN(P_DOWN0)) {
        pg8::Gemm g{(const bf16*)(ws + WS_ACT), (const bf16*)(ws + WS_WD0), M, D, DFF}; pg8::StaticOrder S; S.init(M, D, C.G, (int)blockIdx.x);
        pg8::EpiRes E{C.out, C.out, D, MODV + 5120, 6144};
        pg8::gemm_phase<pg8::EpiRes, pg8::StaticOrder, true, true>(C.lds, g, S, E);
    } SEAM(P_DOWN0);
    const float* MODV1 = MODV + 2 * 6144;
    if (IN(P_NORM1A)) { norm_mod_rows(C, C.out, C.norm_mix + D, MODV1 + 0, MODV1 + 1024, XN); } SEAM(P_NORM1A);
    if (IN(P_QKV1)) {
        pg8::Gemm g{XN, (const bf16*)(ws + WS_WQKV1), M, NPROJ, D}; pg8::StaticOrder S; S.init(M, NPROJ, C.G, (int)blockIdx.x);
        pg8::EpiProj E{(bf16*)(ws + WS_PR1), NPROJ, CS, 0xFFFFu, 0xFFu, QSCALE};
        pg8::gemm_phase<pg8::EpiProj, pg8::StaticOrder, true, true>(C.lds, g, S, E);
    } SEAM(P_QKV1);
    if (IN(P_ATT1)) { const attn_body::StaticOrder S(C.vcu); attn_body::diff_attn_phase<NPROJ, D>((char*)lds, (const attn_body::bf16*)(ws + WS_PR1), (attn_body::bf16*)(ws + WS_O1), (attn_body::bf16*)(ws + WS_O2), S); } SEAM(P_ATT1);
    if (IN(P_COMB1)) { diff_combine_rows(C, (const bf16*)(ws + WS_O1), (const bf16*)(ws + WS_O2), XN); } SEAM(P_COMB1);
    if (IN(P_OUT1)) {
        pg8::Gemm g{XN, (const bf16*)(ws + WS_WOUT1), M, D, D}; pg8::StaticOrder S; S.init(M, D, C.G, (int)blockIdx.x);
        pg8::EpiRes E{C.out, C.out, D, MODV1 + 2048, 6144};
        pg8::gemm_phase<pg8::EpiRes, pg8::StaticOrder, true, true>(C.lds, g, S, E);
    } SEAM(P_OUT1);
    if (IN(P_NORM1B)) { norm_mod_rows(C, C.out, C.norm_ffn + D, MODV1 + 3072, MODV1 + 4096, XN); } SEAM(P_NORM1B);
    if (IN(P_GATE1)) {
        pg8::Gemm g{XN, (const bf16*)(ws + WS_WG1), M, DFF, D}; pg8::StaticOrder S; S.init(M, DFF, C.G, (int)blockIdx.x);
        pg8::EpiProj E{(bf16*)(ws + WS_G), DFF, CS, 0u, 0u, 1.f};
        pg8::gemm_phase<pg8::EpiProj, pg8::StaticOrder, true, true>(C.lds, g, S, E);
    } SEAM(P_GATE1);
    if (IN(P_UP1)) {
        pg8::Gemm g{XN, (const bf16*)(ws + WS_WU1), M, DFF, D}; pg8::StaticOrder S; S.init(M, DFF, C.G, (int)blockIdx.x);
        pg8::EpiAct E{(bf16*)(ws + WS_ACT), (const bf16*)(ws + WS_G), DFF, C.conv_w + 3 * DFF, C.conv_b + DFF};
        pg8::gemm_phase<pg8::EpiAct, pg8::StaticOrder, true, true>(C.lds, g, S, E);
    } SEAM(P_UP1);
    if (IN(P_DOWN1)) {
        pg8::Gemm g{(const bf16*)(ws + WS_ACT), (const bf16*)(ws + WS_WD1), M, D, DFF}; pg8::StaticOrder S; S.init(M, D, C.G, (int)blockIdx.x);
        pg8::EpiRes E{C.out, C.out, D, MODV1 + 5120, 6144};
        pg8::gemm_phase<pg8::EpiRes, pg8::StaticOrder, true, true>(C.lds, g, S, E);
    } SEAM(P_DOWN1);
    if (IN(P_FINAL)) { final_norm_rows(C, C.out, C.norm_f); }
#undef IN
#undef SEAM
}

#ifndef MK_PER_PHASE
#define MK_PER_PHASE 1
#endif
extern "C" void kernel_launch(void* const* d_in, const int* in_sizes, int n_in, void* d_out, int out_size, void* d_ws, size_t ws_size, hipStream_t stream) {
    static int grid = 0;
    if (grid == 0) {
        if (n_in != 28 || in_sizes[0] != M * D || out_size != M * D || ws_size < WS_END) { fprintf(stderr, "kernel_launch: unexpected problem (n_in %d, in0 %d, out %d, ws %zu; need ws >= %zu); nothing launched\n", n_in, n_in > 0 ? in_sizes[0] : -1, out_size, ws_size, (size_t)WS_END); grid = -1; return; }
        int dev = 0, cus = 0, per_cu = 0;
        if (hipGetDevice(&dev) != hipSuccess || hipDeviceGetAttribute(&cus, hipDeviceAttributeMultiprocessorCount, dev) != hipSuccess) { fprintf(stderr, "kernel_launch: device query failed\n"); grid = -1; return; }
        if (hipFuncSetAttribute((const void*)mega_fwd, hipFuncAttributeMaxDynamicSharedMemorySize, LDS_BYTES) != hipSuccess) { fprintf(stderr, "kernel_launch: hipFuncSetAttribute failed\n"); grid = -1; return; }
        if (hipOccupancyMaxActiveBlocksPerMultiprocessor(&per_cu, (const void*)mega_fwd, NTHREADS, LDS_BYTES) != hipSuccess || per_cu < 1) { fprintf(stderr, "kernel_launch: occupancy query reports %d workgroups per CU\n", per_cu); per_cu = 1; }
        (void)hipGetLastError();
        grid = cus;
        if (grid % 8 != 0 || grid > 256) { grid = (grid > 256) ? 256 : (grid / 8) * 8; }
        fprintf(stderr, "kernel_launch: grid %d (cus %d, occupancy %d/CU)\n", grid, cus, per_cu);
    }
    if (grid <= 0) return;
    (void)hipMemsetAsync((char*)d_ws + WS_CTL, 0, CTL_ZERO_BYTES, stream);
    Args a{};
    for (int i = 0; i < 28; ++i) a.in[i] = d_in[i];
    a.out = (float*)d_out; a.ws = (unsigned char*)d_ws;
#if MK_PER_PHASE
    for (int p = 0; p < N_PHASES; ++p) { a.ph_lo = p; a.ph_hi = p + 1; hipLaunchKernelGGL(mega_fwd, dim3(grid), dim3(NTHREADS), LDS_BYTES, stream, a); }
#else
    a.ph_lo = 0; a.ph_hi = N_PHASES; hipLaunchKernelGGL(mega_fwd, dim3(grid), dim3(NTHREADS), LDS_BYTES, stream, a);
#endif
    const hipError_t le = hipPeekAtLastError();
    if (le != hipSuccess) fprintf(stderr, "kernel_launch: launch failed: %s\n", hipGetErrorName(le));
}
```

```cpp
#include <hip/hip_runtime.h>
#include <hip/hip_bf16.h>
#include <cstdio>
#include <cstdint>
#include <cmath>
namespace pg8 {
#define PG8_LAS __attribute__((address_space(3)))
typedef unsigned short bf16_t;
typedef short bf16x8 __attribute__((ext_vector_type(8)));
typedef float f32x4 __attribute__((ext_vector_type(4)));
typedef unsigned u32x4 __attribute__((ext_vector_type(4)));
constexpr int BM = 256, BK = 64, HALF = 128, HTB = HALF * BK * 2  , STAGE_BYTES = 8 * HTB, NXCD = 8, WGM = 8;

__host__ __device__ __forceinline__ int lds_byte(int r, int c) { const int st = (r >> 4) * 2 + (c >> 5), rr = r & 15, cc = c & 31, ob = rr * 64 + cc * 2; return st * 1024 + (ob ^ (((ob >> 9) & 1) << 5)); }
__host__ __device__ __forceinline__ void stage_rc(int b, int& R, int& C) { const int st = b / 1024, sb = b % 1024, swz = sb ^ (((sb >> 9) & 1) << 5); R = (st >> 1) * 16 + swz / 64; C = (st & 1) * 32 + (swz % 64) / 2; }
__host__ __device__ __forceinline__ int perm32(int rho) { const int n = rho >> 4, i = rho & 15; return 8 * (i >> 2) + 4 * n + (i & 3); }

struct Unit { int pm, pn; };
struct Gemm { const bf16_t* A; const bf16_t* Bt; int M, N, K; };

struct StaticOrder {
    int nM, nN, nwg, G, c;
    __host__ __device__ void init(int M, int N, int G_, int c_) { nM = M / BM; nN = N / BM; nwg = nM * nN; G = G_; c = c_; }
    __host__ __device__ bool next(int i, Unit& u) const {
        const long L = (long)i * G + c; if (L >= nwg) return false;
        int wgid = (int)L; { const int q = nwg / NXCD, r = nwg % NXCD, xcd = wgid % NXCD, off = wgid / NXCD; wgid = (xcd < r ? xcd * (q + 1) : r * (q + 1) + (xcd - r) * q) + off; }
        const int nig = WGM * nN, gid = wgid / nig, fm = gid * WGM, gsz = (nM - fm) < WGM ? (nM - fm) : WGM;
        u.pm = fm + ((wgid % nig) % gsz); u.pn = (wgid % nig) / gsz; return true;
    }
    __device__ __forceinline__ void a_ready(const Unit&) const {}
    __device__ __forceinline__ void done(const Unit&) const {}
};

__device__ __forceinline__ unsigned cvt_pk_bf16(float lo, float hi) { unsigned r; asm volatile("v_cvt_pk_bf16_f32 %0, %1, %2" : "=v"(r) : "v"(lo), "v"(hi)); return r; }
typedef float f32x2 __attribute__((ext_vector_type(2)));
__device__ __forceinline__ float bflo(unsigned w) { return __uint_as_float(w << 16); }
__device__ __forceinline__ float bfhi(unsigned w) { return __uint_as_float(w & 0xffff0000u); }
struct EpiProj {
    static constexpr bool PERM = true, AFTER_DRAIN = false;
    bf16_t* O; int ldc; const float* cs; unsigned ropemask, scalemask; float qscale;
    __device__ __forceinline__ void operator()(const f32x4 (&acc)[2][2][4][2], const Unit& u, int wr, int wc, int fr, int fq) const {
        const int row0 = u.pm * BM + wr * 64 + fr, col0 = u.pn * BM + wc * 32 + 8 * fq;
#pragma unroll
        for (int bj = 0; bj < 2; ++bj) {
            const unsigned bit = 1u << (2 * u.pn + bj);
            const float sc = (scalemask & bit) ? qscale : 1.f;
            const bool rope = ((ropemask & bit) != 0u) && ((wc & 1) == 0);
#pragma unroll
            for (int ai = 0; ai < 2; ++ai)
#pragma unroll
                for (int m = 0; m < 4; ++m) {
                    const int row = row0 + ai * HALF + m * 16;
                    f32x4 v0 = acc[ai][bj][m][0] * sc, v1 = acc[ai][bj][m][1] * sc;
                    if (rope) {
                        const float* t = cs + (size_t)row * 16;
                        const f32x4 c0 = *(const f32x4*)t, c1 = *(const f32x4*)(t + 4), s0 = *(const f32x4*)(t + 8), s1 = *(const f32x4*)(t + 12);
                        f32x4 p0, p1;
#pragma unroll
                        for (int j = 0; j < 4; ++j) { p0[j] = __shfl_xor(v0[j], 16); p1[j] = __shfl_xor(v1[j], 16); }
                        if (fq < 2) { const float sg = (fq == 0) ? -1.f : 1.f; v0 = v0 * c0 + p0 * s0 * sg; v1 = v1 * c1 + p1 * s1 * sg; }
                    }
                    u32x4 w; w.x = cvt_pk_bf16(v0[0], v0[1]); w.y = cvt_pk_bf16(v0[2], v0[3]); w.z = cvt_pk_bf16(v1[0], v1[1]); w.w = cvt_pk_bf16(v1[2], v1[3]);
                    *(u32x4*)(O + (size_t)row * ldc + col0 + bj * HALF) = w;
                }
        }
    }
};
struct EpiAct {
    static constexpr bool PERM = true, AFTER_DRAIN = false;
    bf16_t* O; const bf16_t* G; int ldc; const float* cw; const float* cb;
    __device__ __forceinline__ void operator()(const f32x4 (&acc)[2][2][4][2], const Unit& u, int wr, int wc, int fr, int fq) const {
        const int row0 = u.pm * BM + wr * 64 + fr, col0 = u.pn * BM + wc * 32 + 8 * fq;
#pragma unroll
        for (int bj = 0; bj < 2; ++bj) {
            const int col = col0 + bj * HALF;
            f32x4 k0[2], k1[2], k2[2], bb[2];
#pragma unroll
            for (int n = 0; n < 2; ++n) { k0[n] = *(const f32x4*)(cw + col + 4 * n); k1[n] = *(const f32x4*)(cw + ldc + col + 4 * n); k2[n] = *(const f32x4*)(cw + 2 * ldc + col + 4 * n); bb[n] = *(const f32x4*)(cb + col + 4 * n); }
#pragma unroll
            for (int ai = 0; ai < 2; ++ai)
#pragma unroll
                for (int m = 0; m < 4; ++m) {
                    const int row = row0 + ai * HALF + m * 16, t = row & 8191;
                    const bf16_t* gp = G + (size_t)row * ldc + col;
                    const u32x4 g2 = *(const u32x4*)gp;
                    u32x4 g1 = (u32x4){0u, 0u, 0u, 0u}, g0 = (u32x4){0u, 0u, 0u, 0u};
                    if (t >= 1) g1 = *(const u32x4*)(gp - ldc);
                    if (t >= 2) g0 = *(const u32x4*)(gp - 2 * ldc);
                    f32x4 r[2];
#pragma unroll
                    for (int n = 0; n < 2; ++n) {
                        const unsigned a0 = n ? g0.z : g0.x, a1 = n ? g0.w : g0.y, b0 = n ? g1.z : g1.x, b1 = n ? g1.w : g1.y, c0 = n ? g2.z : g2.x, c1 = n ? g2.w : g2.y;
                        f32x4 x0 = (f32x4){bflo(a0), bfhi(a0), bflo(a1), bfhi(a1)}, x1 = (f32x4){bflo(b0), bfhi(b0), bflo(b1), bfhi(b1)}, x2 = (f32x4){bflo(c0), bfhi(c0), bflo(c1), bfhi(c1)};
                        f32x4 cv = k0[n] * x0 + k1[n] * x1 + k2[n] * x2 + bb[n];
#pragma unroll
                        for (int j = 0; j < 4; ++j) { const float e = __builtin_amdgcn_exp2f(-1.4426950408889634f * cv[j]); cv[j] = cv[j] * __builtin_amdgcn_rcpf(1.f + e); }
                        r[n] = cv * acc[ai][bj][m][n];
                    }
                    u32x4 w; w.x = cvt_pk_bf16(r[0][0], r[0][1]); w.y = cvt_pk_bf16(r[0][2], r[0][3]); w.z = cvt_pk_bf16(r[1][0], r[1][1]); w.w = cvt_pk_bf16(r[1][2], r[1][3]);
                    *(u32x4*)(O + (size_t)row * ldc + col) = w;
                }
        }
    }
};
struct EpiRes {
    static constexpr bool PERM = false, AFTER_DRAIN = false;
    const float* base; float* out; int ldc; const float* gate; int gstride;
    __device__ __forceinline__ void operator()(const f32x4 (&acc)[2][2][4][2], const Unit& u, int wr, int wc, int fr, int fq) const {
        const int col0 = u.pn * BM + wc * 32 + 4 * fq; const float* gp = gate + (size_t)((u.pm * BM) >> 13) * gstride;
        f32x4 gv[2][2];
#pragma unroll
        for (int bj = 0; bj < 2; ++bj)
#pragma unroll
            for (int n = 0; n < 2; ++n) gv[bj][n] = *(const f32x4*)(gp + col0 + bj * HALF + n * 16);
#pragma unroll
        for (int ai = 0; ai < 2; ++ai)
#pragma unroll
            for (int m = 0; m < 4; ++m) { const size_t off = (size_t)(u.pm * BM + ai * HALF + wr * 64 + m * 16 + fr) * ldc + col0;
#pragma unroll
                for (int bj = 0; bj < 2; ++bj)
#pragma unroll
                    for (int n = 0; n < 2; ++n) { const f32x4 bs = *(const f32x4*)(base + off + bj * HALF + n * 16); *(f32x4*)(out + off + bj * HALF + n * 16) = bs + gv[bj][n] * acc[ai][bj][m][n]; }
                if (m & 1) asm volatile("" ::: "memory"); }
    }
};
template <class Epi, class Sched, bool ALIGN_EPI = false, bool SP2 = false>
__device__ __forceinline__ void gemm_phase(PG8_LAS unsigned char* lds, const Gemm g, const Sched& S, const Epi& E) {
    const int tid = threadIdx.x, wid = __builtin_amdgcn_readfirstlane(tid >> 6), lane = tid & 63, wr = wid >> 2, wc = wid & 3, fr = lane & 15, fq = lane >> 4;
    const int K = g.K, nt = K / BK;
    unsigned voffA[2], voffB[2];
#pragma unroll
    for (int i = 0; i < 2; ++i) { int R, C; stage_rc(tid * 16 + i * 8192, R, C); const int Rb = Epi::PERM ? ((R & ~31) + perm32(R & 31)) : R;
        voffA[i] = (unsigned)(R * K + C) * 2u; voffB[i] = (unsigned)(Rb * K + C) * 2u; }
    const size_t kstep = (size_t)(BK * 2);
    const size_t hstep = (size_t)HALF * K * 2;
    const size_t tstep = 2 * hstep;
    const unsigned ldsw = (unsigned)wid * 1024u;
    const int aoff = lds_byte(wr * 64 + fr, fq * 8), boff = lds_byte(wc * 32 + fr, fq * 8);
#define PG8_SA(b, h) (((b) * 2 + (h)) * HTB)
#define PG8_SB(b, h) ((4 + (b) * 2 + (h)) * HTB)
#define PG8_STAGE(bufoff, gbase, voff) do { _Pragma("unroll") for (int _i = 0; _i < 2; ++_i) \
        __builtin_amdgcn_global_load_lds((const unsigned*)((const char*)(gbase) + (voff)[_i]), (PG8_LAS unsigned*)(lds + (bufoff) + ldsw + _i * 8192), 16, 0, 0); } while (0)
#define PG8_LDA(dst, b, h) do { _Pragma("unroll") for (int m = 0; m < 4; ++m) _Pragma("unroll") for (int k = 0; k < 2; ++k) dst[m][k] = *(const PG8_LAS bf16x8*)(lds + PG8_SA(b, h) + aoff + m * 2048 + k * 1024); } while (0)
#define PG8_LDB(dst, b, h) do { _Pragma("unroll") for (int n = 0; n < 2; ++n) _Pragma("unroll") for (int k = 0; k < 2; ++k) dst[n][k] = *(const PG8_LAS bf16x8*)(lds + PG8_SB(b, h) + boff + n * 2048 + k * 1024); } while (0)
#define PG8_MMA(ai, bj, At, Bt) do { __builtin_amdgcn_s_setprio(1); _Pragma("unroll") for (int m = 0; m < 4; ++m) _Pragma("unroll") for (int n = 0; n < 2; ++n) _Pragma("unroll") for (int k = 0; k < 2; ++k) \
        acc[ai][bj][m][n] = __builtin_amdgcn_mfma_f32_16x16x32_bf16(Bt[n][k], At[m][k], acc[ai][bj][m][n], 0, 0, 0); __builtin_amdgcn_s_setprio(0); } while (0)
#define PG8_WAIT_V(n) asm volatile("s_waitcnt vmcnt(" #n ")" ::: "memory")
#define PG8_WAIT_L(n) asm volatile("s_waitcnt lgkmcnt(" #n ")" ::: "memory")
#define PG8_BAR __builtin_amdgcn_s_barrier()
#define PG8_SCHED __builtin_amdgcn_sched_barrier(0)
    Unit cur, nxt; int ui = 0;
    if (!S.next(0, cur)) return;
    f32x4 acc[2][2][4][2];
#pragma unroll
    for (int a = 0; a < 2; ++a)
#pragma unroll
        for (int b = 0; b < 2; ++b)
#pragma unroll
            for (int m = 0; m < 4; ++m)
#pragma unroll
                for (int n = 0; n < 2; ++n) acc[a][b][m][n] = (f32x4){0.f, 0.f, 0.f, 0.f};
    bf16x8 At[4][2], B0[2][2], B1[2][2];
    const char* cA = (const char*)g.A + (size_t)cur.pm * tstep; const char* cB = (const char*)g.Bt + (size_t)cur.pn * tstep;
    S.a_ready(cur);
    if constexpr (SP2) {
        PG8_STAGE(PG8_SB(0, 0), cB, voffB); PG8_STAGE(PG8_SB(0, 1), cB + hstep, voffB); PG8_STAGE(PG8_SA(0, 0), cA, voffA); PG8_STAGE(PG8_SA(0, 1), cA + hstep, voffA);
        if (wr == 1) PG8_BAR;
        PG8_WAIT_V(2); PG8_BAR;
        PG8_STAGE(PG8_SB(1, 0), cB + kstep, voffB); PG8_STAGE(PG8_SA(1, 0), cA + kstep, voffA); PG8_STAGE(PG8_SB(1, 1), cB + hstep + kstep, voffB);
        PG8_WAIT_V(6); PG8_BAR;
    } else {
        PG8_STAGE(PG8_SB(0, 0), cB, voffB); PG8_STAGE(PG8_SA(0, 0), cA, voffA); PG8_STAGE(PG8_SB(0, 1), cB + hstep, voffB); PG8_STAGE(PG8_SA(0, 1), cA + hstep, voffA);
        if (wr == 1) PG8_BAR;
        PG8_WAIT_V(4); PG8_BAR;
        PG8_STAGE(PG8_SB(1, 0), cB + kstep, voffB); PG8_STAGE(PG8_SA(1, 0), cA + kstep, voffA); PG8_STAGE(PG8_SB(1, 1), cB + hstep + kstep, voffB);
        PG8_WAIT_V(6); PG8_BAR;
    }
    for (;;) {
        const bool has_next = S.next(ui + 1, nxt);
        const char* nA = has_next ? (const char*)g.A + (size_t)nxt.pm * tstep : cA; const char* nB = has_next ? (const char*)g.Bt + (size_t)nxt.pn * tstep : cB;
        for (int t = 0; t < nt; t += 2) {
            const bool last = (t == nt - 2);
            const char* a1 = cA + (size_t)(t + 1) * kstep;
            const char* a2 = last ? nA : cA + (size_t)(t + 2) * kstep; const char* b2 = last ? nB : cB + (size_t)(t + 2) * kstep;
            const char* a3 = a2 + kstep; const char* b3 = b2 + kstep;
            if (last && has_next) S.a_ready(nxt);
            if constexpr (SP2) {
            PG8_LDB(B0, 0, 0); PG8_LDB(B1, 0, 1); PG8_SCHED; PG8_LDA(At, 0, 0); PG8_STAGE(PG8_SA(1, 1), a1 + hstep, voffA);
            PG8_WAIT_V(8); PG8_WAIT_L(0); PG8_BAR; PG8_MMA(0, 0, At, B0); PG8_MMA(0, 1, At, B1); PG8_BAR; PG8_SCHED;
            PG8_LDA(At, 0, 1); PG8_STAGE(PG8_SB(0, 0), b2, voffB); PG8_STAGE(PG8_SB(0, 1), b2 + hstep, voffB); PG8_STAGE(PG8_SA(0, 0), a2, voffA);
            PG8_WAIT_V(8); PG8_WAIT_L(0); PG8_BAR; PG8_MMA(1, 0, At, B0); PG8_MMA(1, 1, At, B1); PG8_BAR; PG8_SCHED;
            PG8_LDB(B0, 1, 0); PG8_LDB(B1, 1, 1); PG8_SCHED; PG8_LDA(At, 1, 0); PG8_STAGE(PG8_SA(0, 1), a2 + hstep, voffA);
            PG8_WAIT_V(8); PG8_WAIT_L(0); PG8_BAR; PG8_MMA(0, 0, At, B0); PG8_MMA(0, 1, At, B1); PG8_BAR; PG8_SCHED;
            PG8_LDA(At, 1, 1); PG8_STAGE(PG8_SB(1, 0), b3, voffB); PG8_STAGE(PG8_SB(1, 1), b3 + hstep, voffB); PG8_STAGE(PG8_SA(1, 0), a3, voffA);
            PG8_WAIT_V(8); PG8_WAIT_L(0); PG8_BAR; PG8_MMA(1, 0, At, B0); PG8_MMA(1, 1, At, B1); PG8_BAR; PG8_SCHED;
            } else {
            PG8_LDB(B0, 0, 0); PG8_SCHED; PG8_LDA(At, 0, 0); PG8_STAGE(PG8_SA(1, 1), a1 + hstep, voffA);
            PG8_WAIT_L(8); PG8_BAR; PG8_WAIT_L(0); PG8_MMA(0, 0, At, B0); PG8_BAR; PG8_SCHED;
            PG8_LDB(B1, 0, 1); PG8_STAGE(PG8_SB(0, 0), b2, voffB);
            PG8_BAR; PG8_WAIT_L(0); PG8_MMA(0, 1, At, B1); PG8_BAR;
            PG8_LDA(At, 0, 1); PG8_STAGE(PG8_SA(0, 0), a2, voffA);
            PG8_BAR; PG8_WAIT_L(0); PG8_MMA(1, 0, At, B0); PG8_BAR; PG8_SCHED;
            PG8_STAGE(PG8_SB(0, 1), b2 + hstep, voffB);
            PG8_WAIT_V(6); PG8_BAR; PG8_MMA(1, 1, At, B1); PG8_BAR;
            PG8_LDB(B0, 1, 0); PG8_SCHED; PG8_LDA(At, 1, 0); PG8_STAGE(PG8_SA(0, 1), a2 + hstep, voffA);
            PG8_WAIT_L(8); PG8_BAR; PG8_WAIT_L(0); PG8_MMA(0, 0, At, B0); PG8_BAR; PG8_SCHED;
            PG8_LDB(B1, 1, 1); PG8_STAGE(PG8_SB(1, 0), b3, voffB);
            PG8_BAR; PG8_WAIT_L(0); PG8_MMA(0, 1, At, B1); PG8_BAR;
            PG8_LDA(At, 1, 1); PG8_STAGE(PG8_SA(1, 0), a3, voffA);
            PG8_BAR; PG8_WAIT_L(0); PG8_MMA(1, 0, At, B0); PG8_BAR; PG8_SCHED;
            PG8_STAGE(PG8_SB(1, 1), b3 + hstep, voffB);
            PG8_WAIT_V(6); PG8_BAR; PG8_MMA(1, 1, At, B1); PG8_BAR;
            }
        }
        if constexpr (ALIGN_EPI) { if (wr == 0) PG8_BAR; }
        if constexpr (!Epi::AFTER_DRAIN) { E(acc, cur, wr, wc, fr, fq); S.done(cur); }
        if (!has_next) break;
#pragma unroll
        for (int a = 0; a < 2; ++a)
#pragma unroll
            for (int b = 0; b < 2; ++b)
#pragma unroll
                for (int m = 0; m < 4; ++m)
#pragma unroll
                    for (int n = 0; n < 2; ++n) acc[a][b][m][n] = (f32x4){0.f, 0.f, 0.f, 0.f};
        cur = nxt; cA = nA; cB = nB; ++ui;
        if constexpr (ALIGN_EPI) { if (wr == 1) PG8_BAR; }
    }
    PG8_WAIT_V(0);
    if constexpr (!ALIGN_EPI) { if (wr == 0) PG8_BAR; }
    PG8_BAR;
    if constexpr (Epi::AFTER_DRAIN) { E.fused(acc, cur, wr, wc, fr, fq, lds, wid, lane); S.done(cur); }
#undef PG8_SA
#undef PG8_SB
#undef PG8_STAGE
#undef PG8_LDA
#undef PG8_LDB
#undef PG8_MMA
#undef PG8_WAIT_V
#undef PG8_WAIT_L
#undef PG8_BAR
#undef PG8_SCHED
}
}
#include <hip/hip_bf16.h>
#include <cmath>
namespace attn_body {
using bf16=__hip_bfloat16;
using bf16x8=__attribute__((ext_vector_type(8)))short;
using s16x4=__attribute__((ext_vector_type(4)))short;
using f32x16=__attribute__((ext_vector_type(16)))float;
using u32x4=__attribute__((ext_vector_type(4)))unsigned;
constexpr int SEQ=8192,D=64;
constexpr int NW=8,QBLK=32,QB=QBLK*NW,KVBLK=64,NQB=SEQ/QB;
constexpr int ATTN_UNIT_ROWS=QB;
__device__ __forceinline__ int crow(int r,int hi){return (r&3)+8*(r>>2)+4*hi;}
#define SBAR() __builtin_amdgcn_sched_barrier(0)
__device__ __forceinline__ void cmask(f32x16&p0,f32x16&p1,int jb,int qrel,int hi){
  const float NEG=-INFINITY; int kb=64*jb+4*hi;
  #pragma unroll
  for(int r=0;r<16;++r){int kv=kb+(r&3)+8*(r>>2); if(kv>qrel)p0[r]=NEG; if(kv+32>qrel)p1[r]=NEG;}
}

constexpr int NSLOT=3, SLOTB=8192;
constexpr int LDS_K=0, LDS_V=NSLOT*SLOTB, LDS_WS=2*NSLOT*SLOTB, LDS_OST=LDS_WS+NW*64*4, LDS_BYTES=LDS_OST+NW*4096;
constexpr float C2=0.125f*1.4426950408889634f;
__device__ __forceinline__ void glds16(const void*gsrc,unsigned lds_dst){unsigned keep;
  asm volatile("s_mov_b32 %0, m0\n\ts_mov_b32 m0, %2\n\ts_nop 0\n\tglobal_load_lds_dwordx4 %1, off\n\ts_mov_b32 m0, %0":"=&s"(keep):"v"(gsrc),"s"(lds_dst):"memory");}
__device__ __forceinline__ float max3f(float a,float b,float c){float r;asm("v_max3_f32 %0, %1, %2, %3":"=v"(r):"v"(a),"v"(b),"v"(c));return r;}
__device__ __forceinline__ float max2f(float a,float b){float r;asm("v_max_f32_e32 %0, %1, %2":"=v"(r):"v"(a),"v"(b));return r;}
__device__ __forceinline__ float fadd_s(float a,float b){float r;asm("v_add_f32_e32 %0, %1, %2":"=v"(r):"v"(a),"v"(b));return r;}
__device__ __forceinline__ float fsub_s(float a,float b){float r;asm("v_sub_f32_e32 %0, %1, %2":"=v"(r):"v"(a),"v"(b));return r;}
typedef float f32x2_t __attribute__((ext_vector_type(2))); typedef __bf16 bf16x2_t __attribute__((ext_vector_type(2)));
__device__ __forceinline__ unsigned cvtpk_s(float lo,float hi){f32x2_t v={lo,hi};bf16x2_t b=__builtin_convertvector(v,bf16x2_t);return __builtin_bit_cast(unsigned,b);}
#define WAIT_BAR(N) asm volatile("s_waitcnt vmcnt(" #N ") lgkmcnt(0)\n\ts_barrier":::"memory")

__device__ __forceinline__ void qkt(f32x16&p0,f32x16&p1,const char*Kslot,const bf16x8*qr,const f32x16&negm,int r32,int hi){
  const char*kb=Kslot+hi*1024+r32*16;
  #pragma unroll
  for(int d0=0;d0<4;++d0){
    const bf16x8 b0=*reinterpret_cast<const bf16x8*>(kb+d0*2048);
    const bf16x8 b1=*reinterpret_cast<const bf16x8*>(kb+d0*2048+512);
    if(d0==0){p0=__builtin_amdgcn_mfma_f32_32x32x16_bf16(b0,qr[0],negm,0,0,0);p1=__builtin_amdgcn_mfma_f32_32x32x16_bf16(b1,qr[0],negm,0,0,0);}
    else{p0=__builtin_amdgcn_mfma_f32_32x32x16_bf16(b0,qr[d0],p0,0,0,0);p1=__builtin_amdgcn_mfma_f32_32x32x16_bf16(b1,qr[d0],p1,0,0,0);}}
}
typedef __attribute__((address_space(3))) const char* lds_cptr;
typedef short v4i16_t __attribute__((ext_vector_type(4)));
__device__ __forceinline__ void kload8(bf16x8*kf,lds_cptr kp){
  kf[0]=*(const __attribute__((address_space(3))) bf16x8*)(kp);      kf[1]=*(const __attribute__((address_space(3))) bf16x8*)(kp+512);
  kf[2]=*(const __attribute__((address_space(3))) bf16x8*)(kp+2048); kf[3]=*(const __attribute__((address_space(3))) bf16x8*)(kp+2560);
  kf[4]=*(const __attribute__((address_space(3))) bf16x8*)(kp+4096); kf[5]=*(const __attribute__((address_space(3))) bf16x8*)(kp+4608);
  kf[6]=*(const __attribute__((address_space(3))) bf16x8*)(kp+6144); kf[7]=*(const __attribute__((address_space(3))) bf16x8*)(kp+6656);
}
__device__ __forceinline__ void kload2(bf16x8*kf,lds_cptr kp,int j){ kf[2*j]=*(const __attribute__((address_space(3))) bf16x8*)(kp+j*2048); kf[2*j+1]=*(const __attribute__((address_space(3))) bf16x8*)(kp+j*2048+512); }
__device__ __forceinline__ s16x4 vtr(lds_cptr p){ return __builtin_bit_cast(s16x4,__builtin_amdgcn_ds_read_tr16_b64_v4i16((__attribute__((address_space(3))) v4i16_t*)p)); }
__device__ __forceinline__ float rowmax(const f32x16&p0,const f32x16&p1){
  float a=max3f(p0[0],p0[1],p1[0]),b=max3f(p0[2],p0[3],p1[1]);a=max3f(a,p1[2],p1[3]);
  #pragma unroll
  for(int r=4;r<16;r+=4){a=max3f(a,p0[r],p0[r+1]);b=max3f(b,p0[r+2],p0[r+3]);a=max3f(a,p1[r],p1[r+1]);b=max3f(b,p1[r+2],p1[r+3]);}
  const float m=max2f(a,b);
  auto rr=__builtin_amdgcn_permlane32_swap(__float_as_uint(m),__float_as_uint(m),false,false);
  return max2f(__uint_as_float(rr[0]),__uint_as_float(rr[1]));
}
__device__ __forceinline__ void pv(f32x16*o,int vb,bf16x8 pa0,bf16x8 pa1,bf16x8 pa2,bf16x8 pa3){
  #pragma unroll
  for(int d0=0;d0<2;++d0){s16x4 lo[4],hi[4];
    #pragma unroll
    for(int ks=0;ks<4;++ks){
      asm volatile("ds_read_b64_tr_b16 %0,%1 offset:%c2":"=&v"(lo[ks]):"v"(vb),"i"(d0*4096+ks*1024):"memory");
      asm volatile("ds_read_b64_tr_b16 %0,%1 offset:%c2":"=&v"(hi[ks]):"v"(vb),"i"(d0*4096+ks*1024+512):"memory");}
    asm volatile("s_waitcnt lgkmcnt(0)":::"memory");SBAR();
    #define PK(k) (bf16x8){lo[k][0],lo[k][1],lo[k][2],lo[k][3],hi[k][0],hi[k][1],hi[k][2],hi[k][3]}
    o[d0]=__builtin_amdgcn_mfma_f32_32x32x16_bf16(pa0,PK(0),o[d0],0,0,0);
    o[d0]=__builtin_amdgcn_mfma_f32_32x32x16_bf16(pa1,PK(1),o[d0],0,0,0);
    o[d0]=__builtin_amdgcn_mfma_f32_32x32x16_bf16(pa2,PK(2),o[d0],0,0,0);
    o[d0]=__builtin_amdgcn_mfma_f32_32x32x16_bf16(pa3,PK(3),o[d0],0,0,0);
    #undef PK
  }
}

#ifndef ATTN_STORE16
#define ATTN_STORE16(p,v) (*(u32x4*)(p)=(v))
#endif
template<int THRL,int PIN,int POUT> __device__ __forceinline__ void attn_unit(int b,int h,int qb,const bf16*Q,const bf16*__restrict__ K,const bf16*__restrict__ V,bf16*O,char*shm){
  const int tid=threadIdx.x,lane=tid&63,r32=lane&31,hi=lane>>5; const int wid=__builtin_amdgcn_readfirstlane(tid>>6);
  const long rowbase=(long)b*SEQ; const int q0=qb*QB;
  const bf16*Qw=Q+(rowbase+q0+wid*QBLK)*PIN+h*D;
  const bf16*Kh=K+rowbase*PIN+h*D,*Vh=V+rowbase*PIN+h*D;
  const unsigned lds0=(unsigned)(uintptr_t)shm;
  float*wsf=(float*)(shm+LDS_WS)+wid*64;
  const bf16*ksrc=Kh+(long)lane*PIN+wid*8;
  const bf16*vsrc=Vh+(long)(16*(wid&3)+(lane>>2))*PIN+(wid>>2)*32+(lane&3)*8;
  const unsigned kdst=lds0+LDS_K+wid*1024, vdst=lds0+LDS_V+wid*1024;
  #define DMA_K(t,slot) glds16(ksrc+(long)(t)*KVBLK*PIN,(unsigned)__builtin_amdgcn_readfirstlane(kdst+(slot)))
  #define DMA_V(t,slot) glds16(vsrc+(long)(t)*KVBLK*PIN,(unsigned)__builtin_amdgcn_readfirstlane(vdst+(slot)))
  const int vb0=(int)(lds0+LDS_V)+((lane>>4)&1)*32+(lane&3)*8+(4*hi+((lane&15)>>2))*64;
  const char*Kbase=shm+LDS_K; bf16x8 kf[8];
  const lds_cptr shm3=(lds_cptr)shm; const lds_cptr kp0=shm3+LDS_K+hi*1024+r32*16; const lds_cptr vp0=shm3+LDS_V+((lane>>4)&1)*32+(lane&3)*8+(4*hi+((lane&15)>>2))*64;
  const int NT=(q0+QB)/KVBLK;
  DMA_K(0,0);DMA_V(0,0);DMA_K(1,SLOTB);
  bf16x8 qr[4];
  #pragma unroll
  for(int d0=0;d0<4;++d0)qr[d0]=*reinterpret_cast<const bf16x8*>(&Qw[(long)r32*PIN+d0*16+hi*8]);
  float mhat=0.f,l_reg=0.f;f32x16 o[2];o[0]=f32x16{};o[1]=f32x16{};f32x16 negm=f32x16{};asm volatile("":"+v"(negm));
  const int qrel=wid*QBLK+r32;
  #define CMASK(P0,P1,t) do{int jb_=(t)-(NT-4); if(jb_>=0)cmask(P0,P1,jb_,qrel,hi);}while(0)
  bool resc=false;
  #define START(P0,P1) do{ const float rm=rowmax(P0,P1); resc=false; \
    { const float dl=rm; mhat=fadd_s(mhat,dl); \
      _Pragma("unroll") for(int r=0;r<16;++r){P0[r]=fsub_s(P0[r],dl);P1[r]=fsub_s(P1[r],dl);} \
      _Pragma("unroll") for(int r=0;r<16;++r)negm[r]=-mhat; asm volatile("":"+v"(negm)); } \
    _Pragma("unroll") for(int r=0;r<16;++r)P0[r]=__builtin_amdgcn_exp2f(P0[r]); }while(0)
  #define RESC() do{ if(resc){ asm volatile("s_waitcnt lgkmcnt(0)":::"memory"); \
      _Pragma("unroll") for(int d_=0;d_<2;++d_) _Pragma("unroll") for(int r=0;r<16;++r)o[d_][r]*=wsf[crow(r,hi)]; } }while(0)
  f32x16 pA0,pA1,pB0,pB1;
  int sl_prev=0,sl_cur=0,sl_next=SLOTB;
  #define ROT() do{sl_prev=sl_cur;sl_cur=sl_next;sl_next=(sl_next==(NSLOT-1)*SLOTB)?0:sl_next+SLOTB;}while(0)
  DMA_K(2,2*SLOTB);
  WAIT_BAR(3);
  qkt(pA0,pA1,Kbase,qr,negm,r32,hi);asm volatile("s_nop 15\n\ts_nop 7":"+v"(pA0),"+v"(pA1));CMASK(pA0,pA1,0);
  START(pA0,pA1);
  _Pragma("unroll") for(int r=0;r<16;++r)pA1[r]=__builtin_amdgcn_exp2f(pA1[r]);
  WAIT_BAR(0);
  DMA_K(3,0);DMA_V(1,SLOTB);
  ROT();
  kload8(kf,kp0+sl_cur);
  WAIT_BAR(2);
  s16x4 vlo[8],vhi[8]; u32x4 pw0,pw1,pw2,pw3;
  #define PKW(P,B) cvtpk_s(P[B],P[B+1])
  #define PAF(k) __builtin_bit_cast(bf16x8,pw##k)
  #define VFR(i) (bf16x8){vlo[i][0],vlo[i][1],vlo[i][2],vlo[i][3],vhi[i][0],vhi[i][1],vhi[i][2],vhi[i][3]}
  #define PIN(x) asm volatile("":"+v"(x))
  #define MX3(a,b,c) __builtin_fmaxf(__builtin_fmaxf((a),(b)),(c))
  #define GAPA(MF,A0,A1,A2,A3,W0,W1,PW) do{ MF; sacc+=A0; sacc+=A1; sacc+=A2; sacc+=A3; PIN(sacc); W0; W1; PIN(PW); SBAR(); }while(0)
  #define EX(v) __builtin_amdgcn_exp2f(v)
  #define GAPB(MF,X,B) do{ MF; X[B]=EX(X[B]); X[B+1]=EX(X[B+1]); X[B+2]=EX(X[B+2]); X[B+3]=EX(X[B+3]); PIN(X); SBAR(); }while(0)
  #define VRD(i) do{ vlo[i]=vtr(vp_+(((i)>>2)*4096+((i)&3)*1024)); vhi[i]=vtr(vp_+(((i)>>2)*4096+((i)&3)*1024+512)); }while(0)
  #define KRD(G,j) do{ if(G){ kload2(kf,kp0+sl_next,j); SBAR(); } }while(0)
  #define STEP(C0,C1,P0,P1,t,GK,GV,GL) do{ SBAR(); \
    const lds_cptr vp_=vp0+sl_prev; \
    VRD(0); SBAR(); float sacc=(P0[0]+P0[1]); \
    GAPA(C0=__builtin_amdgcn_mfma_f32_32x32x16_bf16(kf[0],qr[0],negm,0,0,0), P0[2],P0[3],P0[4],P0[5],     pw0[0]=PKW(P0,0), pw0[1]=PKW(P0,2), pw0); \
    VRD(4); SBAR(); GAPA(C1=__builtin_amdgcn_mfma_f32_32x32x16_bf16(kf[1],qr[0],negm,0,0,0), P0[6],P0[7],P0[8],P0[9],     pw0[2]=PKW(P0,4), pw0[3]=PKW(P0,6), pw0); \
    VRD(1); SBAR(); GAPA(C0=__builtin_amdgcn_mfma_f32_32x32x16_bf16(kf[2],qr[1],C0,0,0,0),   P0[10],P0[11],P0[12],P0[13], pw1[0]=PKW(P0,8), pw1[1]=PKW(P0,10), pw1); \
    VRD(5); SBAR(); GAPA(C1=__builtin_amdgcn_mfma_f32_32x32x16_bf16(kf[3],qr[1],C1,0,0,0),   P0[14],P0[15],P1[0],P1[1],   pw1[2]=PKW(P0,12),pw1[3]=PKW(P0,14), pw1); \
    VRD(2); SBAR(); GAPA(C0=__builtin_amdgcn_mfma_f32_32x32x16_bf16(kf[4],qr[2],C0,0,0,0),   P1[2],P1[3],P1[4],P1[5],     pw2[0]=PKW(P1,0), pw2[1]=PKW(P1,2), pw2); \
    VRD(6); SBAR(); GAPA(C1=__builtin_amdgcn_mfma_f32_32x32x16_bf16(kf[5],qr[2],C1,0,0,0),   P1[6],P1[7],P1[8],P1[9],     pw2[2]=PKW(P1,4), pw2[3]=PKW(P1,6), pw2); \
    VRD(3); SBAR(); GAPA(C0=__builtin_amdgcn_mfma_f32_32x32x16_bf16(kf[6],qr[3],C0,0,0,0),   P1[10],P1[11],P1[12],P1[13], pw3[0]=PKW(P1,8), pw3[1]=PKW(P1,10), pw3); \
    VRD(7); SBAR(); GAPA(C1=__builtin_amdgcn_mfma_f32_32x32x16_bf16(kf[7],qr[3],C1,0,0,0),   P1[14],P1[15],0.f,0.f,       pw3[2]=PKW(P1,12),pw3[3]=PKW(P1,14), pw3); \
    l_reg+=sacc; \
    if(GK){DMA_K((t)+3,sl_cur);} if(GV){DMA_V((t)+1,sl_next);} \
    CMASK(C0,C1,t); \
    { float a=MX3(C0[0],C0[1],C1[0]),b=MX3(C0[2],C0[3],C1[1]); a=MX3(a,C1[2],C1[3]); \
      _Pragma("unroll") for(int r=4;r<16;r+=4){a=MX3(a,C0[r],C0[r+1]);b=MX3(b,C0[r+2],C0[r+3]);a=MX3(a,C1[r],C1[r+1]);b=MX3(b,C1[r+2],C1[r+3]);} \
      float rm=__builtin_fmaxf(a,b); { auto rr=__builtin_amdgcn_permlane32_swap(__float_as_uint(rm),__float_as_uint(rm),false,false); rm=__builtin_fmaxf(__uint_as_float(rr[0]),__uint_as_float(rr[1])); } \
      resc=false; \
      if(__builtin_expect(__any(rm>(float)THRL),0)){ const float dl=__builtin_fmaxf(rm,0.f); mhat+=dl; \
        _Pragma("unroll") for(int r=0;r<16;++r){C0[r]-=dl;C1[r]-=dl;} \
        _Pragma("unroll") for(int r=0;r<16;++r)negm[r]=-mhat; asm volatile("":"+v"(negm)); \
        const float f=__builtin_amdgcn_exp2f(-dl); l_reg*=f; if(hi==0)wsf[r32]=f; resc=true; } } \
    SBAR(); \
    GAPB(o[0]=__builtin_amdgcn_mfma_f32_32x32x16_bf16(PAF(0),VFR(0),o[0],0,0,0), C0,0); \
    GAPB(o[1]=__builtin_amdgcn_mfma_f32_32x32x16_bf16(PAF(0),VFR(4),o[1],0,0,0), C0,4); \
    KRD(GL,0); GAPB(o[0]=__builtin_amdgcn_mfma_f32_32x32x16_bf16(PAF(1),VFR(1),o[0],0,0,0), C0,8); \
    KRD(GL,1); GAPB(o[1]=__builtin_amdgcn_mfma_f32_32x32x16_bf16(PAF(1),VFR(5),o[1],0,0,0), C0,12); \
    KRD(GL,2); GAPB(o[0]=__builtin_amdgcn_mfma_f32_32x32x16_bf16(PAF(2),VFR(2),o[0],0,0,0), C1,0); \
    KRD(GL,3); GAPB(o[1]=__builtin_amdgcn_mfma_f32_32x32x16_bf16(PAF(2),VFR(6),o[1],0,0,0), C1,4); \
    GAPB(o[0]=__builtin_amdgcn_mfma_f32_32x32x16_bf16(PAF(3),VFR(3),o[0],0,0,0), C1,8); \
    GAPB(o[1]=__builtin_amdgcn_mfma_f32_32x32x16_bf16(PAF(3),VFR(7),o[1],0,0,0), C1,12); \
    }while(0)
  int t=1;
  #undef CMASK
  #define CMASK(P0,P1,t) do{}while(0)
  for(;t+5<NT;t+=2){
    STEP(pB0,pB1,pA0,pA1,t,true,true,true);     WAIT_BAR(2); RESC(); ROT();
    STEP(pA0,pA1,pB0,pB1,t+1,true,true,true);   WAIT_BAR(2); RESC(); ROT();
  }
  #undef CMASK
  #define CMASK(P0,P1,t) do{int jb_=(t)-(NT-4); if(jb_>=0)cmask(P0,P1,jb_,qrel,hi);}while(0)
  #define ENDW(tt) do{ if((tt)+3<NT){WAIT_BAR(2);} else if((tt)+2<NT){WAIT_BAR(1);} else {WAIT_BAR(0);} }while(0)
  for(;t+1<NT;t+=2){
    STEP(pB0,pB1,pA0,pA1,t,(t+3<NT),(t+1<NT),(t+1<NT));       ENDW(t);   RESC(); ROT();
    STEP(pA0,pA1,pB0,pB1,t+1,(t+4<NT),(t+2<NT),(t+2<NT));     ENDW(t+1); RESC(); ROT();
  }
  STEP(pB0,pB1,pA0,pA1,NT-1,false,false,false); RESC();
  { float sacc=pB0[0]+pB0[1]; _Pragma("unroll") for(int r=2;r<16;++r)sacc+=pB0[r]; _Pragma("unroll") for(int r=0;r<16;++r)sacc+=pB1[r]; l_reg+=sacc;
    pw0=(u32x4){PKW(pB0,0),PKW(pB0,2),PKW(pB0,4),PKW(pB0,6)};pw1=(u32x4){PKW(pB0,8),PKW(pB0,10),PKW(pB0,12),PKW(pB0,14)};pw2=(u32x4){PKW(pB1,0),PKW(pB1,2),PKW(pB1,4),PKW(pB1,6)};pw3=(u32x4){PKW(pB1,8),PKW(pB1,10),PKW(pB1,12),PKW(pB1,14)};
    SBAR(); pv(o,vb0+sl_cur,PAF(0),PAF(1),PAF(2),PAF(3)); }
  #undef PKW
  #undef PAF
  #undef VFR
  #undef PIN
  #undef MX3
  #undef GAPA
  #undef GAPB
  #undef EX
  #undef VRD
  #undef KRD
  #undef STEP
  #undef ENDW
  {auto rr=__builtin_amdgcn_permlane32_swap(__float_as_uint(l_reg),__float_as_uint(l_reg),false,false);l_reg=__uint_as_float(rr[0])+__uint_as_float(rr[1]);}
  if(hi==0)wsf[32+r32]=l_reg;asm volatile("s_waitcnt lgkmcnt(0)":::"memory");
  float rli[16];
  #pragma unroll
  for(int r=0;r<16;++r)rli[r]=__builtin_amdgcn_rcpf(wsf[32+crow(r,hi)]);
  bf16*Ow=O+(rowbase+q0+wid*QBLK)*POUT+h*D;
  { bf16*stg=(bf16*)(shm+LDS_OST)+wid*2048;
    #pragma unroll
    for(int r=0;r<16;++r){const int orow=crow(r,hi);
      #pragma unroll
      for(int d0=0;d0<2;++d0)stg[orow*64+d0*32+r32]=__float2bfloat16(o[d0][r]*rli[r]);}
    asm volatile("s_waitcnt lgkmcnt(0)":::"memory");
    #pragma unroll
    for(int i=0;i<4;++i){const int row=i*8+(lane>>3),ch=lane&7; const u32x4 v=*(const u32x4*)(stg+row*64+ch*8); ATTN_STORE16(Ow+(long)row*POUT+ch*8,v);} }
  asm volatile("s_waitcnt lgkmcnt(0)\n\ts_barrier":::"memory");
  #undef DMA_K
  #undef DMA_V
  #undef CMASK
  #undef START
  #undef RESC
  #undef ROT
}
constexpr int ATTN_LDS_BYTES=LDS_BYTES;
struct AttnUnit { int bh; int qb; };
struct StaticOrder {
  int vcu;
  __device__ __forceinline__ explicit StaticOrder(int v):vcu(v){}
  __device__ __forceinline__ bool next(int i,AttnUnit&u)const{ if(i>=8)return false; const int s=vcu&7; u.bh=(vcu>>3)+32*(i>>2); const int ii=i&3; u.qb=(ii==0)?s:(ii==1)?15-s:(ii==2)?16+s:31-s; return true; }
};
template<int PIN,int POUT,int THRL=8> __device__ __forceinline__ void diff_attn_phase(char*lds,const bf16*PRJ,bf16*O1,bf16*O2,const StaticOrder&S){
  AttnUnit u;
  _Pragma("unroll 1") for(int i=0;S.next(i,u);++i){ const int rest=u.bh%32, h=rest>>2, wi=(rest>>1)&1, half=rest&1;
    attn_unit<THRL,PIN,POUT>(u.bh/32,0,u.qb,PRJ+(2*h+wi)*64,PRJ+1024+(2*h+wi)*64,PRJ+2048+h*128+half*64,(wi?O2:O1)+h*128+half*64,lds); }
}
#undef SBAR
#undef WAIT_BAR
}
constexpr int NWAVES = 8, NTHREADS = NWAVES * 64;
constexpr int BATCH = 2, T = 8192, D = 1024, M = BATCH * T, DFF = 2816, NPROJ = 3072;
constexpr float RMS_EPS = 1e-6f;
constexpr float QSCALE = 0.18033688011112042f;
constexpr float LAMBDA_INIT = 0.35550906759096934f;
constexpr int C_QN = 0, C_KC = 512, C_VC = 640, C_KS = 768, C_VS = 896, C_KW = 1024, C_VW = 1152, C_QS = 1280, C_KSB = 1792, C_VSB = 2304, C_GL = 2816;
constexpr int C1_Q = 0, C1_K = 1024, C1_V = 2048;

constexpr size_t MiB = 1u << 20, KiB = 1u << 10;
constexpr size_t WS_CTL = 0, CTL_ZERO_BYTES = 64 * KiB;
constexpr size_t WS_MODV = 1 * MiB;
constexpr size_t WS_CB1  = 1 * MiB + 128 * KiB;
constexpr size_t WS_KCMP = 1 * MiB + 256 * KiB;
constexpr size_t WS_VCMP = 1 * MiB + 512 * KiB;
constexpr size_t WS_CW2T = 1 * MiB + 768 * KiB;
constexpr size_t WS_CS   = 2 * MiB;
constexpr size_t WS_WQKV1 = 4 * MiB, WS_WOUT1 = 10 * MiB, WS_WG1 = 12 * MiB, WS_WU1 = WS_WG1 + 5632 * KiB, WS_WD1 = WS_WU1 + 5632 * KiB;
constexpr size_t WS_WG0 = WS_WD1 + 5632 * KiB, WS_WU0 = WS_WG0 + 5632 * KiB, WS_WD0 = WS_WU0 + 5632 * KiB;
constexpr size_t WS_XN = 45 * MiB;
constexpr size_t WS_R = 77 * MiB;
constexpr size_t WS_WIN0 = WS_R, WS_WOUT0 = WS_R + 6 * MiB, WS_CW1T = WS_R + 8 * MiB  , WS_PR = WS_R + 11 * MiB  , WS_OCAT = WS_PR + 96 * MiB;
constexpr size_t WS_G = WS_R, WS_ACT = WS_R + 88 * MiB;
constexpr size_t WS_PR1 = WS_R, WS_O1 = WS_R + 96 * MiB, WS_O2 = WS_O1 + 32 * MiB;
constexpr size_t WS_END = WS_ACT + 88 * MiB;
static_assert(WS_WD0 + 5632 * KiB == WS_XN && WS_OCAT + 32 * MiB <= WS_END && WS_O2 + 32 * MiB <= WS_END && WS_END <= 256 * MiB, "d_ws map");
constexpr int CW_BAR = 4096;

constexpr int LDS_BYTES = 163840;
constexpr int MISC_OFF = LDS_BYTES - 256;
constexpr int WAVE_LDS = 18432;
static_assert(NWAVES * WAVE_LDS <= MISC_OFF, "LDS map");
#define GAS __attribute__((address_space(1)))
#define LAS __attribute__((address_space(3)))
typedef unsigned short bf16;
typedef unsigned v4u __attribute__((ext_vector_type(4)));
typedef float f32x4 __attribute__((ext_vector_type(4)));
typedef short bf16x8 __attribute__((ext_vector_type(8)));
typedef GAS unsigned gu32;
typedef GAS unsigned long long gu64;
#define RLX_AGENT __ATOMIC_RELAXED, __HIP_MEMORY_SCOPE_AGENT
#define LDS_WAIT() asm volatile("s_waitcnt lgkmcnt(0)" ::: "memory")
#define VM_WAIT() asm volatile("s_waitcnt vmcnt(0)" ::: "memory")
__device__ __forceinline__ unsigned long long rt() { return __builtin_amdgcn_s_memrealtime(); }
__device__ __forceinline__ unsigned f2bf(float f) { unsigned u = __builtin_bit_cast(unsigned, f); return (u + 0x7fffu + ((u >> 16) & 1u)) >> 16; }
__device__ __forceinline__ unsigned pk2(float lo, float hi) { return f2bf(lo) | (f2bf(hi) << 16); }

#define XB_TMO      128
#define XB_XCNT(j)  (256  + 64 * (j))
#define XB_XSUB(j)  (1280 + 64 * (j))
#define XB_XGEN(j)  (2304 + 64 * (j))
#define XB_TOP      3328
#define XB_TOPGEN   3392
#define XCD_BAR_WORDS 3456
#define XB_SPIN_CAP (1u << 18)

__device__ __forceinline__ unsigned xb_ld(unsigned* p)              { return __hip_atomic_load(p, __ATOMIC_RELAXED, __HIP_MEMORY_SCOPE_AGENT); }
__device__ __forceinline__ unsigned xb_add(unsigned* p, unsigned v) { return __hip_atomic_fetch_add(p, v, __ATOMIC_RELAXED, __HIP_MEMORY_SCOPE_AGENT); }
__device__ __forceinline__ unsigned xb_xcc_id() { return (unsigned)__builtin_amdgcn_s_getreg((3 << 11) | 20) & 0xFu; }
#define XB_SPIN(cond, bar) do { unsigned _sp = 0; while (cond) { __builtin_amdgcn_s_sleep(1); \
    if ((++_sp & 255u) == 0u) { if (xb_ld(&(bar)[XB_TMO])) break; if (_sp > XB_SPIN_CAP) { atomicAdd(&(bar)[XB_TMO], 1u); break; } } } } while (0)

struct XcdBarrier {
    unsigned* bar; unsigned x;
    volatile LAS unsigned* st;
};

__device__ __forceinline__ XcdBarrier xcd_barrier_post(unsigned* bar, volatile LAS unsigned* st) {
    XcdBarrier b; b.bar = bar; b.x = xb_xcc_id(); b.st = st;
    if (threadIdx.x == 0) (void)xb_add(&bar[XB_XCNT(b.x)], 1u);
    return b;
}
__device__ __forceinline__ void xcd_barrier_complete(unsigned* bar, unsigned x, unsigned& nloc, unsigned& nx) {
    const unsigned G = gridDim.x * gridDim.y * gridDim.z;
    unsigned sum, cnt, mine, sp = 0u;
    for (;;) {
        sum = 0u; cnt = 0u; mine = 0u;
#pragma unroll
        for (unsigned j = 0; j < 16; ++j) { const unsigned c = xb_ld(&bar[XB_XCNT(j)]); sum += c; cnt += (c > 0u) ? 1u : 0u; mine = (j == x) ? c : mine; }
        if (sum == G) break;
        __builtin_amdgcn_s_sleep(1);
        if ((++sp & 255u) == 0u) { if (xb_ld(&bar[XB_TMO])) break; if (sp > XB_SPIN_CAP) { atomicAdd(&bar[XB_TMO], 1u); break; } }
    }
    nloc = mine > 0u ? mine : 1u; nx = cnt > 0u ? cnt : 1u;
}

__device__ __forceinline__ void xcd_barrier(const XcdBarrier& b) {
    asm volatile("s_waitcnt vmcnt(0)" ::: "memory");
    __syncthreads();
    if (threadIdx.x == 0) {
        unsigned* bar = b.bar;
        __builtin_amdgcn_s_waitcnt(0);
        unsigned nloc = b.st[0], nx = b.st[1];
        if (nloc == 0u) { xcd_barrier_complete(bar, b.x, nloc, nx); b.st[0] = nloc; b.st[1] = nx; }
        const unsigned old = xb_add(&bar[XB_XSUB(b.x)], 1u);
        const unsigned gen = old / nloc;
        if (old + 1u == (gen + 1u) * nloc) {
            __builtin_amdgcn_fence(__ATOMIC_RELEASE, "agent");
            asm volatile("s_waitcnt vmcnt(0)" ::: "memory");
            const unsigned og = xb_add(&bar[XB_TOP], 1u);
            const unsigned tg = og / nx;
            if (og + 1u == (tg + 1u) * nx) xb_add(&bar[XB_TOPGEN], 1u);
            else XB_SPIN(xb_ld(&bar[XB_TOPGEN]) == tg, bar);
            __builtin_amdgcn_fence(__ATOMIC_ACQUIRE, "agent");
            xb_add(&bar[XB_XGEN(b.x)], 1u);
            asm volatile("s_waitcnt vmcnt(0)" ::: "memory");
        } else {
            XB_SPIN(xb_ld(&bar[XB_XGEN(b.x)]) == gen, bar);
            __builtin_amdgcn_fence(__ATOMIC_ACQUIRE, "agent");
            asm volatile("s_waitcnt vmcnt(0)" ::: "memory");
        }
    }
    __syncthreads();
}
struct Ctx {
    LAS unsigned char* lds; int tid, lane, wave, vcu, G;
    const float *x, *c; const int* positions; const float *mod_w, *mod_b, *norm_mix, *norm_ffn, *w_gate, *w_up, *conv_w, *conv_b, *w_down, *hyb_w_in, *pos_k, *pos_v, *ck_w1, *ck_w2, *cv_w1, *cv_w2, *hyb_w_out,
        *diff_w_qkv, *lq1, *lk1, *lq2, *lk2, *subln, *diff_w_out, *norm_f;
    float* out; unsigned char* ws;
};
__device__ __forceinline__ float wave_sum(float v) {
#pragma unroll
    for (int o = 1; o < 64; o <<= 1) v += __shfl_xor(v, o);
    return v;
}
__device__ __forceinline__ float wave_max(float v) {
#pragma unroll
    for (int o = 1; o < 64; o <<= 1) v = fmaxf(v, __shfl_xor(v, o));
    return v;
}
__device__ __forceinline__ float bf2f(bf16 h) { return __uint_as_float((unsigned)h << 16); }
__device__ __forceinline__ float dot2(unsigned k, unsigned q, float acc) { typedef __bf16 bf16x2_t __attribute__((ext_vector_type(2))); return __builtin_amdgcn_fdot2_f32_bf16(__builtin_bit_cast(bf16x2_t, k), __builtin_bit_cast(bf16x2_t, q), acc, false); }
#define CFENCE() asm volatile("" ::: "memory")

__device__ __forceinline__ void p0_transpose_item(const float* W, int K, int N, int c0, int w, bf16* WT, int row_off, LAS float* scr, int item, int lane) {
    const int nblk = (w + 31) / 32, kb = item / nblk, nb = item % nblk, k0 = 64 * kb, n0 = 32 * nb;
    const bool okc = (n0 + (lane & 31)) < w;
#pragma unroll 8
    for (int i = 0; i < 32; ++i) { const int kk = 2 * i + (lane >> 5); scr[kk * 33 + (lane & 31)] = okc ? W[(size_t)(k0 + kk) * N + c0 + n0 + (lane & 31)] : 0.f; }
    LDS_WAIT(); CFENCE();
    const int c = lane & 7;
#pragma unroll
    for (int j = 0; j < 4; ++j) { const int n = (lane >> 3) + 8 * j; const LAS float* s = scr + (8 * c) * 33 + n;
        v4u o; o.x = pk2(s[0 * 33], s[1 * 33]); o.y = pk2(s[2 * 33], s[3 * 33]); o.z = pk2(s[4 * 33], s[5 * 33]); o.w = pk2(s[6 * 33], s[7 * 33]);
        if (n0 + n < w) *(GAS v4u*)(WT + (size_t)(row_off + n0 + n) * K + k0 + 8 * c) = o; }
    LDS_WAIT(); CFENCE();
}
constexpr int tj_items(int K, int w) { return (K / 64) * ((w + 31) / 32); }
__device__ __forceinline__ void p0_prologue(const Ctx& C) {
    unsigned char* ws = C.ws;
    {
        LAS float* cond = (LAS float*)C.lds;
        LAS float* part = (LAS float*)(C.lds + 8192);
        LAS float* posl = (LAS float*)(C.lds + 16384);
        for (int i = C.tid; i < 2048; i += NTHREADS) { const float v = C.c[i]; cond[i] = v / (1.f + __expf(-v)); }
        __syncthreads();
        for (int tk = blockIdx.x; tk < 392; tk += C.G) {
            float acc = 0.f;
            if (tk < 384) {
                const int layer = tk / 192, cg = tk % 192, col = 32 * cg + (C.lane & 31), bb = C.lane >> 5;
                const float* wp = C.mod_w + (size_t)layer * D * 6144 + (size_t)(128 * C.wave) * 6144 + col; const LAS float* cp = cond + bb * 1024 + 128 * C.wave;
#pragma unroll 16
                for (int k = 0; k < 128; ++k) acc += cp[k] * wp[(size_t)k * 6144];
            } else {
                const int which = (tk - 384) >> 2, n = 64 * ((tk - 384) & 3) + C.lane; const float* pe = which ? C.pos_v : C.pos_k; const float* w1 = which ? C.cv_w1 : C.ck_w1;
                for (int i = C.tid; i < 2048; i += NTHREADS) posl[i] = pe[i];
                __syncthreads();
                const float* wp = w1 + (size_t)(256 * C.wave) * 256 + n; const LAS float* pp = posl + 256 * C.wave;
#pragma unroll 16
                for (int k = 0; k < 256; ++k) acc += pp[k] * wp[(size_t)k * 256];
            }
            part[C.wave * 64 + C.lane] = acc;
            __syncthreads();
            if (C.wave == 0) {
                float s = 0.f;
#pragma unroll
                for (int w = 0; w < 8; ++w) s += part[w * 64 + C.lane];
                if (tk < 384) { const int layer = tk / 192, cg = tk % 192, col = 32 * cg + (C.lane & 31), bb = C.lane >> 5;
                    ((float*)(ws + WS_MODV))[(size_t)(layer * 2 + bb) * 6144 + col] = s + C.mod_b[layer * 6144 + col]; }
                else { const int which = (tk - 384) >> 2, n = 64 * ((tk - 384) & 3) + C.lane; ((float*)(ws + WS_CB1))[which * 256 + n] = s; }
            }
            __syncthreads();
        }
    }
    LAS float* scr = (LAS float*)(C.lds + C.wave * 16384);
    const int gw = C.vcu * NWAVES + C.wave, NGW = C.G * NWAVES;
    constexpr int NITEMS = tj_items(D, 1280) + tj_items(D, 1536) + tj_items(D, 24) + tj_items(D, D) + 2 * tj_items(D, DFF) + tj_items(DFF, D) + tj_items(D, 3072) + tj_items(D, D) + 2 * tj_items(D, DFF) + tj_items(DFF, D)
        + 2 * tj_items(2048, 256) + 2 * tj_items(256, 64);
    __syncthreads();
    for (int it = gw; it < NITEMS; it += NGW) {
        int r = it;
#define TJ(Wp, K_, N_, c0_, w_, WT_, r0_) { constexpr int cnt_ = tj_items(K_, w_); if (r < cnt_) { p0_transpose_item(Wp, K_, N_, c0_, w_, (bf16*)(WT_), r0_, scr, r, C.lane); continue; } r -= cnt_; }
        TJ(C.hyb_w_in, D, 2840, 0, 1280, ws + WS_WIN0, 0)
        TJ(C.hyb_w_in, D, 2840, 1304, 1536, ws + WS_WIN0, 1280)
        TJ(C.hyb_w_in, D, 2840, 1280, 24, ws + WS_WIN0, 2816)
        TJ(C.hyb_w_out, D, D, 0, D, ws + WS_WOUT0, 0)
        TJ(C.w_gate, D, DFF, 0, DFF, ws + WS_WG0, 0)
        TJ(C.w_up, D, DFF, 0, DFF, ws + WS_WU0, 0)
        TJ(C.w_down, DFF, D, 0, D, ws + WS_WD0, 0)
        TJ(C.diff_w_qkv, D, 3072, 0, 3072, ws + WS_WQKV1, 0)
        TJ(C.diff_w_out, D, D, 0, D, ws + WS_WOUT1, 0)
        TJ(C.w_gate + (size_t)D * DFF, D, DFF, 0, DFF, ws + WS_WG1, 0)
        TJ(C.w_up + (size_t)D * DFF, D, DFF, 0, DFF, ws + WS_WU1, 0)
        TJ(C.w_down + (size_t)D * DFF, DFF, D, 0, D, ws + WS_WD1, 0)
        TJ(C.ck_w1, 2048, 256, 0, 256, ws + WS_CW1T, 0)
        TJ(C.cv_w1, 2048, 256, 0, 256, ws + WS_CW1T + 1 * MiB, 0)
        TJ(C.ck_w2, 256, 64, 0, 64, ws + WS_CW2T, 0)
        TJ(C.cv_w2, 256, 64, 0, 64, ws + WS_CW2T + 32 * KiB, 0)
#undef TJ
    }
    { GAS v4u* z = (GAS v4u*)(ws + WS_WIN0 + (size_t)2840 * D * 2); const int n16 = (3072 - 2840) * D * 2 / 16;
      for (int i = C.vcu * NTHREADS + C.tid; i < n16; i += C.G * NTHREADS) z[i] = (v4u){0u, 0u, 0u, 0u}; }
    { float* cs = (float*)(ws + WS_CS);
      for (int e = C.vcu * NTHREADS + C.tid; e < M * 8; e += C.G * NTHREADS) {
          const int m = e >> 3, i = e & 7;
          const double inv = (i == 0) ? 1.0 : (i == 1) ? 0.19392274474868576 : (i == 2) ? 0.03760603093086393 : (i == 3) ? 0.007292664737217109 : (i == 4) ? 0.001414213562373095 : (i == 5) ? 0.0002742481756762073
                              : (i == 6) ? 5.318295896944988e-05 : 1.031338537721246e-05;
          const double rev = (double)C.positions[m] * inv * 0.15915494309189535; const float fr = (float)(rev - floor(rev));
          cs[(size_t)m * 16 + i] = __builtin_amdgcn_cosf(fr); cs[(size_t)m * 16 + 8 + i] = __builtin_amdgcn_sinf(fr); } }
}

__device__ __forceinline__ void norm_mod_rows(const Ctx& C, const float* X, const float* gain, const float* shv, const float* scv, bf16* XN) {
    const int gw = C.vcu * NWAVES + C.wave, NGW = C.G * NWAVES;
    for (int m = gw; m < M; m += NGW) {
        const int b = m >> 13; const GAS f32x4* xr = (const GAS f32x4*)(X + (size_t)m * D) + C.lane;
        f32x4 v[4]; float s = 0.f;
#pragma unroll
        for (int j = 0; j < 4; ++j) { v[j] = xr[64 * j]; s += (v[j].x * v[j].x + v[j].y * v[j].y) + (v[j].z * v[j].z + v[j].w * v[j].w); }
        const float rs = 1.0f / sqrtf(wave_sum(s) * (1.f / D) + RMS_EPS);
        GAS unsigned long long* o8 = (GAS unsigned long long*)(XN + (size_t)m * D) + C.lane;
#pragma unroll
        for (int j = 0; j < 4; ++j) { const int col = 4 * (64 * j + C.lane);
            const f32x4 g4 = *(const GAS f32x4*)(gain + col), sh4 = *(const GAS f32x4*)(shv + (size_t)b * 6144 + col), sc4 = *(const GAS f32x4*)(scv + (size_t)b * 6144 + col);
            const f32x4 h = v[j] * rs * g4 * (sc4 + 1.0f) + sh4;
            o8[64 * j] = (unsigned long long)pk2(h.x, h.y) | ((unsigned long long)pk2(h.z, h.w) << 32); }
    }
}
__device__ __forceinline__ void final_norm_rows(const Ctx& C, float* X, const float* gain) {
    const int gw = C.vcu * NWAVES + C.wave, NGW = C.G * NWAVES;
    for (int m = gw; m < M; m += NGW) {
        GAS f32x4* xr = (GAS f32x4*)(X + (size_t)m * D) + C.lane;
        f32x4 v[4]; float s = 0.f;
#pragma unroll
        for (int j = 0; j < 4; ++j) { v[j] = xr[64 * j]; s += (v[j].x * v[j].x + v[j].y * v[j].y) + (v[j].z * v[j].z + v[j].w * v[j].w); }
        const float rs = 1.0f / sqrtf(wave_sum(s) * (1.f / D) + RMS_EPS);
#pragma unroll
        for (int j = 0; j < 4; ++j) { const f32x4 g4 = *(const GAS f32x4*)(gain + 4 * (64 * j + C.lane)); xr[64 * j] = v[j] * rs * g4; }
    }
}
__device__ __forceinline__ void diff_combine_rows(const Ctx& C, const bf16* O1, const bf16* O2, bf16* OC) {
    const int gw = C.vcu * NWAVES + C.wave, NGW = C.G * NWAVES;
    const float lam = __expf(wave_sum(C.lq1[C.lane] * C.lk1[C.lane])) - __expf(wave_sum(C.lq2[C.lane] * C.lk2[C.lane])) + LAMBDA_INIT;
    float sl[16];
#pragma unroll
    for (int i = 0; i < 16; ++i) sl[i] = C.subln[(16 * C.lane + i) & 127] * (1.0f - LAMBDA_INIT);
    for (int m = gw; m < M; m += NGW) {
        const GAS v4u* p1 = (const GAS v4u*)(O1 + (size_t)m * D + 16 * C.lane); const GAS v4u* p2 = (const GAS v4u*)(O2 + (size_t)m * D + 16 * C.lane);
        float o[16]; float ss = 0.f;
#pragma unroll
        for (int h = 0; h < 2; ++h) { const v4u a = p1[h], bq = p2[h];
#pragma unroll
            for (int e = 0; e < 4; ++e) { const unsigned ua = e == 0 ? a.x : e == 1 ? a.y : e == 2 ? a.z : a.w, ub = e == 0 ? bq.x : e == 1 ? bq.y : e == 2 ? bq.z : bq.w;
                o[8 * h + 2 * e] = __uint_as_float(ua << 16) - lam * __uint_as_float(ub << 16); o[8 * h + 2 * e + 1] = __uint_as_float(ua & 0xffff0000u) - lam * __uint_as_float(ub & 0xffff0000u); } }
#pragma unroll
        for (int i = 0; i < 16; ++i) ss += o[i] * o[i];
        ss += __shfl_xor(ss, 1); ss += __shfl_xor(ss, 2); ss += __shfl_xor(ss, 4);
        const float rs = 1.0f / sqrtf(ss * (1.f / 128.f) + RMS_EPS);
        v4u w0, w1;
        w0.x = pk2(o[0] * rs * sl[0], o[1] * rs * sl[1]); w0.y = pk2(o[2] * rs * sl[2], o[3] * rs * sl[3]); w0.z = pk2(o[4] * rs * sl[4], o[5] * rs * sl[5]); w0.w = pk2(o[6] * rs * sl[6], o[7] * rs * sl[7]);
        w1.x = pk2(o[8] * rs * sl[8], o[9] * rs * sl[9]); w1.y = pk2(o[10] * rs * sl[10], o[11] * rs * sl[11]); w1.z = pk2(o[12] * rs * sl[12], o[13] * rs * sl[13]); w1.w = pk2(o[14] * rs * sl[14], o[15] * rs * sl[15]);
        GAS v4u* q = (GAS v4u*)(OC + (size_t)m * D + 16 * C.lane); q[0] = w0; q[1] = w1;
    }
}

__device__ __forceinline__ void compress_unit(const Ctx& C, int unit) {
    typedef float f32x16 __attribute__((ext_vector_type(16)));
    const int which = unit >> 6, b = (unit >> 5) & 1, g = (unit >> 4) & 1, cb = unit & 15;
    const int lane = C.lane, n = lane & 31, hi = lane >> 5, w = C.wave;
    const bf16* PR = (const bf16*)(C.ws + WS_PR); const bf16* W1T = (const bf16*)(C.ws + WS_CW1T + (size_t)which * MiB); const bf16* W2T = (const bf16*)(C.ws + WS_CW2T + (size_t)which * 32 * KiB);
    const float* cb1 = (const float*)(C.ws + WS_CB1) + which * 256;
    LAS bf16* H = (LAS bf16*)C.lds;
    int c = 32 * cb + n; if (c > 510) c = 510;
    const bf16* ap = PR + ((size_t)(b * T + 16 * c)) * NPROJ + (which ? C_VC : C_KC) + g * 64 + 8 * hi;
    const bf16* bp = W1T + (size_t)(32 * w + n) * 2048 + 8 * hi;
    f32x16 acc = {};
#pragma unroll 4
    for (int ks = 0; ks < 128; ++ks) {
        const bf16x8 a = *(const GAS bf16x8*)(ap + (size_t)(ks >> 2) * NPROJ + (ks & 3) * 16);
        const bf16x8 bb = *(const GAS bf16x8*)(bp + ks * 16);
        acc = __builtin_amdgcn_mfma_f32_32x32x16_bf16(a, bb, acc, 0, 0, 0);
    }
    { const float bias = cb1[32 * w + n];
#pragma unroll
      for (int r = 0; r < 16; ++r) { const int row = (r & 3) + 8 * (r >> 2) + 4 * hi; float v = acc[r] + bias; v = v / (1.f + __expf(-v)); H[row * 256 + 32 * w + n] = (bf16)f2bf(v); } }
    __syncthreads();
    if (w < 2) {
        f32x16 a2 = {};
#pragma unroll
        for (int ks = 0; ks < 16; ++ks) {
            const bf16x8 a = *(const LAS bf16x8*)(H + n * 256 + ks * 16 + 8 * hi);
            const bf16x8 bb = *(const GAS bf16x8*)(W2T + (size_t)(32 * w + n) * 256 + ks * 16 + 8 * hi);
            a2 = __builtin_amdgcn_mfma_f32_32x32x16_bf16(a, bb, a2, 0, 0, 0);
        }
        bf16* OUT = (bf16*)(C.ws + (which ? WS_VCMP : WS_KCMP)) + (size_t)((b * 2 + g) * 512) * 64;
        const float* cs = (const float*)(C.ws + WS_CS);
#pragma unroll
        for (int r = 0; r < 16; ++r) {
            const int row = (r & 3) + 8 * (r >> 2) + 4 * hi, cc = 32 * cb + row;
            float v = a2[r];
            if (which == 0 && w == 0) {
                const float pv = __shfl_xor(v, 8);
                if (n < 16) { const int cq = cc > 510 ? 510 : cc; const float* t = cs + ((size_t)(b * T + 16 * cq + 31)) * 16; const float co = t[n & 7], si = t[8 + (n & 7)];
                    v = (n < 8) ? (v * co - pv * si) : (v * co + pv * si); }
            }
            if (cc > 510) v = 0.f;
            OUT[(size_t)cc * 64 + 32 * w + n] = (bf16)f2bf(v);
        }
    }
    __syncthreads();
}

__device__ __forceinline__ void score4(const unsigned (&q)[4][32], const bf16* kp, float& s0, float& s1, float& s2, float& s3) {
    s0 = s1 = s2 = s3 = 0.f;
#pragma unroll
    for (int cch = 0; cch < 8; ++cch) { const v4u kv = ((const GAS v4u*)kp)[cch];
#pragma unroll
        for (int e = 0; e < 4; ++e) { const unsigned kw = e == 0 ? kv.x : e == 1 ? kv.y : e == 2 ? kv.z : kv.w;
            s0 = dot2(kw, q[0][4 * cch + e], s0); s1 = dot2(kw, q[1][4 * cch + e], s1); s2 = dot2(kw, q[2][4 * cch + e], s2); s3 = dot2(kw, q[3][4 * cch + e], s3); } }
}
__device__ __forceinline__ void nsa_query(const Ctx& C, int b, int t, int g, LAS unsigned char* wl) {
    const int lane = C.lane; const bf16* PR = (const bf16*)(C.ws + WS_PR); const size_t row = (size_t)b * T + t;
    LAS f32x4* sc = (LAS f32x4*)wl; LAS unsigned* qd = (LAS unsigned*)(wl + 16384);
    { const GAS unsigned* qsrc = (const GAS unsigned*)(PR + row * NPROJ + C_QN + g * 256); qd[lane] = qsrc[lane]; qd[lane + 64] = qsrc[lane + 64]; }
    CFENCE();
    unsigned q[4][32];
#pragma unroll
    for (int h = 0; h < 4; ++h)
#pragma unroll
        for (int i = 0; i < 8; ++i) { const v4u tq = ((const LAS v4u*)qd)[h * 8 + i]; q[h][4 * i] = tq.x; q[h][4 * i + 1] = tq.y; q[h][4 * i + 2] = tq.z; q[h][4 * i + 3] = tq.w; }
    float gate; { float glv = 0.f; if (lane < 12) glv = bf2f(PR[row * NPROJ + C_GL + g * 12 + lane]); gate = 1.f / (1.f + __expf(-glv)); }
    float oacc[4] = {0.f, 0.f, 0.f, 0.f};
    const int cur = t >> 6;
    const int nvalid = (t >= 31) ? (((t - 31) >> 4) + 1) : 0;
    float imp0 = 0.f, imp1 = 0.f;
    if (nvalid > 0) {
        const bf16* KC = (const bf16*)(C.ws + WS_KCMP) + (size_t)((b * 2 + g) * 512) * 64; const bf16* VC = (const bf16*)(C.ws + WS_VCMP) + (size_t)((b * 2 + g) * 512) * 64;
        float m0 = -1e30f, m1 = -1e30f, m2 = -1e30f, m3 = -1e30f;
        for (int cc = lane; cc < nvalid; cc += 64) { float s0, s1, s2, s3; score4(q, KC + (size_t)cc * 64, s0, s1, s2, s3); sc[cc] = (f32x4){s0, s1, s2, s3}; m0 = fmaxf(m0, s0); m1 = fmaxf(m1, s1); m2 = fmaxf(m2, s2); m3 = fmaxf(m3, s3); }
        m0 = wave_max(m0); m1 = wave_max(m1); m2 = wave_max(m2); m3 = wave_max(m3);
        float l0 = 0.f, l1 = 0.f, l2 = 0.f, l3 = 0.f;
        for (int cc = lane; cc < nvalid; cc += 64) { f32x4 s = sc[cc]; s.x = __builtin_amdgcn_exp2f(s.x - m0); s.y = __builtin_amdgcn_exp2f(s.y - m1); s.z = __builtin_amdgcn_exp2f(s.z - m2); s.w = __builtin_amdgcn_exp2f(s.w - m3); sc[cc] = s; l0 += s.x; l1 += s.y; l2 += s.z; l3 += s.w; }
        const float i0 = 1.f / wave_sum(l0), i1 = 1.f / wave_sum(l1), i2 = 1.f / wave_sum(l2), i3 = 1.f / wave_sum(l3);
        CFENCE();
#pragma unroll
        for (int half = 0; half < 2; ++half) { const int nb = lane + 64 * half; float a = 0.f;
            for (int cc = 4 * nb - 1; cc <= 4 * nb + 3; ++cc) if (cc >= 0 && cc < nvalid) { const f32x4 p = sc[cc]; a += p.x * i0 + p.y * i1 + p.z * i2 + p.w * i3; }
            if (half == 0) imp0 = a; else imp1 = a; }
        float a0 = 0.f, a1 = 0.f, a2 = 0.f, a3 = 0.f;
        for (int cc = 0; cc < nvalid; ++cc) { const f32x4 p = sc[cc]; const float v = bf2f(VC[(size_t)cc * 64 + lane]); a0 += p.x * v; a1 += p.y * v; a2 += p.z * v; a3 += p.w * v; }
        oacc[0] += __shfl(gate, 0) * a0 * i0; oacc[1] += __shfl(gate, 3) * a1 * i1; oacc[2] += __shfl(gate, 6) * a2 * i2; oacc[3] += __shfl(gate, 9) * a3 * i3;
        CFENCE();
    }
    int sel[16];
    {
        float v0, v1;
        { const int nb = lane; const bool forced = (nb == 0) || (nb == cur) || (nb == cur - 1); v0 = forced ? 1e9f : (nb <= cur ? imp0 : -1e9f); }
        { const int nb = lane + 64; const bool forced = (nb == cur) || (nb == cur - 1); v1 = forced ? 1e9f : (nb <= cur ? imp1 : -1e9f); }
#pragma unroll
        for (int i = 0; i < 16; ++i) {
            float bv; int bi; if (v0 >= v1) { bv = v0; bi = lane; } else { bv = v1; bi = lane + 64; }
#pragma unroll
            for (int off = 32; off >= 1; off >>= 1) { const float ov = __shfl_xor(bv, off); const int oi = __shfl_xor(bi, off); if (ov > bv || (ov == bv && oi < bi)) { bv = ov; bi = oi; } }
            sel[i] = bi; if (bi == lane) v0 = -3e38f; if (bi == lane + 64) v1 = -3e38f;
        }
    }
    {
        float m0 = -1e30f, m1 = -1e30f, m2 = -1e30f, m3 = -1e30f;
#pragma unroll
        for (int i = 0; i < 16; ++i) {
            const int blk = __builtin_amdgcn_readfirstlane(sel[i]);
            if (blk <= cur) { const int tok = blk * 64 + lane; float s0, s1, s2, s3; score4(q, PR + ((size_t)b * T + tok) * NPROJ + C_KS + g * 64, s0, s1, s2, s3);
                if (tok <= t) { m0 = fmaxf(m0, s0); m1 = fmaxf(m1, s1); m2 = fmaxf(m2, s2); m3 = fmaxf(m3, s3); } else { s0 = s1 = s2 = s3 = -1e30f; }
                sc[i * 64 + lane] = (f32x4){s0, s1, s2, s3}; }
        }
        m0 = wave_max(m0); m1 = wave_max(m1); m2 = wave_max(m2); m3 = wave_max(m3);
        float l0 = 0.f, l1 = 0.f, l2 = 0.f, l3 = 0.f;
#pragma unroll
        for (int i = 0; i < 16; ++i) {
            const int blk = __builtin_amdgcn_readfirstlane(sel[i]);
            if (blk <= cur) { f32x4 s = sc[i * 64 + lane]; const bool ok = (blk * 64 + lane) <= t;
                s.x = ok ? __builtin_amdgcn_exp2f(s.x - m0) : 0.f; s.y = ok ? __builtin_amdgcn_exp2f(s.y - m1) : 0.f; s.z = ok ? __builtin_amdgcn_exp2f(s.z - m2) : 0.f; s.w = ok ? __builtin_amdgcn_exp2f(s.w - m3) : 0.f;
                sc[i * 64 + lane] = s; l0 += s.x; l1 += s.y; l2 += s.z; l3 += s.w; }
        }
        const float i0 = 1.f / wave_sum(l0), i1 = 1.f / wave_sum(l1), i2 = 1.f / wave_sum(l2), i3 = 1.f / wave_sum(l3);
        CFENCE();
        float a0 = 0.f, a1 = 0.f, a2 = 0.f, a3 = 0.f;
#pragma unroll
        for (int i = 0; i < 16; ++i) {
            const int blk = __builtin_amdgcn_readfirstlane(sel[i]);
            if (blk <= cur) { int nj = t - blk * 64 + 1; if (nj > 64) nj = 64; const bf16* vp = PR + ((size_t)b * T + blk * 64) * NPROJ + C_VS + g * 64 + lane;
                for (int j = 0; j < nj; ++j) { const f32x4 p = sc[i * 64 + j]; const float v = bf2f(vp[(size_t)j * NPROJ]); a0 += p.x * v; a1 += p.y * v; a2 += p.z * v; a3 += p.w * v; } }
        }
        oacc[0] += __shfl(gate, 1) * a0 * i0; oacc[1] += __shfl(gate, 4) * a1 * i1; oacc[2] += __shfl(gate, 7) * a2 * i2; oacc[3] += __shfl(gate, 10) * a3 * i3;
        CFENCE();
    }
    {
        float m0 = -1e30f, m1 = -1e30f, m2 = -1e30f, m3 = -1e30f;
#pragma unroll
        for (int i = 0; i < 8; ++i) { const int j = lane + 64 * i, kp = t - 511 + j;
            float s0 = -1e30f, s1 = -1e30f, s2 = -1e30f, s3 = -1e30f;
            if (kp >= 0) { score4(q, PR + ((size_t)b * T + kp) * NPROJ + C_KW + g * 64, s0, s1, s2, s3); m0 = fmaxf(m0, s0); m1 = fmaxf(m1, s1); m2 = fmaxf(m2, s2); m3 = fmaxf(m3, s3); }
            sc[j] = (f32x4){s0, s1, s2, s3}; }
        m0 = wave_max(m0); m1 = wave_max(m1); m2 = wave_max(m2); m3 = wave_max(m3);
        float l0 = 0.f, l1 = 0.f, l2 = 0.f, l3 = 0.f;
#pragma unroll
        for (int i = 0; i < 8; ++i) { const int j = lane + 64 * i; const bool ok = (t - 511 + j) >= 0; f32x4 s = sc[j];
            s.x = ok ? __builtin_amdgcn_exp2f(s.x - m0) : 0.f; s.y = ok ? __builtin_amdgcn_exp2f(s.y - m1) : 0.f; s.z = ok ? __builtin_amdgcn_exp2f(s.z - m2) : 0.f; s.w = ok ? __builtin_amdgcn_exp2f(s.w - m3) : 0.f;
            sc[j] = s; l0 += s.x; l1 += s.y; l2 += s.z; l3 += s.w; }
        const float i0 = 1.f / wave_sum(l0), i1 = 1.f / wave_sum(l1), i2 = 1.f / wave_sum(l2), i3 = 1.f / wave_sum(l3);
        CFENCE();
        float a0 = 0.f, a1 = 0.f, a2 = 0.f, a3 = 0.f;
        const int j0 = (t >= 511) ? 0 : (511 - t); const bf16* vp = PR + ((size_t)b * T + (t - 511)) * NPROJ + C_VW + g * 64 + lane;
        for (int j = j0; j < 512; ++j) { const f32x4 p = sc[j]; const float v = bf2f(vp[(ptrdiff_t)j * NPROJ]); a0 += p.x * v; a1 += p.y * v; a2 += p.z * v; a3 += p.w * v; }
        oacc[0] += __shfl(gate, 2) * a0 * i0; oacc[1] += __shfl(gate, 5) * a1 * i1; oacc[2] += __shfl(gate, 8) * a2 * i2; oacc[3] += __shfl(gate, 11) * a3 * i3;
        CFENCE();
    }
    bf16* OC = (bf16*)(C.ws + WS_OCAT) + row * D + g * 256 + lane;
#pragma unroll
    for (int h = 0; h < 4; ++h) OC[h * 64] = (bf16)f2bf(oacc[h]);
}
__device__ __forceinline__ void sb_query(const Ctx& C, int b, int t, int h, LAS unsigned char* wl) {
    const int lane = C.lane; const bf16* PR = (const bf16*)(C.ws + WS_PR); const size_t row = (size_t)b * T + t;
    LAS float* ab = (LAS float*)wl; LAS unsigned* qd = (LAS unsigned*)(wl + 16384);
    { const GAS unsigned* qsrc = (const GAS unsigned*)(PR + row * NPROJ + C_QS + h * 64); if (lane < 32) qd[lane] = qsrc[lane]; }
    CFENCE();
    unsigned q[32];
#pragma unroll
    for (int i = 0; i < 8; ++i) { const v4u tq = ((const LAS v4u*)qd)[i]; q[4 * i] = tq.x; q[4 * i + 1] = tq.y; q[4 * i + 2] = tq.z; q[4 * i + 3] = tq.w; }
    float o = 0.f, carry = 0.f;
    for (int base = t - 1; base >= 0; base -= 64) {
        const int key = base - lane; const bool valid = key >= 0; const int kc = valid ? key : 0;
        const bf16* kp = PR + ((size_t)b * T + kc) * NPROJ + C_KSB + h * 64;
        float z = 0.f;
#pragma unroll
        for (int cch = 0; cch < 8; ++cch) { const v4u kv = ((const GAS v4u*)kp)[cch]; z = dot2(kv.x, q[4 * cch], z); z = dot2(kv.y, q[4 * cch + 1], z); z = dot2(kv.z, q[4 * cch + 2], z); z = dot2(kv.w, q[4 * cch + 3], z); }
        const float L = __builtin_amdgcn_logf(1.f + __builtin_amdgcn_exp2f(-fabsf(z)));
        const float lk = valid ? -(fmaxf(z, 0.f) + L) : 0.f;
        const float ls = fminf(z, 0.f) - L;
        float inc = lk;
#pragma unroll
        for (int d = 1; d < 64; d <<= 1) { const float tv = __shfl_up(inc, d); if (lane >= d) inc += tv; }
        const float a = valid ? __builtin_amdgcn_exp2f(ls + carry + (inc - lk)) : 0.f;
        CFENCE(); ab[lane] = a; CFENCE();
        const int nv = (base + 1 < 64) ? (base + 1) : 64; const bf16* vp = PR + ((size_t)b * T + base) * NPROJ + C_VSB + h * 64 + lane;
        for (int j = 0; j < nv; ++j) o += ab[j] * bf2f(vp[-(ptrdiff_t)j * NPROJ]);
        carry += __shfl(inc, 63);
        if (carry < -60.f) break;
    }
    ((bf16*)(C.ws + WS_OCAT))[row * D + 512 + h * 64 + lane] = (bf16)f2bf(o);
}
__device__ __forceinline__ void hybrid_attention_phase(const Ctx& C) {
    LAS unsigned char* wl = C.lds + C.wave * WAVE_LDS;
    const int gw = C.vcu * NWAVES + C.wave, NGW = C.G * NWAVES;
    for (int tk = gw; tk < BATCH * 2 * T; tk += NGW) { const int t = tk & (T - 1), g = (tk >> 13) & 1, b = tk >> 14; nsa_query(C, b, t, g, wl); }
    for (int tk = gw; tk < BATCH * 8 * T; tk += NGW) { const int t = tk & (T - 1), h = (tk >> 13) & 7, b = tk >> 16; sb_query(C, b, t, h, wl); }
}
#ifndef PH_MASK
#define PH_MASK 0xFFFFFFu
#endif
struct Args { const void* in[28]; float* out; unsigned char* ws; int ph_lo, ph_hi; };
enum Phase { P_PROLOG = 0, P_NORM0A, P_INPROJ, P_CMP, P_ATT0, P_OUT0, P_NORM0B, P_GATE0, P_UP0, P_DOWN0, P_NORM1A, P_QKV1, P_ATT1, P_COMB1, P_OUT1, P_NORM1B, P_GATE1, P_UP1, P_DOWN1, P_FINAL, N_PHASES };

__global__ void __launch_bounds__(NTHREADS, 2) mega_fwd(Args args) {
    extern __shared__ __attribute__((aligned(16))) unsigned char lds[];
    Ctx C;
    C.lds = (LAS unsigned char*)lds; C.tid = threadIdx.x; C.lane = C.tid & 63; C.wave = __builtin_amdgcn_readfirstlane(C.tid >> 6);
    C.G = gridDim.x; { const int bx = blockIdx.x; C.vcu = (C.G % 8 == 0) ? (bx % 8) * (C.G / 8) + bx / 8 : bx; }
    C.x = (const float*)args.in[0]; C.c = (const float*)args.in[1]; C.positions = (const int*)args.in[2]; C.mod_w = (const float*)args.in[3]; C.mod_b = (const float*)args.in[4];
    C.norm_mix = (const float*)args.in[5]; C.norm_ffn = (const float*)args.in[6]; C.w_gate = (const float*)args.in[7]; C.w_up = (const float*)args.in[8]; C.conv_w = (const float*)args.in[9];
    C.conv_b = (const float*)args.in[10]; C.w_down = (const float*)args.in[11]; C.hyb_w_in = (const float*)args.in[12]; C.pos_k = (const float*)args.in[13]; C.pos_v = (const float*)args.in[14];
    C.ck_w1 = (const float*)args.in[15]; C.ck_w2 = (const float*)args.in[16]; C.cv_w1 = (const float*)args.in[17]; C.cv_w2 = (const float*)args.in[18]; C.hyb_w_out = (const float*)args.in[19];
    C.diff_w_qkv = (const float*)args.in[20]; C.lq1 = (const float*)args.in[21]; C.lk1 = (const float*)args.in[22]; C.lq2 = (const float*)args.in[23]; C.lk2 = (const float*)args.in[24];
    C.subln = (const float*)args.in[25]; C.diff_w_out = (const float*)args.in[26]; C.norm_f = (const float*)args.in[27];
    C.out = args.out; C.ws = args.ws;
    unsigned char* ws = args.ws;
    volatile LAS unsigned* MISC = (volatile LAS unsigned*)(C.lds + MISC_OFF);
    for (int u = C.tid; u < 64; u += NTHREADS) MISC[u] = 0u;
    __syncthreads();
    const int lo = args.ph_lo, hi = args.ph_hi;
    const bool one_launch = (hi - lo) > 1;
    XcdBarrier bar; bar.bar = (unsigned*)(ws + WS_CTL) + CW_BAR; bar.x = 0; bar.st = nullptr;
    if (one_launch) bar = xcd_barrier_post((unsigned*)(ws + WS_CTL) + CW_BAR, MISC + 8);
#define IN(k) (((PH_MASK >> (k)) & 1u) && lo <= (k) && (k) < hi)
#define SEAM(k) do { if (IN(k) && IN((k) + 1)) xcd_barrier(bar); } while (0)
    const float* MODV = (const float*)(ws + WS_MODV);
    const float* CS = (const float*)(ws + WS_CS);
    bf16* XN = (bf16*)(ws + WS_XN);

    if (IN(P_PROLOG)) { p0_prologue(C); } SEAM(P_PROLOG);
    if (IN(P_NORM0A)) { norm_mod_rows(C, C.x, C.norm_mix, MODV + 0, MODV + 1024, XN); } SEAM(P_NORM0A);
    if (IN(P_INPROJ)) {
        pg8::Gemm g{XN, (const bf16*)(ws + WS_WIN0), M, NPROJ, D}; pg8::StaticOrder S; S.init(M, NPROJ, C.G, (int)blockIdx.x);
        pg8::EpiProj E{(bf16*)(ws + WS_PR), NPROJ, CS, 0xFu | (1u << 6) | (1u << 8), 0xFu | (0xFu << 10), QSCALE};
        pg8::gemm_phase<pg8::EpiProj, pg8::StaticOrder, true, true>(C.lds, g, S, E);
    } SEAM(P_INPROJ);
    if (IN(P_CMP)) { for (int u = blockIdx.x; u < 128; u += C.G) compress_unit(C, u); } SEAM(P_CMP);
    if (IN(P_ATT0)) { hybrid_attention_phase(C); } SEAM(P_ATT0);
    if (IN(P_OUT0)) {
        pg8::Gemm g{(const bf16*)(ws + WS_OCAT), (const bf16*)(ws + WS_WOUT0), M, D, D}; pg8::StaticOrder S; S.init(M, D, C.G, (int)blockIdx.x);
        pg8::EpiRes E{C.x, C.out, D, MODV + 2048, 6144};
        pg8::gemm_phase<pg8::EpiRes, pg8::StaticOrder, true, true>(C.lds, g, S, E);
    } SEAM(P_OUT0);
    if (IN(P_NORM0B)) { norm_mod_rows(C, C.out, C.norm_ffn, MODV + 3072, MODV + 4096, XN); } SEAM(P_NORM0B);
    if (IN(P_GATE0)) {
        pg8::Gemm g{XN, (const bf16*)(ws + WS_WG0), M, DFF, D}; pg8::StaticOrder S; S.init(M, DFF, C.G, (int)blockIdx.x);
        pg8::EpiProj E{(bf16*)(ws + WS_G), DFF, CS, 0u, 0u, 1.f};
        pg8::gemm_phase<pg8::EpiProj, pg8::StaticOrder, true, true>(C.lds, g, S, E);
    } SEAM(P_GATE0);
    if (IN(P_UP0)) {
        pg8::Gemm g{XN, (const bf16*)(ws + WS_WU0), M, DFF, D}; pg8::StaticOrder S; S.init(M, DFF, C.G, (int)blockIdx.x);
        pg8::EpiAct E{(bf16*)(ws + WS_ACT), (const bf16*)(ws + WS_G), DFF, C.conv_w, C.conv_b};
        pg8::gemm_phase<pg8::EpiAct, pg8::StaticOrder, true, true>(C.lds, g, S, E);
    } SEAM(P_UP0);
    if (IN(P_DOWN0)) {
        pg8::Gemm g{(const bf16*)(ws + WS_ACT), (const bf16*)(ws + WS_WD0), M, D, DFF}; pg8::StaticOrder S; S.init(M, D, C.G, (int)blockIdx.x);
        pg8::EpiRes E{C.out, C.out, D, MODV + 5120, 6144};
        pg8::gemm_phase<pg8::EpiRes, pg8::StaticOrder, true, true>(C.lds, g, S, E);
    } SEAM(P_DOWN0);
    const float* MODV1 = MODV + 2 * 6144;
    if (IN(P_NORM1A)) { norm_mod_rows(C, C.out, C.norm_mix + D, MODV1 + 0, MODV1 + 1024, XN); } SEAM(P_NORM1A);
    if (IN(P_QKV1)) {
        pg8::Gemm g{XN, (const bf16*)(ws + WS_WQKV1), M, NPROJ, D}; pg8::StaticOrder S; S.init(M, NPROJ, C.G, (int)blockIdx.x);
        pg8::EpiProj E{(bf16*)(ws + WS_PR1), NPROJ, CS, 0xFFFFu, 0xFFu, QSCALE};
        pg8::gemm_phase<pg8::EpiProj, pg8::StaticOrder, true, true>(C.lds, g, S, E);
    } SEAM(P_QKV1);
    if (IN(P_ATT1)) { const attn_body::StaticOrder S(C.vcu); attn_body::diff_attn_phase<NPROJ, D>((char*)lds, (const attn_body::bf16*)(ws + WS_PR1), (attn_body::bf16*)(ws + WS_O1), (attn_body::bf16*)(ws + WS_O2), S); } SEAM(P_ATT1);
    if (IN(P_COMB1)) { diff_combine_rows(C, (const bf16*)(ws + WS_O1), (const bf16*)(ws + WS_O2), XN); } SEAM(P_COMB1);
    if (IN(P_OUT1)) {
        pg8::Gemm g{XN, (const bf16*)(ws + WS_WOUT1), M, D, D}; pg8::StaticOrder S; S.init(M, D, C.G, (int)blockIdx.x);
        pg8::EpiRes E{C.out, C.out, D, MODV1 + 2048, 6144};
        pg8::gemm_phase<pg8::EpiRes, pg8::StaticOrder, true, true>(C.lds, g, S, E);
    } SEAM(P_OUT1);
    if (IN(P_NORM1B)) { norm_mod_rows(C, C.out, C.norm_ffn + D, MODV1 + 3072, MODV1 + 4096, XN); } SEAM(P_NORM1B);
    if (IN(P_GATE1)) {
        pg8::Gemm g{XN, (const bf16*)(ws + WS_WG1), M, DFF, D}; pg8::StaticOrder S; S.init(M, DFF, C.G, (int)blockIdx.x);
        pg8::EpiProj E{(bf16*)(ws + WS_G), DFF, CS, 0u, 0u, 1.f};
        pg8::gemm_phase<pg8::EpiProj, pg8::StaticOrder, true, true>(C.lds, g, S, E);
    } SEAM(P_GATE1);
    if (IN(P_UP1)) {
        pg8::Gemm g{XN, (const bf16*)(ws + WS_WU1), M, DFF, D}; pg8::StaticOrder S; S.init(M, DFF, C.G, (int)blockIdx.x);
        pg8::EpiAct E{(bf16*)(ws + WS_ACT), (const bf16*)(ws + WS_G), DFF, C.conv_w + 3 * DFF, C.conv_b + DFF};
        pg8::gemm_phase<pg8::EpiAct, pg8::StaticOrder, true, true>(C.lds, g, S, E);
    } SEAM(P_UP1);
    if (IN(P_DOWN1)) {
        pg8::Gemm g{(const bf16*)(ws + WS_ACT), (const bf16*)(ws + WS_WD1), M, D, DFF}; pg8::StaticOrder S; S.init(M, D, C.G, (int)blockIdx.x);
        pg8::EpiRes E{C.out, C.out, D, MODV1 + 5120, 6144};
        pg8::gemm_phase<pg8::EpiRes, pg8::StaticOrder, true, true>(C.lds, g, S, E);
    } SEAM(P_DOWN1);
    if (IN(P_FINAL)) { final_norm_rows(C, C.out, C.norm_f); }
#undef IN
#undef SEAM
}

#ifndef MK_PER_PHASE
#define MK_PER_PHASE 0
#endif
extern "C" void kernel_launch(void* const* d_in, const int* in_sizes, int n_in, void* d_out, int out_size, void* d_ws, size_t ws_size, hipStream_t stream) {
    static int grid = 0;
    if (grid == 0) {
        if (n_in != 28 || in_sizes[0] != M * D || out_size != M * D || ws_size < WS_END) { fprintf(stderr, "kernel_launch: unexpected problem (n_in %d, in0 %d, out %d, ws %zu; need ws >= %zu); nothing launched\n", n_in, n_in > 0 ? in_sizes[0] : -1, out_size, ws_size, (size_t)WS_END); grid = -1; return; }
        int dev = 0, cus = 0, per_cu = 0;
        if (hipGetDevice(&dev) != hipSuccess || hipDeviceGetAttribute(&cus, hipDeviceAttributeMultiprocessorCount, dev) != hipSuccess) { fprintf(stderr, "kernel_launch: device query failed\n"); grid = -1; return; }
        if (hipFuncSetAttribute((const void*)mega_fwd, hipFuncAttributeMaxDynamicSharedMemorySize, LDS_BYTES) != hipSuccess) { fprintf(stderr, "kernel_launch: hipFuncSetAttribute failed\n"); grid = -1; return; }
        if (hipOccupancyMaxActiveBlocksPerMultiprocessor(&per_cu, (const void*)mega_fwd, NTHREADS, LDS_BYTES) != hipSuccess || per_cu < 1) { fprintf(stderr, "kernel_launch: occupancy query reports %d workgroups per CU\n", per_cu); per_cu = 1; }
        (void)hipGetLastError();
        grid = cus;
        if (grid % 8 != 0 || grid > 256) { grid = (grid > 256) ? 256 : (grid / 8) * 8; }
        fprintf(stderr, "kernel_launch: grid %d (cus %d, occupancy %d/CU)\n", grid, cus, per_cu);
    }
    if (grid <= 0) return;
    (void)hipMemsetAsync((char*)d_ws + WS_CTL, 0, CTL_ZERO_BYTES, stream);
    Args a{};
    for (int i = 0; i < 28; ++i) a.in[i] = d_in[i];
    a.out = (float*)d_out; a.ws = (unsigned char*)d_ws;
#if MK_PER_PHASE
    for (int p = 0; p < N_PHASES; ++p) { a.ph_lo = p; a.ph_hi = p + 1; hipLaunchKernelGGL(mega_fwd, dim3(grid), dim3(NTHREADS), LDS_BYTES, stream, a); }
#else
    a.ph_lo = 0; a.ph_hi = N_PHASES; hipLaunchKernelGGL(mega_fwd, dim3(grid), dim3(NTHREADS), LDS_BYTES, stream, a);
#endif
    const hipError_t le = hipPeekAtLastError();
    if (le != hipSuccess) fprintf(stderr, "kernel_launch: launch failed: %s\n", hipGetErrorName(le));
}
```

```cpp
#include <hip/hip_runtime.h>
#include <hip/hip_bf16.h>
#include <cstdio>
#include <cstdint>
#include <cmath>
namespace pg8 {
#define PG8_LAS __attribute__((address_space(3)))
typedef unsigned short bf16_t;
typedef short bf16x8 __attribute__((ext_vector_type(8)));
typedef float f32x4 __attribute__((ext_vector_type(4)));
typedef unsigned u32x4 __attribute__((ext_vector_type(4)));
constexpr int BM = 256, BK = 64, HALF = 128, HTB = HALF * BK * 2  , STAGE_BYTES = 8 * HTB, NXCD = 8, WGM = 8;

__host__ __device__ __forceinline__ int lds_byte(int r, int c) { const int st = (r >> 4) * 2 + (c >> 5), rr = r & 15, cc = c & 31, ob = rr * 64 + cc * 2; return st * 1024 + (ob ^ (((ob >> 9) & 1) << 5)); }
__host__ __device__ __forceinline__ void stage_rc(int b, int& R, int& C) { const int st = b / 1024, sb = b % 1024, swz = sb ^ (((sb >> 9) & 1) << 5); R = (st >> 1) * 16 + swz / 64; C = (st & 1) * 32 + (swz % 64) / 2; }
__host__ __device__ __forceinline__ int perm32(int rho) { const int n = rho >> 4, i = rho & 15; return 8 * (i >> 2) + 4 * n + (i & 3); }

struct Unit { int pm, pn; };
struct Gemm { const bf16_t* A; const bf16_t* Bt; int M, N, K; };

struct StaticOrder {
    int nM, nN, nwg, G, c;
    __host__ __device__ void init(int M, int N, int G_, int c_) { nM = M / BM; nN = N / BM; nwg = nM * nN; G = G_; c = c_; }
    __host__ __device__ bool next(int i, Unit& u) const {
        const long L = (long)i * G + c; if (L >= nwg) return false;
        int wgid = (int)L; { const int q = nwg / NXCD, r = nwg % NXCD, xcd = wgid % NXCD, off = wgid / NXCD; wgid = (xcd < r ? xcd * (q + 1) : r * (q + 1) + (xcd - r) * q) + off; }
        const int nig = WGM * nN, gid = wgid / nig, fm = gid * WGM, gsz = (nM - fm) < WGM ? (nM - fm) : WGM;
        u.pm = fm + ((wgid % nig) % gsz); u.pn = (wgid % nig) / gsz; return true;
    }
    __device__ __forceinline__ void a_ready(const Unit&) const {}
    __device__ __forceinline__ void done(const Unit&) const {}
};

__device__ __forceinline__ unsigned cvt_pk_bf16(float lo, float hi) { unsigned r; asm volatile("v_cvt_pk_bf16_f32 %0, %1, %2" : "=v"(r) : "v"(lo), "v"(hi)); return r; }
typedef float f32x2 __attribute__((ext_vector_type(2)));
__device__ __forceinline__ float bflo(unsigned w) { return __uint_as_float(w << 16); }
__device__ __forceinline__ float bfhi(unsigned w) { return __uint_as_float(w & 0xffff0000u); }
struct EpiProj {
    static constexpr bool PERM = true, AFTER_DRAIN = false;
    bf16_t* O; int ldc; const float* cs; unsigned ropemask, scalemask; float qscale;
    __device__ __forceinline__ void operator()(const f32x4 (&acc)[2][2][4][2], const Unit& u, int wr, int wc, int fr, int fq) const {
        const int row0 = u.pm * BM + wr * 64 + fr, col0 = u.pn * BM + wc * 32 + 8 * fq;
#pragma unroll
        for (int bj = 0; bj < 2; ++bj) {
            const unsigned bit = 1u << (2 * u.pn + bj);
            const float sc = (scalemask & bit) ? qscale : 1.f;
            const bool rope = ((ropemask & bit) != 0u) && ((wc & 1) == 0);
#pragma unroll
            for (int ai = 0; ai < 2; ++ai)
#pragma unroll
                for (int m = 0; m < 4; ++m) {
                    const int row = row0 + ai * HALF + m * 16;
                    f32x4 v0 = acc[ai][bj][m][0] * sc, v1 = acc[ai][bj][m][1] * sc;
                    if (rope) {
                        const float* t = cs + (size_t)row * 16;
                        const f32x4 c0 = *(const f32x4*)t, c1 = *(const f32x4*)(t + 4), s0 = *(const f32x4*)(t + 8), s1 = *(const f32x4*)(t + 12);
                        f32x4 p0, p1;
#pragma unroll
                        for (int j = 0; j < 4; ++j) { p0[j] = __shfl_xor(v0[j], 16); p1[j] = __shfl_xor(v1[j], 16); }
                        if (fq < 2) { const float sg = (fq == 0) ? -1.f : 1.f; v0 = v0 * c0 + p0 * s0 * sg; v1 = v1 * c1 + p1 * s1 * sg; }
                    }
                    u32x4 w; w.x = cvt_pk_bf16(v0[0], v0[1]); w.y = cvt_pk_bf16(v0[2], v0[3]); w.z = cvt_pk_bf16(v1[0], v1[1]); w.w = cvt_pk_bf16(v1[2], v1[3]);
                    *(u32x4*)(O + (size_t)row * ldc + col0 + bj * HALF) = w;
                }
        }
    }
};
struct EpiAct {
    static constexpr bool PERM = true, AFTER_DRAIN = false;
    bf16_t* O; const bf16_t* G; int ldc; const float* cw; const float* cb;
    __device__ __forceinline__ void operator()(const f32x4 (&acc)[2][2][4][2], const Unit& u, int wr, int wc, int fr, int fq) const {
        const int row0 = u.pm * BM + wr * 64 + fr, col0 = u.pn * BM + wc * 32 + 8 * fq;
#pragma unroll
        for (int bj = 0; bj < 2; ++bj) {
            const int col = col0 + bj * HALF;
            f32x4 k0[2], k1[2], k2[2], bb[2];
#pragma unroll
            for (int n = 0; n < 2; ++n) { k0[n] = *(const f32x4*)(cw + col + 4 * n); k1[n] = *(const f32x4*)(cw + ldc + col + 4 * n); k2[n] = *(const f32x4*)(cw + 2 * ldc + col + 4 * n); bb[n] = *(const f32x4*)(cb + col + 4 * n); }
#pragma unroll
            for (int ai = 0; ai < 2; ++ai)
#pragma unroll
                for (int m = 0; m < 4; ++m) {
                    const int row = row0 + ai * HALF + m * 16, t = row & 8191;
                    const bf16_t* gp = G + (size_t)row * ldc + col;
                    const u32x4 g2 = *(const u32x4*)gp;
                    u32x4 g1 = (u32x4){0u, 0u, 0u, 0u}, g0 = (u32x4){0u, 0u, 0u, 0u};
                    if (t >= 1) g1 = *(const u32x4*)(gp - ldc);
                    if (t >= 2) g0 = *(const u32x4*)(gp - 2 * ldc);
                    f32x4 r[2];
#pragma unroll
                    for (int n = 0; n < 2; ++n) {
                        const unsigned a0 = n ? g0.z : g0.x, a1 = n ? g0.w : g0.y, b0 = n ? g1.z : g1.x, b1 = n ? g1.w : g1.y, c0 = n ? g2.z : g2.x, c1 = n ? g2.w : g2.y;
                        f32x4 x0 = (f32x4){bflo(a0), bfhi(a0), bflo(a1), bfhi(a1)}, x1 = (f32x4){bflo(b0), bfhi(b0), bflo(b1), bfhi(b1)}, x2 = (f32x4){bflo(c0), bfhi(c0), bflo(c1), bfhi(c1)};
                        f32x4 cv = k0[n] * x0 + k1[n] * x1 + k2[n] * x2 + bb[n];
#pragma unroll
                        for (int j = 0; j < 4; ++j) { const float e = __builtin_amdgcn_exp2f(-1.4426950408889634f * cv[j]); cv[j] = cv[j] * __builtin_amdgcn_rcpf(1.f + e); }
                        r[n] = cv * acc[ai][bj][m][n];
                    }
                    u32x4 w; w.x = cvt_pk_bf16(r[0][0], r[0][1]); w.y = cvt_pk_bf16(r[0][2], r[0][3]); w.z = cvt_pk_bf16(r[1][0], r[1][1]); w.w = cvt_pk_bf16(r[1][2], r[1][3]);
                    *(u32x4*)(O + (size_t)row * ldc + col) = w;
                }
        }
    }
};
struct EpiRes {
    static constexpr bool PERM = false, AFTER_DRAIN = false;
    const float* base; float* out; int ldc; const float* gate; int gstride;
    __device__ __forceinline__ void operator()(const f32x4 (&acc)[2][2][4][2], const Unit& u, int wr, int wc, int fr, int fq) const {
        const int col0 = u.pn * BM + wc * 32 + 4 * fq; const float* gp = gate + (size_t)((u.pm * BM) >> 13) * gstride;
        f32x4 gv[2][2];
#pragma unroll
        for (int bj = 0; bj < 2; ++bj)
#pragma unroll
            for (int n = 0; n < 2; ++n) gv[bj][n] = *(const f32x4*)(gp + col0 + bj * HALF + n * 16);
#pragma unroll
        for (int ai = 0; ai < 2; ++ai)
#pragma unroll
            for (int m = 0; m < 4; ++m) { const size_t off = (size_t)(u.pm * BM + ai * HALF + wr * 64 + m * 16 + fr) * ldc + col0;
#pragma unroll
                for (int bj = 0; bj < 2; ++bj)
#pragma unroll
                    for (int n = 0; n < 2; ++n) { const f32x4 bs = *(const f32x4*)(base + off + bj * HALF + n * 16); *(f32x4*)(out + off + bj * HALF + n * 16) = bs + gv[bj][n] * acc[ai][bj][m][n]; }
                if (m & 1) asm volatile("" ::: "memory"); }
    }
};
template <class Epi, class Sched, bool ALIGN_EPI = false, bool SP2 = false>
__device__ __forceinline__ void gemm_phase(PG8_LAS unsigned char* lds, const Gemm g, const Sched& S, const Epi& E) {
    const int tid = threadIdx.x, wid = __builtin_amdgcn_readfirstlane(tid >> 6), lane = tid & 63, wr = wid >> 2, wc = wid & 3, fr = lane & 15, fq = lane >> 4;
    const int K = g.K, nt = K / BK;
    unsigned voffA[2], voffB[2];
#pragma unroll
    for (int i = 0; i < 2; ++i) { int R, C; stage_rc(tid * 16 + i * 8192, R, C); const int Rb = Epi::PERM ? ((R & ~31) + perm32(R & 31)) : R;
        voffA[i] = (unsigned)(R * K + C) * 2u; voffB[i] = (unsigned)(Rb * K + C) * 2u; }
    const size_t kstep = (size_t)(BK * 2);
    const size_t hstep = (size_t)HALF * K * 2;
    const size_t tstep = 2 * hstep;
    const unsigned ldsw = (unsigned)wid * 1024u;
    const int aoff = lds_byte(wr * 64 + fr, fq * 8), boff = lds_byte(wc * 32 + fr, fq * 8);
#define PG8_SA(b, h) (((b) * 2 + (h)) * HTB)
#define PG8_SB(b, h) ((4 + (b) * 2 + (h)) * HTB)
#define PG8_STAGE(bufoff, gbase, voff) do { _Pragma("unroll") for (int _i = 0; _i < 2; ++_i) \
        __builtin_amdgcn_global_load_lds((const unsigned*)((const char*)(gbase) + (voff)[_i]), (PG8_LAS unsigned*)(lds + (bufoff) + ldsw + _i * 8192), 16, 0, 0); } while (0)
#define PG8_LDA(dst, b, h) do { _Pragma("unroll") for (int m = 0; m < 4; ++m) _Pragma("unroll") for (int k = 0; k < 2; ++k) dst[m][k] = *(const PG8_LAS bf16x8*)(lds + PG8_SA(b, h) + aoff + m * 2048 + k * 1024); } while (0)
#define PG8_LDB(dst, b, h) do { _Pragma("unroll") for (int n = 0; n < 2; ++n) _Pragma("unroll") for (int k = 0; k < 2; ++k) dst[n][k] = *(const PG8_LAS bf16x8*)(lds + PG8_SB(b, h) + boff + n * 2048 + k * 1024); } while (0)
#define PG8_MMA(ai, bj, At, Bt) do { __builtin_amdgcn_s_setprio(1); _Pragma("unroll") for (int m = 0; m < 4; ++m) _Pragma("unroll") for (int n = 0; n < 2; ++n) _Pragma("unroll") for (int k = 0; k < 2; ++k) \
        acc[ai][bj][m][n] = __builtin_amdgcn_mfma_f32_16x16x32_bf16(Bt[n][k], At[m][k], acc[ai][bj][m][n], 0, 0, 0); __builtin_amdgcn_s_setprio(0); } while (0)
#define PG8_WAIT_V(n) asm volatile("s_waitcnt vmcnt(" #n ")" ::: "memory")
#define PG8_WAIT_L(n) asm volatile("s_waitcnt lgkmcnt(" #n ")" ::: "memory")
#define PG8_BAR __builtin_amdgcn_s_barrier()
#define PG8_SCHED __builtin_amdgcn_sched_barrier(0)
    Unit cur, nxt; int ui = 0;
    if (!S.next(0, cur)) return;
    f32x4 acc[2][2][4][2];
#pragma unroll
    for (int a = 0; a < 2; ++a)
#pragma unroll
        for (int b = 0; b < 2; ++b)
#pragma unroll
            for (int m = 0; m < 4; ++m)
#pragma unroll
                for (int n = 0; n < 2; ++n) acc[a][b][m][n] = (f32x4){0.f, 0.f, 0.f, 0.f};
    bf16x8 At[4][2], B0[2][2], B1[2][2];
    const char* cA = (const char*)g.A + (size_t)cur.pm * tstep; const char* cB = (const char*)g.Bt + (size_t)cur.pn * tstep;
    S.a_ready(cur);
    if constexpr (SP2) {
        PG8_STAGE(PG8_SB(0, 0), cB, voffB); PG8_STAGE(PG8_SB(0, 1), cB + hstep, voffB); PG8_STAGE(PG8_SA(0, 0), cA, voffA); PG8_STAGE(PG8_SA(0, 1), cA + hstep, voffA);
        if (wr == 1) PG8_BAR;
        PG8_WAIT_V(2); PG8_BAR;
        PG8_STAGE(PG8_SB(1, 0), cB + kstep, voffB); PG8_STAGE(PG8_SA(1, 0), cA + kstep, voffA); PG8_STAGE(PG8_SB(1, 1), cB + hstep + kstep, voffB);
        PG8_WAIT_V(6); PG8_BAR;
    } else {
        PG8_STAGE(PG8_SB(0, 0), cB, voffB); PG8_STAGE(PG8_SA(0, 0), cA, voffA); PG8_STAGE(PG8_SB(0, 1), cB + hstep, voffB); PG8_STAGE(PG8_SA(0, 1), cA + hstep, voffA);
        if (wr == 1) PG8_BAR;
        PG8_WAIT_V(4); PG8_BAR;
        PG8_STAGE(PG8_SB(1, 0), cB + kstep, voffB); PG8_STAGE(PG8_SA(1, 0), cA + kstep, voffA); PG8_STAGE(PG8_SB(1, 1), cB + hstep + kstep, voffB);
        PG8_WAIT_V(6); PG8_BAR;
    }
    for (;;) {
        const bool has_next = S.next(ui + 1, nxt);
        const char* nA = has_next ? (const char*)g.A + (size_t)nxt.pm * tstep : cA; const char* nB = has_next ? (const char*)g.Bt + (size_t)nxt.pn * tstep : cB;
        for (int t = 0; t < nt; t += 2) {
            const bool last = (t == nt - 2);
            const char* a1 = cA + (size_t)(t + 1) * kstep;
            const char* a2 = last ? nA : cA + (size_t)(t + 2) * kstep; const char* b2 = last ? nB : cB + (size_t)(t + 2) * kstep;
            const char* a3 = a2 + kstep; const char* b3 = b2 + kstep;
            if (last && has_next) S.a_ready(nxt);
            if constexpr (SP2) {
            PG8_LDB(B0, 0, 0); PG8_LDB(B1, 0, 1); PG8_SCHED; PG8_LDA(At, 0, 0); PG8_STAGE(PG8_SA(1, 1), a1 + hstep, voffA);
            PG8_WAIT_V(8); PG8_WAIT_L(0); PG8_BAR; PG8_MMA(0, 0, At, B0); PG8_MMA(0, 1, At, B1); PG8_BAR; PG8_SCHED;
            PG8_LDA(At, 0, 1); PG8_STAGE(PG8_SB(0, 0), b2, voffB); PG8_STAGE(PG8_SB(0, 1), b2 + hstep, voffB); PG8_STAGE(PG8_SA(0, 0), a2, voffA);
            PG8_WAIT_V(8); PG8_WAIT_L(0); PG8_BAR; PG8_MMA(1, 0, At, B0); PG8_MMA(1, 1, At, B1); PG8_BAR; PG8_SCHED;
            PG8_LDB(B0, 1, 0); PG8_LDB(B1, 1, 1); PG8_SCHED; PG8_LDA(At, 1, 0); PG8_STAGE(PG8_SA(0, 1), a2 + hstep, voffA);
            PG8_WAIT_V(8); PG8_WAIT_L(0); PG8_BAR; PG8_MMA(0, 0, At, B0); PG8_MMA(0, 1, At, B1); PG8_BAR; PG8_SCHED;
            PG8_LDA(At, 1, 1); PG8_STAGE(PG8_SB(1, 0), b3, voffB); PG8_STAGE(PG8_SB(1, 1), b3 + hstep, voffB); PG8_STAGE(PG8_SA(1, 0), a3, voffA);
            PG8_WAIT_V(8); PG8_WAIT_L(0); PG8_BAR; PG8_MMA(1, 0, At, B0); PG8_MMA(1, 1, At, B1); PG8_BAR; PG8_SCHED;
            } else {
            PG8_LDB(B0, 0, 0); PG8_SCHED; PG8_LDA(At, 0, 0); PG8_STAGE(PG8_SA(1, 1), a1 + hstep, voffA);
            PG8_WAIT_L(8); PG8_BAR; PG8_WAIT_L(0); PG8_MMA(0, 0, At, B0); PG8_BAR; PG8_SCHED;
            PG8_LDB(B1, 0, 1); PG8_STAGE(PG8_SB(0, 0), b2, voffB);
            PG8_BAR; PG8_WAIT_L(0); PG8_MMA(0, 1, At, B1); PG8_BAR;
            PG8_LDA(At, 0, 1); PG8_STAGE(PG8_SA(0, 0), a2, voffA);
            PG8_BAR; PG8_WAIT_L(0); PG8_MMA(1, 0, At, B0); PG8_BAR; PG8_SCHED;
            PG8_STAGE(PG8_SB(0, 1), b2 + hstep, voffB);
            PG8_WAIT_V(6); PG8_BAR; PG8_MMA(1, 1, At, B1); PG8_BAR;
            PG8_LDB(B0, 1, 0); PG8_SCHED; PG8_LDA(At, 1, 0); PG8_STAGE(PG8_SA(0, 1), a2 + hstep, voffA);
            PG8_WAIT_L(8); PG8_BAR; PG8_WAIT_L(0); PG8_MMA(0, 0, At, B0); PG8_BAR; PG8_SCHED;
            PG8_LDB(B1, 1, 1); PG8_STAGE(PG8_SB(1, 0), b3, voffB);
            PG8_BAR; PG8_WAIT_L(0); PG8_MMA(0, 1, At, B1); PG8_BAR;
            PG8_LDA(At, 1, 1); PG8_STAGE(PG8_SA(1, 0), a3, voffA);
            PG8_BAR; PG8_WAIT_L(0); PG8_MMA(1, 0, At, B0); PG8_BAR; PG8_SCHED;
            PG8_STAGE(PG8_SB(1, 1), b3 + hstep, voffB);
            PG8_WAIT_V(6); PG8_BAR; PG8_MMA(1, 1, At, B1); PG8_BAR;
            }
        }
        if constexpr (ALIGN_EPI) { if (wr == 0) PG8_BAR; }
        if constexpr (!Epi::AFTER_DRAIN) { E(acc, cur, wr, wc, fr, fq); S.done(cur); }
        if (!has_next) break;
#pragma unroll
        for (int a = 0; a < 2; ++a)
#pragma unroll
            for (int b = 0; b < 2; ++b)
#pragma unroll
                for (int m = 0; m < 4; ++m)
#pragma unroll
                    for (int n = 0; n < 2; ++n) acc[a][b][m][n] = (f32x4){0.f, 0.f, 0.f, 0.f};
        cur = nxt; cA = nA; cB = nB; ++ui;
        if constexpr (ALIGN_EPI) { if (wr == 1) PG8_BAR; }
    }
    PG8_WAIT_V(0);
    if constexpr (!ALIGN_EPI) { if (wr == 0) PG8_BAR; }
    PG8_BAR;
    if constexpr (Epi::AFTER_DRAIN) { E.fused(acc, cur, wr, wc, fr, fq, lds, wid, lane); S.done(cur); }
#undef PG8_SA
#undef PG8_SB
#undef PG8_STAGE
#undef PG8_LDA
#undef PG8_LDB
#undef PG8_MMA
#undef PG8_WAIT_V
#undef PG8_WAIT_L
#undef PG8_BAR
#undef PG8_SCHED
}
}
#include <hip/hip_bf16.h>
#include <cmath>
namespace attn_body {
using bf16=__hip_bfloat16;
using bf16x8=__attribute__((ext_vector_type(8)))short;
using s16x4=__attribute__((ext_vector_type(4)))short;
using f32x16=__attribute__((ext_vector_type(16)))float;
using u32x4=__attribute__((ext_vector_type(4)))unsigned;
constexpr int SEQ=8192,D=64;
constexpr int NW=8,QBLK=32,QB=QBLK*NW,KVBLK=64,NQB=SEQ/QB;
constexpr int ATTN_UNIT_ROWS=QB;
__device__ __forceinline__ int crow(int r,int hi){return (r&3)+8*(r>>2)+4*hi;}
#define SBAR() __builtin_amdgcn_sched_barrier(0)
__device__ __forceinline__ void cmask(f32x16&p0,f32x16&p1,int jb,int qrel,int hi){
  const float NEG=-INFINITY; int kb=64*jb+4*hi;
  #pragma unroll
  for(int r=0;r<16;++r){int kv=kb+(r&3)+8*(r>>2); if(kv>qrel)p0[r]=NEG; if(kv+32>qrel)p1[r]=NEG;}
}

constexpr int NSLOT=3, SLOTB=8192;
constexpr int LDS_K=0, LDS_V=NSLOT*SLOTB, LDS_WS=2*NSLOT*SLOTB, LDS_OST=LDS_WS+NW*64*4, LDS_BYTES=LDS_OST+NW*4096;
constexpr float C2=0.125f*1.4426950408889634f;
__device__ __forceinline__ void glds16(const void*gsrc,unsigned lds_dst){unsigned keep;
  asm volatile("s_mov_b32 %0, m0\n\ts_mov_b32 m0, %2\n\ts_nop 0\n\tglobal_load_lds_dwordx4 %1, off\n\ts_mov_b32 m0, %0":"=&s"(keep):"v"(gsrc),"s"(lds_dst):"memory");}
__device__ __forceinline__ float max3f(float a,float b,float c){float r;asm("v_max3_f32 %0, %1, %2, %3":"=v"(r):"v"(a),"v"(b),"v"(c));return r;}
__device__ __forceinline__ float max2f(float a,float b){float r;asm("v_max_f32_e32 %0, %1, %2":"=v"(r):"v"(a),"v"(b));return r;}
__device__ __forceinline__ float fadd_s(float a,float b){float r;asm("v_add_f32_e32 %0, %1, %2":"=v"(r):"v"(a),"v"(b));return r;}
__device__ __forceinline__ float fsub_s(float a,float b){float r;asm("v_sub_f32_e32 %0, %1, %2":"=v"(r):"v"(a),"v"(b));return r;}
typedef float f32x2_t __attribute__((ext_vector_type(2))); typedef __bf16 bf16x2_t __attribute__((ext_vector_type(2)));
__device__ __forceinline__ unsigned cvtpk_s(float lo,float hi){f32x2_t v={lo,hi};bf16x2_t b=__builtin_convertvector(v,bf16x2_t);return __builtin_bit_cast(unsigned,b);}
#define WAIT_BAR(N) asm volatile("s_waitcnt vmcnt(" #N ") lgkmcnt(0)\n\ts_barrier":::"memory")

__device__ __forceinline__ void qkt(f32x16&p0,f32x16&p1,const char*Kslot,const bf16x8*qr,const f32x16&negm,int r32,int hi){
  const char*kb=Kslot+hi*1024+r32*16;
  #pragma unroll
  for(int d0=0;d0<4;++d0){
    const bf16x8 b0=*reinterpret_cast<const bf16x8*>(kb+d0*2048);
    const bf16x8 b1=*reinterpret_cast<const bf16x8*>(kb+d0*2048+512);
    if(d0==0){p0=__builtin_amdgcn_mfma_f32_32x32x16_bf16(b0,qr[0],negm,0,0,0);p1=__builtin_amdgcn_mfma_f32_32x32x16_bf16(b1,qr[0],negm,0,0,0);}
    else{p0=__builtin_amdgcn_mfma_f32_32x32x16_bf16(b0,qr[d0],p0,0,0,0);p1=__builtin_amdgcn_mfma_f32_32x32x16_bf16(b1,qr[d0],p1,0,0,0);}}
}
typedef __attribute__((address_space(3))) const char* lds_cptr;
typedef short v4i16_t __attribute__((ext_vector_type(4)));
__device__ __forceinline__ void kload8(bf16x8*kf,lds_cptr kp){
  kf[0]=*(const __attribute__((address_space(3))) bf16x8*)(kp);      kf[1]=*(const __attribute__((address_space(3))) bf16x8*)(kp+512);
  kf[2]=*(const __attribute__((address_space(3))) bf16x8*)(kp+2048); kf[3]=*(const __attribute__((address_space(3))) bf16x8*)(kp+2560);
  kf[4]=*(const __attribute__((address_space(3))) bf16x8*)(kp+4096); kf[5]=*(const __attribute__((address_space(3))) bf16x8*)(kp+4608);
  kf[6]=*(const __attribute__((address_space(3))) bf16x8*)(kp+6144); kf[7]=*(const __attribute__((address_space(3))) bf16x8*)(kp+6656);
}
__device__ __forceinline__ void kload2(bf16x8*kf,lds_cptr kp,int j){ kf[2*j]=*(const __attribute__((address_space(3))) bf16x8*)(kp+j*2048); kf[2*j+1]=*(const __attribute__((address_space(3))) bf16x8*)(kp+j*2048+512); }
__device__ __forceinline__ s16x4 vtr(lds_cptr p){ return __builtin_bit_cast(s16x4,__builtin_amdgcn_ds_read_tr16_b64_v4i16((__attribute__((address_space(3))) v4i16_t*)p)); }
__device__ __forceinline__ float rowmax(const f32x16&p0,const f32x16&p1){
  float a=max3f(p0[0],p0[1],p1[0]),b=max3f(p0[2],p0[3],p1[1]);a=max3f(a,p1[2],p1[3]);
  #pragma unroll
  for(int r=4;r<16;r+=4){a=max3f(a,p0[r],p0[r+1]);b=max3f(b,p0[r+2],p0[r+3]);a=max3f(a,p1[r],p1[r+1]);b=max3f(b,p1[r+2],p1[r+3]);}
  const float m=max2f(a,b);
  auto rr=__builtin_amdgcn_permlane32_swap(__float_as_uint(m),__float_as_uint(m),false,false);
  return max2f(__uint_as_float(rr[0]),__uint_as_float(rr[1]));
}
__device__ __forceinline__ void pv(f32x16*o,int vb,bf16x8 pa0,bf16x8 pa1,bf16x8 pa2,bf16x8 pa3){
  #pragma unroll
  for(int d0=0;d0<2;++d0){s16x4 lo[4],hi[4];
    #pragma unroll
    for(int ks=0;ks<4;++ks){
      asm volatile("ds_read_b64_tr_b16 %0,%1 offset:%c2":"=&v"(lo[ks]):"v"(vb),"i"(d0*4096+ks*1024):"memory");
      asm volatile("ds_read_b64_tr_b16 %0,%1 offset:%c2":"=&v"(hi[ks]):"v"(vb),"i"(d0*4096+ks*1024+512):"memory");}
    asm volatile("s_waitcnt lgkmcnt(0)":::"memory");SBAR();
    #define PK(k) (bf16x8){lo[k][0],lo[k][1],lo[k][2],lo[k][3],hi[k][0],hi[k][1],hi[k][2],hi[k][3]}
    o[d0]=__builtin_amdgcn_mfma_f32_32x32x16_bf16(pa0,PK(0),o[d0],0,0,0);
    o[d0]=__builtin_amdgcn_mfma_f32_32x32x16_bf16(pa1,PK(1),o[d0],0,0,0);
    o[d0]=__builtin_amdgcn_mfma_f32_32x32x16_bf16(pa2,PK(2),o[d0],0,0,0);
    o[d0]=__builtin_amdgcn_mfma_f32_32x32x16_bf16(pa3,PK(3),o[d0],0,0,0);
    #undef PK
  }
}

#ifndef ATTN_STORE16
#define ATTN_STORE16(p,v) (*(u32x4*)(p)=(v))
#endif
template<int THRL,int PIN,int POUT> __device__ __forceinline__ void attn_unit(int b,int h,int qb,const bf16*Q,const bf16*__restrict__ K,const bf16*__restrict__ V,bf16*O,char*shm){
  const int tid=threadIdx.x,lane=tid&63,r32=lane&31,hi=lane>>5; const int wid=__builtin_amdgcn_readfirstlane(tid>>6);
  const long rowbase=(long)b*SEQ; const int q0=qb*QB;
  const bf16*Qw=Q+(rowbase+q0+wid*QBLK)*PIN+h*D;
  const bf16*Kh=K+rowbase*PIN+h*D,*Vh=V+rowbase*PIN+h*D;
  const unsigned lds0=(unsigned)(uintptr_t)shm;
  float*wsf=(float*)(shm+LDS_WS)+wid*64;
  const bf16*ksrc=Kh+(long)lane*PIN+wid*8;
  const bf16*vsrc=Vh+(long)(16*(wid&3)+(lane>>2))*PIN+(wid>>2)*32+(lane&3)*8;
  const unsigned kdst=lds0+LDS_K+wid*1024, vdst=lds0+LDS_V+wid*1024;
  #define DMA_K(t,slot) glds16(ksrc+(long)(t)*KVBLK*PIN,(unsigned)__builtin_amdgcn_readfirstlane(kdst+(slot)))
  #define DMA_V(t,slot) glds16(vsrc+(long)(t)*KVBLK*PIN,(unsigned)__builtin_amdgcn_readfirstlane(vdst+(slot)))
  const int vb0=(int)(lds0+LDS_V)+((lane>>4)&1)*32+(lane&3)*8+(4*hi+((lane&15)>>2))*64;
  const char*Kbase=shm+LDS_K; bf16x8 kf[8];
  const lds_cptr shm3=(lds_cptr)shm; const lds_cptr kp0=shm3+LDS_K+hi*1024+r32*16; const lds_cptr vp0=shm3+LDS_V+((lane>>4)&1)*32+(lane&3)*8+(4*hi+((lane&15)>>2))*64;
  const int NT=(q0+QB)/KVBLK;
  DMA_K(0,0);DMA_V(0,0);DMA_K(1,SLOTB);
  bf16x8 qr[4];
  #pragma unroll
  for(int d0=0;d0<4;++d0)qr[d0]=*reinterpret_cast<const bf16x8*>(&Qw[(long)r32*PIN+d0*16+hi*8]);
  float mhat=0.f,l_reg=0.f;f32x16 o[2];o[0]=f32x16{};o[1]=f32x16{};f32x16 negm=f32x16{};asm volatile("":"+v"(negm));
  const int qrel=wid*QBLK+r32;
  #define CMASK(P0,P1,t) do{int jb_=(t)-(NT-4); if(jb_>=0)cmask(P0,P1,jb_,qrel,hi);}while(0)
  bool resc=false;
  #define START(P0,P1) do{ const float rm=rowmax(P0,P1); resc=false; \
    { const float dl=rm; mhat=fadd_s(mhat,dl); \
      _Pragma("unroll") for(int r=0;r<16;++r){P0[r]=fsub_s(P0[r],dl);P1[r]=fsub_s(P1[r],dl);} \
      _Pragma("unroll") for(int r=0;r<16;++r)negm[r]=-mhat; asm volatile("":"+v"(negm)); } \
    _Pragma("unroll") for(int r=0;r<16;++r)P0[r]=__builtin_amdgcn_exp2f(P0[r]); }while(0)
  #define RESC() do{ if(resc){ asm volatile("s_waitcnt lgkmcnt(0)":::"memory"); \
      _Pragma("unroll") for(int d_=0;d_<2;++d_) _Pragma("unroll") for(int r=0;r<16;++r)o[d_][r]*=wsf[crow(r,hi)]; } }while(0)
  f32x16 pA0,pA1,pB0,pB1;
  int sl_prev=0,sl_cur=0,sl_next=SLOTB;
  #define ROT() do{sl_prev=sl_cur;sl_cur=sl_next;sl_next=(sl_next==(NSLOT-1)*SLOTB)?0:sl_next+SLOTB;}while(0)
  DMA_K(2,2*SLOTB);
  WAIT_BAR(3);
  qkt(pA0,pA1,Kbase,qr,negm,r32,hi);asm volatile("s_nop 15\n\ts_nop 7":"+v"(pA0),"+v"(pA1));CMASK(pA0,pA1,0);
  START(pA0,pA1);
  _Pragma("unroll") for(int r=0;r<16;++r)pA1[r]=__builtin_amdgcn_exp2f(pA1[r]);
  WAIT_BAR(0);
  DMA_K(3,0);DMA_V(1,SLOTB);
  ROT();
  kload8(kf,kp0+sl_cur);
  WAIT_BAR(2);
  s16x4 vlo[8],vhi[8]; u32x4 pw0,pw1,pw2,pw3;
  #define PKW(P,B) cvtpk_s(P[B],P[B+1])
  #define PAF(k) __builtin_bit_cast(bf16x8,pw##k)
  #define VFR(i) (bf16x8){vlo[i][0],vlo[i][1],vlo[i][2],vlo[i][3],vhi[i][0],vhi[i][1],vhi[i][2],vhi[i][3]}
  #define PIN(x) asm volatile("":"+v"(x))
  #define MX3(a,b,c) __builtin_fmaxf(__builtin_fmaxf((a),(b)),(c))
  #define GAPA(MF,A0,A1,A2,A3,W0,W1,PW) do{ MF; sacc+=A0; sacc+=A1; sacc+=A2; sacc+=A3; PIN(sacc); W0; W1; PIN(PW); SBAR(); }while(0)
  #define EX(v) __builtin_amdgcn_exp2f(v)
  #define GAPB(MF,X,B) do{ MF; X[B]=EX(X[B]); X[B+1]=EX(X[B+1]); X[B+2]=EX(X[B+2]); X[B+3]=EX(X[B+3]); PIN(X); SBAR(); }while(0)
  #define VRD(i) do{ vlo[i]=vtr(vp_+(((i)>>2)*4096+((i)&3)*1024)); vhi[i]=vtr(vp_+(((i)>>2)*4096+((i)&3)*1024+512)); }while(0)
  #define KRD(G,j) do{ if(G){ kload2(kf,kp0+sl_next,j); SBAR(); } }while(0)
  #define STEP(C0,C1,P0,P1,t,GK,GV,GL) do{ SBAR(); \
    const lds_cptr vp_=vp0+sl_prev; \
    VRD(0); SBAR(); float sacc=(P0[0]+P0[1]); \
    GAPA(C0=__builtin_amdgcn_mfma_f32_32x32x16_bf16(kf[0],qr[0],negm,0,0,0), P0[2],P0[3],P0[4],P0[5],     pw0[0]=PKW(P0,0), pw0[1]=PKW(P0,2), pw0); \
    VRD(4); SBAR(); GAPA(C1=__builtin_amdgcn_mfma_f32_32x32x16_bf16(kf[1],qr[0],negm,0,0,0), P0[6],P0[7],P0[8],P0[9],     pw0[2]=PKW(P0,4), pw0[3]=PKW(P0,6), pw0); \
    VRD(1); SBAR(); GAPA(C0=__builtin_amdgcn_mfma_f32_32x32x16_bf16(kf[2],qr[1],C0,0,0,0),   P0[10],P0[11],P0[12],P0[13], pw1[0]=PKW(P0,8), pw1[1]=PKW(P0,10), pw1); \
    VRD(5); SBAR(); GAPA(C1=__builtin_amdgcn_mfma_f32_32x32x16_bf16(kf[3],qr[1],C1,0,0,0),   P0[14],P0[15],P1[0],P1[1],   pw1[2]=PKW(P0,12),pw1[3]=PKW(P0,14), pw1); \
    VRD(2); SBAR(); GAPA(C0=__builtin_amdgcn_mfma_f32_32x32x16_bf16(kf[4],qr[2],C0,0,0,0),   P1[2],P1[3],P1[4],P1[5],     pw2[0]=PKW(P1,0), pw2[1]=PKW(P1,2), pw2); \
    VRD(6); SBAR(); GAPA(C1=__builtin_amdgcn_mfma_f32_32x32x16_bf16(kf[5],qr[2],C1,0,0,0),   P1[6],P1[7],P1[8],P1[9],     pw2[2]=PKW(P1,4), pw2[3]=PKW(P1,6), pw2); \
    VRD(3); SBAR(); GAPA(C0=__builtin_amdgcn_mfma_f32_32x32x16_bf16(kf[6],qr[3],C0,0,0,0),   P1[10],P1[11],P1[12],P1[13], pw3[0]=PKW(P1,8), pw3[1]=PKW(P1,10), pw3); \
    VRD(7); SBAR(); GAPA(C1=__builtin_amdgcn_mfma_f32_32x32x16_bf16(kf[7],qr[3],C1,0,0,0),   P1[14],P1[15],0.f,0.f,       pw3[2]=PKW(P1,12),pw3[3]=PKW(P1,14), pw3); \
    l_reg+=sacc; \
    if(GK){DMA_K((t)+3,sl_cur);} if(GV){DMA_V((t)+1,sl_next);} \
    CMASK(C0,C1,t); \
    { float a=MX3(C0[0],C0[1],C1[0]),b=MX3(C0[2],C0[3],C1[1]); a=MX3(a,C1[2],C1[3]); \
      _Pragma("unroll") for(int r=4;r<16;r+=4){a=MX3(a,C0[r],C0[r+1]);b=MX3(b,C0[r+2],C0[r+3]);a=MX3(a,C1[r],C1[r+1]);b=MX3(b,C1[r+2],C1[r+3]);} \
      float rm=__builtin_fmaxf(a,b); { auto rr=__builtin_amdgcn_permlane32_swap(__float_as_uint(rm),__float_as_uint(rm),false,false); rm=__builtin_fmaxf(__uint_as_float(rr[0]),__uint_as_float(rr[1])); } \
      resc=false; \
      if(__builtin_expect(__any(rm>(float)THRL),0)){ const float dl=__builtin_fmaxf(rm,0.f); mhat+=dl; \
        _Pragma("unroll") for(int r=0;r<16;++r){C0[r]-=dl;C1[r]-=dl;} \
        _Pragma("unroll") for(int r=0;r<16;++r)negm[r]=-mhat; asm volatile("":"+v"(negm)); \
        const float f=__builtin_amdgcn_exp2f(-dl); l_reg*=f; if(hi==0)wsf[r32]=f; resc=true; } } \
    SBAR(); \
    GAPB(o[0]=__builtin_amdgcn_mfma_f32_32x32x16_bf16(PAF(0),VFR(0),o[0],0,0,0), C0,0); \
    GAPB(o[1]=__builtin_amdgcn_mfma_f32_32x32x16_bf16(PAF(0),VFR(4),o[1],0,0,0), C0,4); \
    KRD(GL,0); GAPB(o[0]=__builtin_amdgcn_mfma_f32_32x32x16_bf16(PAF(1),VFR(1),o[0],0,0,0), C0,8); \
    KRD(GL,1); GAPB(o[1]=__builtin_amdgcn_mfma_f32_32x32x16_bf16(PAF(1),VFR(5),o[1],0,0,0), C0,12); \
    KRD(GL,2); GAPB(o[0]=__builtin_amdgcn_mfma_f32_32x32x16_bf16(PAF(2),VFR(2),o[0],0,0,0), C1,0); \
    KRD(GL,3); GAPB(o[1]=__builtin_amdgcn_mfma_f32_32x32x16_bf16(PAF(2),VFR(6),o[1],0,0,0), C1,4); \
    GAPB(o[0]=__builtin_amdgcn_mfma_f32_32x32x16_bf16(PAF(3),VFR(3),o[0],0,0,0), C1,8); \
    GAPB(o[1]=__builtin_amdgcn_mfma_f32_32x32x16_bf16(PAF(3),VFR(7),o[1],0,0,0), C1,12); \
    }while(0)
  int t=1;
  #undef CMASK
  #define CMASK(P0,P1,t) do{}while(0)
  for(;t+5<NT;t+=2){
    STEP(pB0,pB1,pA0,pA1,t,true,true,true);     WAIT_BAR(2); RESC(); ROT();
    STEP(pA0,pA1,pB0,pB1,t+1,true,true,true);   WAIT_BAR(2); RESC(); ROT();
  }
  #undef CMASK
  #define CMASK(P0,P1,t) do{int jb_=(t)-(NT-4); if(jb_>=0)cmask(P0,P1,jb_,qrel,hi);}while(0)
  #define ENDW(tt) do{ if((tt)+3<NT){WAIT_BAR(2);} else if((tt)+2<NT){WAIT_BAR(1);} else {WAIT_BAR(0);} }while(0)
  for(;t+1<NT;t+=2){
    STEP(pB0,pB1,pA0,pA1,t,(t+3<NT),(t+1<NT),(t+1<NT));       ENDW(t);   RESC(); ROT();
    STEP(pA0,pA1,pB0,pB1,t+1,(t+4<NT),(t+2<NT),(t+2<NT));     ENDW(t+1); RESC(); ROT();
  }
  STEP(pB0,pB1,pA0,pA1,NT-1,false,false,false); RESC();
  { float sacc=pB0[0]+pB0[1]; _Pragma("unroll") for(int r=2;r<16;++r)sacc+=pB0[r]; _Pragma("unroll") for(int r=0;r<16;++r)sacc+=pB1[r]; l_reg+=sacc;
    pw0=(u32x4){PKW(pB0,0),PKW(pB0,2),PKW(pB0,4),PKW(pB0,6)};pw1=(u32x4){PKW(pB0,8),PKW(pB0,10),PKW(pB0,12),PKW(pB0,14)};pw2=(u32x4){PKW(pB1,0),PKW(pB1,2),PKW(pB1,4),PKW(pB1,6)};pw3=(u32x4){PKW(pB1,8),PKW(pB1,10),PKW(pB1,12),PKW(pB1,14)};
    SBAR(); pv(o,vb0+sl_cur,PAF(0),PAF(1),PAF(2),PAF(3)); }
  #undef PKW
  #undef PAF
  #undef VFR
  #undef PIN
  #undef MX3
  #undef GAPA
  #undef GAPB
  #undef EX
  #undef VRD
  #undef KRD
  #undef STEP
  #undef ENDW
  {auto rr=__builtin_amdgcn_permlane32_swap(__float_as_uint(l_reg),__float_as_uint(l_reg),false,false);l_reg=__uint_as_float(rr[0])+__uint_as_float(rr[1]);}
  if(hi==0)wsf[32+r32]=l_reg;asm volatile("s_waitcnt lgkmcnt(0)":::"memory");
  float rli[16];
  #pragma unroll
  for(int r=0;r<16;++r)rli[r]=__builtin_amdgcn_rcpf(wsf[32+crow(r,hi)]);
  bf16*Ow=O+(rowbase+q0+wid*QBLK)*POUT+h*D;
  { bf16*stg=(bf16*)(shm+LDS_OST)+wid*2048;
    #pragma unroll
    for(int r=0;r<16;++r){const int orow=crow(r,hi);
      #pragma unroll
      for(int d0=0;d0<2;++d0)stg[orow*64+d0*32+r32]=__float2bfloat16(o[d0][r]*rli[r]);}
    asm volatile("s_waitcnt lgkmcnt(0)":::"memory");
    #pragma unroll
    for(int i=0;i<4;++i){const int row=i*8+(lane>>3),ch=lane&7; const u32x4 v=*(const u32x4*)(stg+row*64+ch*8); ATTN_STORE16(Ow+(long)row*POUT+ch*8,v);} }
  asm volatile("s_waitcnt lgkmcnt(0)\n\ts_barrier":::"memory");
  #undef DMA_K
  #undef DMA_V
  #undef CMASK
  #undef START
  #undef RESC
  #undef ROT
}
constexpr int ATTN_LDS_BYTES=LDS_BYTES;
struct AttnUnit { int bh; int qb; };
struct StaticOrder {
  int vcu;
  __device__ __forceinline__ explicit StaticOrder(int v):vcu(v){}
  __device__ __forceinline__ bool next(int i,AttnUnit&u)const{ if(i>=8)return false; const int s=vcu&7; u.bh=(vcu>>3)+32*(i>>2); const int ii=i&3; u.qb=(ii==0)?s:(ii==1)?15-s:(ii==2)?16+s:31-s; return true; }
};
template<int PIN,int POUT,int THRL=8> __device__ __forceinline__ void diff_attn_phase(char*lds,const bf16*PRJ,bf16*O1,bf16*O2,const StaticOrder&S){
  AttnUnit u;
  _Pragma("unroll 1") for(int i=0;S.next(i,u);++i){ const int rest=u.bh%32, h=rest>>2, wi=(rest>>1)&1, half=rest&1;
    attn_unit<THRL,PIN,POUT>(u.bh/32,0,u.qb,PRJ+(2*h+wi)*64,PRJ+1024+(2*h+wi)*64,PRJ+2048+h*128+half*64,(wi?O2:O1)+h*128+half*64,lds); }
}
#undef SBAR
#undef WAIT_BAR
}
constexpr int NWAVES = 8, NTHREADS = NWAVES * 64;
constexpr int BATCH = 2, T = 8192, D = 1024, M = BATCH * T, DFF = 2816, NPROJ = 3072;
constexpr float RMS_EPS = 1e-6f;
constexpr float QSCALE = 0.18033688011112042f;
constexpr float LAMBDA_INIT = 0.35550906759096934f;
constexpr int C_QN = 0, C_KC = 512, C_VC = 640, C_KS = 768, C_VS = 896, C_KW = 1024, C_VW = 1152, C_QS = 1280, C_KSB = 1792, C_VSB = 2304, C_GL = 2816;
constexpr int C1_Q = 0, C1_K = 1024, C1_V = 2048;

constexpr size_t MiB = 1u << 20, KiB = 1u << 10;
constexpr size_t WS_CTL = 0, CTL_ZERO_BYTES = 64 * KiB;
constexpr size_t WS_MODV = 1 * MiB;
constexpr size_t WS_CB1  = 1 * MiB + 128 * KiB;
constexpr size_t WS_KCMP = 1 * MiB + 256 * KiB;
constexpr size_t WS_VCMP = 1 * MiB + 512 * KiB;
constexpr size_t WS_CW2T = 1 * MiB + 768 * KiB;
constexpr size_t WS_CS   = 2 * MiB;
constexpr size_t WS_WQKV1 = 4 * MiB, WS_WOUT1 = 10 * MiB, WS_WG1 = 12 * MiB, WS_WU1 = WS_WG1 + 5632 * KiB, WS_WD1 = WS_WU1 + 5632 * KiB;
constexpr size_t WS_WG0 = WS_WD1 + 5632 * KiB, WS_WU0 = WS_WG0 + 5632 * KiB, WS_WD0 = WS_WU0 + 5632 * KiB;
constexpr size_t WS_XN = 45 * MiB;
constexpr size_t WS_R = 77 * MiB;
constexpr size_t WS_WIN0 = WS_R, WS_WOUT0 = WS_R + 6 * MiB, WS_CW1T = WS_R + 8 * MiB  , WS_PR = WS_R + 11 * MiB  , WS_OCAT = WS_PR + 96 * MiB;
constexpr size_t WS_G = WS_R, WS_ACT = WS_R + 88 * MiB;
constexpr size_t WS_PR1 = WS_R, WS_O1 = WS_R + 96 * MiB, WS_O2 = WS_O1 + 32 * MiB;
constexpr size_t WS_END = WS_ACT + 88 * MiB;
static_assert(WS_WD0 + 5632 * KiB == WS_XN && WS_OCAT + 32 * MiB <= WS_END && WS_O2 + 32 * MiB <= WS_END && WS_END <= 256 * MiB, "d_ws map");
constexpr int CW_BAR = 4096;

constexpr int LDS_BYTES = 163840;
constexpr int MISC_OFF = LDS_BYTES - 256;
constexpr int WAVE_LDS = 18432;
static_assert(NWAVES * WAVE_LDS <= MISC_OFF, "LDS map");
#define GAS __attribute__((address_space(1)))
#define LAS __attribute__((address_space(3)))
typedef unsigned short bf16;
typedef unsigned v4u __attribute__((ext_vector_type(4)));
typedef float f32x4 __attribute__((ext_vector_type(4)));
typedef short bf16x8 __attribute__((ext_vector_type(8)));
typedef GAS unsigned gu32;
typedef GAS unsigned long long gu64;
#define RLX_AGENT __ATOMIC_RELAXED, __HIP_MEMORY_SCOPE_AGENT
#define LDS_WAIT() asm volatile("s_waitcnt lgkmcnt(0)" ::: "memory")
#define VM_WAIT() asm volatile("s_waitcnt vmcnt(0)" ::: "memory")
__device__ __forceinline__ unsigned long long rt() { return __builtin_amdgcn_s_memrealtime(); }
__device__ __forceinline__ unsigned f2bf(float f) { unsigned u = __builtin_bit_cast(unsigned, f); return (u + 0x7fffu + ((u >> 16) & 1u)) >> 16; }
__device__ __forceinline__ unsigned pk2(float lo, float hi) { return f2bf(lo) | (f2bf(hi) << 16); }

#define XB_TMO      128
#define XB_XCNT(j)  (256  + 64 * (j))
#define XB_XSUB(j)  (1280 + 64 * (j))
#define XB_XGEN(j)  (2304 + 64 * (j))
#define XB_TOP      3328
#define XB_TOPGEN   3392
#define XCD_BAR_WORDS 3456
#define XB_SPIN_CAP (1u << 18)

__device__ __forceinline__ unsigned xb_ld(unsigned* p)              { return __hip_atomic_load(p, __ATOMIC_RELAXED, __HIP_MEMORY_SCOPE_AGENT); }
__device__ __forceinline__ unsigned xb_add(unsigned* p, unsigned v) { return __hip_atomic_fetch_add(p, v, __ATOMIC_RELAXED, __HIP_MEMORY_SCOPE_AGENT); }
__device__ __forceinline__ unsigned xb_xcc_id() { return (unsigned)__builtin_amdgcn_s_getreg((3 << 11) | 20) & 0xFu; }
#define XB_SPIN(cond, bar) do { unsigned _sp = 0; while (cond) { __builtin_amdgcn_s_sleep(1); \
    if ((++_sp & 255u) == 0u) { if (xb_ld(&(bar)[XB_TMO])) break; if (_sp > XB_SPIN_CAP) { atomicAdd(&(bar)[XB_TMO], 1u); break; } } } } while (0)

struct XcdBarrier {
    unsigned* bar; unsigned x;
    volatile LAS unsigned* st;
};

__device__ __forceinline__ XcdBarrier xcd_barrier_post(unsigned* bar, volatile LAS unsigned* st) {
    XcdBarrier b; b.bar = bar; b.x = xb_xcc_id(); b.st = st;
    if (threadIdx.x == 0) (void)xb_add(&bar[XB_XCNT(b.x)], 1u);
    return b;
}
__device__ __forceinline__ void xcd_barrier_complete(unsigned* bar, unsigned x, unsigned& nloc, unsigned& nx) {
    const unsigned G = gridDim.x * gridDim.y * gridDim.z;
    unsigned sum, cnt, mine, sp = 0u;
    for (;;) {
        sum = 0u; cnt = 0u; mine = 0u;
#pragma unroll
        for (unsigned j = 0; j < 16; ++j) { const unsigned c = xb_ld(&bar[XB_XCNT(j)]); sum += c; cnt += (c > 0u) ? 1u : 0u; mine = (j == x) ? c : mine; }
        if (sum == G) break;
        __builtin_amdgcn_s_sleep(1);
        if ((++sp & 255u) == 0u) { if (xb_ld(&bar[XB_TMO])) break; if (sp > XB_SPIN_CAP) { atomicAdd(&bar[XB_TMO], 1u); break; } }
    }
    nloc = mine > 0u ? mine : 1u; nx = cnt > 0u ? cnt : 1u;
}

__device__ __forceinline__ void xcd_barrier(const XcdBarrier& b) {
    asm volatile("s_waitcnt vmcnt(0)" ::: "memory");
    __syncthreads();
    if (threadIdx.x == 0) {
        unsigned* bar = b.bar;
        __builtin_amdgcn_s_waitcnt(0);
        unsigned nloc = b.st[0], nx = b.st[1];
        if (nloc == 0u) { xcd_barrier_complete(bar, b.x, nloc, nx); b.st[0] = nloc; b.st[1] = nx; }
        const unsigned old = xb_add(&bar[XB_XSUB(b.x)], 1u);
        const unsigned gen = old / nloc;
        if (old + 1u == (gen + 1u) * nloc) {
            __builtin_amdgcn_fence(__ATOMIC_RELEASE, "agent");
            asm volatile("s_waitcnt vmcnt(0)" ::: "memory");
            const unsigned og = xb_add(&bar[XB_TOP], 1u);
            const unsigned tg = og / nx;
            if (og + 1u == (tg + 1u) * nx) xb_add(&bar[XB_TOPGEN], 1u);
            else XB_SPIN(xb_ld(&bar[XB_TOPGEN]) == tg, bar);
            __builtin_amdgcn_fence(__ATOMIC_ACQUIRE, "agent");
            xb_add(&bar[XB_XGEN(b.x)], 1u);
            asm volatile("s_waitcnt vmcnt(0)" ::: "memory");
        } else {
            XB_SPIN(xb_ld(&bar[XB_XGEN(b.x)]) == gen, bar);
            __builtin_amdgcn_fence(__ATOMIC_ACQUIRE, "agent");
            asm volatile("s_waitcnt vmcnt(0)" ::: "memory");
        }
    }
    __syncthreads();
}
struct Ctx {
    LAS unsigned char* lds; int tid, lane, wave, vcu, G;
    const float *x, *c; const int* positions; const float *mod_w, *mod_b, *norm_mix, *norm_ffn, *w_gate, *w_up, *conv_w, *conv_b, *w_down, *hyb_w_in, *pos_k, *pos_v, *ck_w1, *ck_w2, *cv_w1, *cv_w2, *hyb_w_out,
        *diff_w_qkv, *lq1, *lk1, *lq2, *lk2, *subln, *diff_w_out, *norm_f;
    float* out; unsigned char* ws;
};
__device__ __forceinline__ float wave_sum(float v) {
#pragma unroll
    for (int o = 1; o < 64; o <<= 1) v += __shfl_xor(v, o);
    return v;
}
__device__ __forceinline__ float wave_max(float v) {
#pragma unroll
    for (int o = 1; o < 64; o <<= 1) v = fmaxf(v, __shfl_xor(v, o));
    return v;
}
__device__ __forceinline__ float bf2f(bf16 h) { return __uint_as_float((unsigned)h << 16); }
__device__ __forceinline__ float dot2(unsigned k, unsigned q, float acc) { typedef __bf16 bf16x2_t __attribute__((ext_vector_type(2))); return __builtin_amdgcn_fdot2_f32_bf16(__builtin_bit_cast(bf16x2_t, k), __builtin_bit_cast(bf16x2_t, q), acc, false); }
#define CFENCE() asm volatile("" ::: "memory")

__device__ __forceinline__ void p0_transpose_item(const float* W, int K, int N, int c0, int w, bf16* WT, int row_off, LAS float* scr, int item, int lane) {
    const int nblk = (w + 31) / 32, kb = item / nblk, nb = item % nblk, k0 = 64 * kb, n0 = 32 * nb;
    const bool okc = (n0 + (lane & 31)) < w;
#pragma unroll 8
    for (int i = 0; i < 32; ++i) { const int kk = 2 * i + (lane >> 5); scr[kk * 33 + (lane & 31)] = okc ? W[(size_t)(k0 + kk) * N + c0 + n0 + (lane & 31)] : 0.f; }
    LDS_WAIT(); CFENCE();
    const int c = lane & 7;
#pragma unroll
    for (int j = 0; j < 4; ++j) { const int n = (lane >> 3) + 8 * j; const LAS float* s = scr + (8 * c) * 33 + n;
        v4u o; o.x = pk2(s[0 * 33], s[1 * 33]); o.y = pk2(s[2 * 33], s[3 * 33]); o.z = pk2(s[4 * 33], s[5 * 33]); o.w = pk2(s[6 * 33], s[7 * 33]);
        if (n0 + n < w) *(GAS v4u*)(WT + (size_t)(row_off + n0 + n) * K + k0 + 8 * c) = o; }
    LDS_WAIT(); CFENCE();
}
constexpr int tj_items(int K, int w) { return (K / 64) * ((w + 31) / 32); }
__device__ __forceinline__ void p0_prologue(const Ctx& C) {
    unsigned char* ws = C.ws;
    {
        LAS float* cond = (LAS float*)C.lds;
        LAS float* part = (LAS float*)(C.lds + 8192);
        LAS float* posl = (LAS float*)(C.lds + 16384);
        for (int i = C.tid; i < 2048; i += NTHREADS) { const float v = C.c[i]; cond[i] = v / (1.f + __expf(-v)); }
        __syncthreads();
        for (int tk = blockIdx.x; tk < 392; tk += C.G) {
            float acc = 0.f;
            if (tk < 384) {
                const int layer = tk / 192, cg = tk % 192, col = 32 * cg + (C.lane & 31), bb = C.lane >> 5;
                const float* wp = C.mod_w + (size_t)layer * D * 6144 + (size_t)(128 * C.wave) * 6144 + col; const LAS float* cp = cond + bb * 1024 + 128 * C.wave;
#pragma unroll 16
                for (int k = 0; k < 128; ++k) acc += cp[k] * wp[(size_t)k * 6144];
            } else {
                const int which = (tk - 384) >> 2, n = 64 * ((tk - 384) & 3) + C.lane; const float* pe = which ? C.pos_v : C.pos_k; const float* w1 = which ? C.cv_w1 : C.ck_w1;
                for (int i = C.tid; i < 2048; i += NTHREADS) posl[i] = pe[i];
                __syncthreads();
                const float* wp = w1 + (size_t)(256 * C.wave) * 256 + n; const LAS float* pp = posl + 256 * C.wave;
#pragma unroll 16
                for (int k = 0; k < 256; ++k) acc += pp[k] * wp[(size_t)k * 256];
            }
            part[C.wave * 64 + C.lane] = acc;
            __syncthreads();
            if (C.wave == 0) {
                float s = 0.f;
#pragma unroll
                for (int w = 0; w < 8; ++w) s += part[w * 64 + C.lane];
                if (tk < 384) { const int layer = tk / 192, cg = tk % 192, col = 32 * cg + (C.lane & 31), bb = C.lane >> 5;
                    ((float*)(ws + WS_MODV))[(size_t)(layer * 2 + bb) * 6144 + col] = s + C.mod_b[layer * 6144 + col]; }
                else { const int which = (tk - 384) >> 2, n = 64 * ((tk - 384) & 3) + C.lane; ((float*)(ws + WS_CB1))[which * 256 + n] = s; }
            }
            __syncthreads();
        }
    }
    LAS float* scr = (LAS float*)(C.lds + C.wave * 16384);
    const int gw = C.vcu * NWAVES + C.wave, NGW = C.G * NWAVES;
    constexpr int NITEMS = tj_items(D, 1280) + tj_items(D, 1536) + tj_items(D, 24) + tj_items(D, D) + 2 * tj_items(D, DFF) + tj_items(DFF, D) + tj_items(D, 3072) + tj_items(D, D) + 2 * tj_items(D, DFF) + tj_items(DFF, D)
        + 2 * tj_items(2048, 256) + 2 * tj_items(256, 64);
    __syncthreads();
    for (int it = gw; it < NITEMS; it += NGW) {
        int r = it;
#define TJ(Wp, K_, N_, c0_, w_, WT_, r0_) { constexpr int cnt_ = tj_items(K_, w_); if (r < cnt_) { p0_transpose_item(Wp, K_, N_, c0_, w_, (bf16*)(WT_), r0_, scr, r, C.lane); continue; } r -= cnt_; }
        TJ(C.hyb_w_in, D, 2840, 0, 1280, ws + WS_WIN0, 0)
        TJ(C.hyb_w_in, D, 2840, 1304, 1536, ws + WS_WIN0, 1280)
        TJ(C.hyb_w_in, D, 2840, 1280, 24, ws + WS_WIN0, 2816)
        TJ(C.hyb_w_out, D, D, 0, D, ws + WS_WOUT0, 0)
        TJ(C.w_gate, D, DFF, 0, DFF, ws + WS_WG0, 0)
        TJ(C.w_up, D, DFF, 0, DFF, ws + WS_WU0, 0)
        TJ(C.w_down, DFF, D, 0, D, ws + WS_WD0, 0)
        TJ(C.diff_w_qkv, D, 3072, 0, 3072, ws + WS_WQKV1, 0)
        TJ(C.diff_w_out, D, D, 0, D, ws + WS_WOUT1, 0)
        TJ(C.w_gate + (size_t)D * DFF, D, DFF, 0, DFF, ws + WS_WG1, 0)
        TJ(C.w_up + (size_t)D * DFF, D, DFF, 0, DFF, ws + WS_WU1, 0)
        TJ(C.w_down + (size_t)D * DFF, DFF, D, 0, D, ws + WS_WD1, 0)
        TJ(C.ck_w1, 2048, 256, 0, 256, ws + WS_CW1T, 0)
        TJ(C.cv_w1, 2048, 256, 0, 256, ws + WS_CW1T + 1 * MiB, 0)
        TJ(C.ck_w2, 256, 64, 0, 64, ws + WS_CW2T, 0)
        TJ(C.cv_w2, 256, 64, 0, 64, ws + WS_CW2T + 32 * KiB, 0)
#undef TJ
    }
    { GAS v4u* z = (GAS v4u*)(ws + WS_WIN0 + (size_t)2840 * D * 2); const int n16 = (3072 - 2840) * D * 2 / 16;
      for (int i = C.vcu * NTHREADS + C.tid; i < n16; i += C.G * NTHREADS) z[i] = (v4u){0u, 0u, 0u, 0u}; }
    { float* cs = (float*)(ws + WS_CS);
      for (int e = C.vcu * NTHREADS + C.tid; e < M * 8; e += C.G * NTHREADS) {
          const int m = e >> 3, i = e & 7;
          const double inv = (i == 0) ? 1.0 : (i == 1) ? 0.19392274474868576 : (i == 2) ? 0.03760603093086393 : (i == 3) ? 0.007292664737217109 : (i == 4) ? 0.001414213562373095 : (i == 5) ? 0.0002742481756762073
                              : (i == 6) ? 5.318295896944988e-05 : 1.031338537721246e-05;
          const double rev = (double)C.positions[m] * inv * 0.15915494309189535; const float fr = (float)(rev - floor(rev));
          cs[(size_t)m * 16 + i] = __builtin_amdgcn_cosf(fr); cs[(size_t)m * 16 + 8 + i] = __builtin_amdgcn_sinf(fr); } }
}

__device__ __forceinline__ void norm_mod_rows(const Ctx& C, const float* X, const float* gain, const float* shv, const float* scv, bf16* XN) {
    const int gw = C.vcu * NWAVES + C.wave, NGW = C.G * NWAVES;
    for (int m = gw; m < M; m += NGW) {
        const int b = m >> 13; const GAS f32x4* xr = (const GAS f32x4*)(X + (size_t)m * D) + C.lane;
        f32x4 v[4]; float s = 0.f;
#pragma unroll
        for (int j = 0; j < 4; ++j) { v[j] = xr[64 * j]; s += (v[j].x * v[j].x + v[j].y * v[j].y) + (v[j].z * v[j].z + v[j].w * v[j].w); }
        const float rs = 1.0f / sqrtf(wave_sum(s) * (1.f / D) + RMS_EPS);
        GAS unsigned long long* o8 = (GAS unsigned long long*)(XN + (size_t)m * D) + C.lane;
#pragma unroll
        for (int j = 0; j < 4; ++j) { const int col = 4 * (64 * j + C.lane);
            const f32x4 g4 = *(const GAS f32x4*)(gain + col), sh4 = *(const GAS f32x4*)(shv + (size_t)b * 6144 + col), sc4 = *(const GAS f32x4*)(scv + (size_t)b * 6144 + col);
            const f32x4 h = v[j] * rs * g4 * (sc4 + 1.0f) + sh4;
            o8[64 * j] = (unsigned long long)pk2(h.x, h.y) | ((unsigned long long)pk2(h.z, h.w) << 32); }
    }
}
__device__ __forceinline__ void final_norm_rows(const Ctx& C, float* X, const float* gain) {
    const int gw = C.vcu * NWAVES + C.wave, NGW = C.G * NWAVES;
    for (int m = gw; m < M; m += NGW) {
        GAS f32x4* xr = (GAS f32x4*)(X + (size_t)m * D) + C.lane;
        f32x4 v[4]; float s = 0.f;
#pragma unroll
        for (int j = 0; j < 4; ++j) { v[j] = xr[64 * j]; s += (v[j].x * v[j].x + v[j].y * v[j].y) + (v[j].z * v[j].z + v[j].w * v[j].w); }
        const float rs = 1.0f / sqrtf(wave_sum(s) * (1.f / D) + RMS_EPS);
#pragma unroll
        for (int j = 0; j < 4; ++j) { const f32x4 g4 = *(const GAS f32x4*)(gain + 4 * (64 * j + C.lane)); xr[64 * j] = v[j] * rs * g4; }
    }
}
__device__ __forceinline__ void diff_combine_rows(const Ctx& C, const bf16* O1, const bf16* O2, bf16* OC) {
    const int gw = C.vcu * NWAVES + C.wave, NGW = C.G * NWAVES;
    const float lam = __expf(wave_sum(C.lq1[C.lane] * C.lk1[C.lane])) - __expf(wave_sum(C.lq2[C.lane] * C.lk2[C.lane])) + LAMBDA_INIT;
    float sl[16];
#pragma unroll
    for (int i = 0; i < 16; ++i) sl[i] = C.subln[(16 * C.lane + i) & 127] * (1.0f - LAMBDA_INIT);
    for (int m = gw; m < M; m += NGW) {
        const GAS v4u* p1 = (const GAS v4u*)(O1 + (size_t)m * D + 16 * C.lane); const GAS v4u* p2 = (const GAS v4u*)(O2 + (size_t)m * D + 16 * C.lane);
        float o[16]; float ss = 0.f;
#pragma unroll
        for (int h = 0; h < 2; ++h) { const v4u a = p1[h], bq = p2[h];
#pragma unroll
            for (int e = 0; e < 4; ++e) { const unsigned ua = e == 0 ? a.x : e == 1 ? a.y : e == 2 ? a.z : a.w, ub = e == 0 ? bq.x : e == 1 ? bq.y : e == 2 ? bq.z : bq.w;
                o[8 * h + 2 * e] = __uint_as_float(ua << 16) - lam * __uint_as_float(ub << 16); o[8 * h + 2 * e + 1] = __uint_as_float(ua & 0xffff0000u) - lam * __uint_as_float(ub & 0xffff0000u); } }
#pragma unroll
        for (int i = 0; i < 16; ++i) ss += o[i] * o[i];
        ss += __shfl_xor(ss, 1); ss += __shfl_xor(ss, 2); ss += __shfl_xor(ss, 4);
        const float rs = 1.0f / sqrtf(ss * (1.f / 128.f) + RMS_EPS);
        v4u w0, w1;
        w0.x = pk2(o[0] * rs * sl[0], o[1] * rs * sl[1]); w0.y = pk2(o[2] * rs * sl[2], o[3] * rs * sl[3]); w0.z = pk2(o[4] * rs * sl[4], o[5] * rs * sl[5]); w0.w = pk2(o[6] * rs * sl[6], o[7] * rs * sl[7]);
        w1.x = pk2(o[8] * rs * sl[8], o[9] * rs * sl[9]); w1.y = pk2(o[10] * rs * sl[10], o[11] * rs * sl[11]); w1.z = pk2(o[12] * rs * sl[12], o[13] * rs * sl[13]); w1.w = pk2(o[14] * rs * sl[14], o[15] * rs * sl[15]);
        GAS v4u* q = (GAS v4u*)(OC + (size_t)m * D + 16 * C.lane); q[0] = w0; q[1] = w1;
    }
}

__device__ __forceinline__ void compress_unit(const Ctx& C, int unit) {
    typedef float f32x16 __attribute__((ext_vector_type(16)));
    const int which = unit >> 6, b = (unit >> 5) & 1, g = (unit >> 4) & 1, cb = unit & 15;
    const int lane = C.lane, n = lane & 31, hi = lane >> 5, w = C.wave;
    const bf16* PR = (const bf16*)(C.ws + WS_PR); const bf16* W1T = (const bf16*)(C.ws + WS_CW1T + (size_t)which * MiB); const bf16* W2T = (const bf16*)(C.ws + WS_CW2T + (size_t)which * 32 * KiB);
    const float* cb1 = (const float*)(C.ws + WS_CB1) + which * 256;
    LAS bf16* H = (LAS bf16*)C.lds;
    int c = 32 * cb + n; if (c > 510) c = 510;
    const bf16* ap = PR + ((size_t)(b * T + 16 * c)) * NPROJ + (which ? C_VC : C_KC) + g * 64 + 8 * hi;
    const bf16* bp = W1T + (size_t)(32 * w + n) * 2048 + 8 * hi;
    f32x16 acc = {};
#pragma unroll 4
    for (int ks = 0; ks < 128; ++ks) {
        const bf16x8 a = *(const GAS bf16x8*)(ap + (size_t)(ks >> 2) * NPROJ + (ks & 3) * 16);
        const bf16x8 bb = *(const GAS bf16x8*)(bp + ks * 16);
        acc = __builtin_amdgcn_mfma_f32_32x32x16_bf16(a, bb, acc, 0, 0, 0);
    }
    { const float bias = cb1[32 * w + n];
#pragma unroll
      for (int r = 0; r < 16; ++r) { const int row = (r & 3) + 8 * (r >> 2) + 4 * hi; float v = acc[r] + bias; v = v / (1.f + __expf(-v)); H[row * 256 + 32 * w + n] = (bf16)f2bf(v); } }
    __syncthreads();
    if (w < 2) {
        f32x16 a2 = {};
#pragma unroll
        for (int ks = 0; ks < 16; ++ks) {
            const bf16x8 a = *(const LAS bf16x8*)(H + n * 256 + ks * 16 + 8 * hi);
            const bf16x8 bb = *(const GAS bf16x8*)(W2T + (size_t)(32 * w + n) * 256 + ks * 16 + 8 * hi);
            a2 = __builtin_amdgcn_mfma_f32_32x32x16_bf16(a, bb, a2, 0, 0, 0);
        }
        bf16* OUT = (bf16*)(C.ws + (which ? WS_VCMP : WS_KCMP)) + (size_t)((b * 2 + g) * 512) * 64;
        const float* cs = (const float*)(C.ws + WS_CS);
#pragma unroll
        for (int r = 0; r < 16; ++r) {
            const int row = (r & 3) + 8 * (r >> 2) + 4 * hi, cc = 32 * cb + row;
            float v = a2[r];
            if (which == 0 && w == 0) {
                const float pv = __shfl_xor(v, 8);
                if (n < 16) { const int cq = cc > 510 ? 510 : cc; const float* t = cs + ((size_t)(b * T + 16 * cq + 31)) * 16; const float co = t[n & 7], si = t[8 + (n & 7)];
                    v = (n < 8) ? (v * co - pv * si) : (v * co + pv * si); }
            }
            if (cc > 510) v = 0.f;
            OUT[(size_t)cc * 64 + 32 * w + n] = (bf16)f2bf(v);
        }
    }
    __syncthreads();
}

__device__ __forceinline__ void score4(const unsigned (&q)[4][32], const bf16* kp, float& s0, float& s1, float& s2, float& s3) {
    s0 = s1 = s2 = s3 = 0.f;
#pragma unroll
    for (int cch = 0; cch < 8; ++cch) { const v4u kv = ((const GAS v4u*)kp)[cch];
#pragma unroll
        for (int e = 0; e < 4; ++e) { const unsigned kw = e == 0 ? kv.x : e == 1 ? kv.y : e == 2 ? kv.z : kv.w;
            s0 = dot2(kw, q[0][4 * cch + e], s0); s1 = dot2(kw, q[1][4 * cch + e], s1); s2 = dot2(kw, q[2][4 * cch + e], s2); s3 = dot2(kw, q[3][4 * cch + e], s3); } }
}
__device__ __forceinline__ void nsa_query(const Ctx& C, int b, int t, int g, LAS unsigned char* wl) {
    const int lane = C.lane; const bf16* PR = (const bf16*)(C.ws + WS_PR); const size_t row = (size_t)b * T + t;
    LAS f32x4* sc = (LAS f32x4*)wl; LAS unsigned* qd = (LAS unsigned*)(wl + 16384);
    { const GAS unsigned* qsrc = (const GAS unsigned*)(PR + row * NPROJ + C_QN + g * 256); qd[lane] = qsrc[lane]; qd[lane + 64] = qsrc[lane + 64]; }
    CFENCE();
    unsigned q[4][32];
#pragma unroll
    for (int h = 0; h < 4; ++h)
#pragma unroll
        for (int i = 0; i < 8; ++i) { const v4u tq = ((const LAS v4u*)qd)[h * 8 + i]; q[h][4 * i] = tq.x; q[h][4 * i + 1] = tq.y; q[h][4 * i + 2] = tq.z; q[h][4 * i + 3] = tq.w; }
    float gate; { float glv = 0.f; if (lane < 12) glv = bf2f(PR[row * NPROJ + C_GL + g * 12 + lane]); gate = 1.f / (1.f + __expf(-glv)); }
    float oacc[4] = {0.f, 0.f, 0.f, 0.f};
    const int cur = t >> 6;
    const int nvalid = (t >= 31) ? (((t - 31) >> 4) + 1) : 0;
    float imp0 = 0.f, imp1 = 0.f;
    if (nvalid > 0) {
        const bf16* KC = (const bf16*)(C.ws + WS_KCMP) + (size_t)((b * 2 + g) * 512) * 64; const bf16* VC = (const bf16*)(C.ws + WS_VCMP) + (size_t)((b * 2 + g) * 512) * 64;
        float m0 = -1e30f, m1 = -1e30f, m2 = -1e30f, m3 = -1e30f;
        for (int cc = lane; cc < nvalid; cc += 64) { float s0, s1, s2, s3; score4(q, KC + (size_t)cc * 64, s0, s1, s2, s3); sc[cc] = (f32x4){s0, s1, s2, s3}; m0 = fmaxf(m0, s0); m1 = fmaxf(m1, s1); m2 = fmaxf(m2, s2); m3 = fmaxf(m3, s3); }
        m0 = wave_max(m0); m1 = wave_max(m1); m2 = wave_max(m2); m3 = wave_max(m3);
        float l0 = 0.f, l1 = 0.f, l2 = 0.f, l3 = 0.f;
        for (int cc = lane; cc < nvalid; cc += 64) { f32x4 s = sc[cc]; s.x = __builtin_amdgcn_exp2f(s.x - m0); s.y = __builtin_amdgcn_exp2f(s.y - m1); s.z = __builtin_amdgcn_exp2f(s.z - m2); s.w = __builtin_amdgcn_exp2f(s.w - m3); sc[cc] = s; l0 += s.x; l1 += s.y; l2 += s.z; l3 += s.w; }
        const float i0 = 1.f / wave_sum(l0), i1 = 1.f / wave_sum(l1), i2 = 1.f / wave_sum(l2), i3 = 1.f / wave_sum(l3);
        CFENCE();
#pragma unroll
        for (int half = 0; half < 2; ++half) { const int nb = lane + 64 * half; float a = 0.f;
            for (int cc = 4 * nb - 1; cc <= 4 * nb + 3; ++cc) if (cc >= 0 && cc < nvalid) { const f32x4 p = sc[cc]; a += p.x * i0 + p.y * i1 + p.z * i2 + p.w * i3; }
            if (half == 0) imp0 = a; else imp1 = a; }
        float a0 = 0.f, a1 = 0.f, a2 = 0.f, a3 = 0.f;
        for (int cc = 0; cc < nvalid; ++cc) { const f32x4 p = sc[cc]; const float v = bf2f(VC[(size_t)cc * 64 + lane]); a0 += p.x * v; a1 += p.y * v; a2 += p.z * v; a3 += p.w * v; }
        oacc[0] += __shfl(gate, 0) * a0 * i0; oacc[1] += __shfl(gate, 3) * a1 * i1; oacc[2] += __shfl(gate, 6) * a2 * i2; oacc[3] += __shfl(gate, 9) * a3 * i3;
        CFENCE();
    }
    int sel[16];
    {
        float v0, v1;
        { const int nb = lane; const bool forced = (nb == 0) || (nb == cur) || (nb == cur - 1); v0 = forced ? 1e9f : (nb <= cur ? imp0 : -1e9f); }
        { const int nb = lane + 64; const bool forced = (nb == cur) || (nb == cur - 1); v1 = forced ? 1e9f : (nb <= cur ? imp1 : -1e9f); }
#pragma unroll
        for (int i = 0; i < 16; ++i) {
            float bv; int bi; if (v0 >= v1) { bv = v0; bi = lane; } else { bv = v1; bi = lane + 64; }
#pragma unroll
            for (int off = 32; off >= 1; off >>= 1) { const float ov = __shfl_xor(bv, off); const int oi = __shfl_xor(bi, off); if (ov > bv || (ov == bv && oi < bi)) { bv = ov; bi = oi; } }
            sel[i] = bi; if (bi == lane) v0 = -3e38f; if (bi == lane + 64) v1 = -3e38f;
        }
    }
    {
        float m0 = -1e30f, m1 = -1e30f, m2 = -1e30f, m3 = -1e30f;
#pragma unroll
        for (int i = 0; i < 16; ++i) {
            const int blk = __builtin_amdgcn_readfirstlane(sel[i]);
            if (blk <= cur) { const int tok = blk * 64 + lane; float s0, s1, s2, s3; score4(q, PR + ((size_t)b * T + tok) * NPROJ + C_KS + g * 64, s0, s1, s2, s3);
                if (tok <= t) { m0 = fmaxf(m0, s0); m1 = fmaxf(m1, s1); m2 = fmaxf(m2, s2); m3 = fmaxf(m3, s3); } else { s0 = s1 = s2 = s3 = -1e30f; }
                sc[i * 64 + lane] = (f32x4){s0, s1, s2, s3}; }
        }
        m0 = wave_max(m0); m1 = wave_max(m1); m2 = wave_max(m2); m3 = wave_max(m3);
        float l0 = 0.f, l1 = 0.f, l2 = 0.f, l3 = 0.f;
#pragma unroll
        for (int i = 0; i < 16; ++i) {
            const int blk = __builtin_amdgcn_readfirstlane(sel[i]);
            if (blk <= cur) { f32x4 s = sc[i * 64 + lane]; const bool ok = (blk * 64 + lane) <= t;
                s.x = ok ? __builtin_amdgcn_exp2f(s.x - m0) : 0.f; s.y = ok ? __builtin_amdgcn_exp2f(s.y - m1) : 0.f; s.z = ok ? __builtin_amdgcn_exp2f(s.z - m2) : 0.f; s.w = ok ? __builtin_amdgcn_exp2f(s.w - m3) : 0.f;
                sc[i * 64 + lane] = s; l0 += s.x; l1 += s.y; l2 += s.z; l3 += s.w; }
        }
        const float i0 = 1.f / wave_sum(l0), i1 = 1.f / wave_sum(l1), i2 = 1.f / wave_sum(l2), i3 = 1.f / wave_sum(l3);
        CFENCE();
        float a0 = 0.f, a1 = 0.f, a2 = 0.f, a3 = 0.f;
#pragma unroll
        for (int i = 0; i < 16; ++i) {
            const int blk = __builtin_amdgcn_readfirstlane(sel[i]);
            if (blk <= cur) { int nj = t - blk * 64 + 1; if (nj > 64) nj = 64; const bf16* vp = PR + ((size_t)b * T + blk * 64) * NPROJ + C_VS + g * 64 + lane;
                for (int j = 0; j < nj; ++j) { const f32x4 p = sc[i * 64 + j]; const float v = bf2f(vp[(size_t)j * NPROJ]); a0 += p.x * v; a1 += p.y * v; a2 += p.z * v; a3 += p.w * v; } }
        }
        oacc[0] += __shfl(gate, 1) * a0 * i0; oacc[1] += __shfl(gate, 4) * a1 * i1; oacc[2] += __shfl(gate, 7) * a2 * i2; oacc[3] += __shfl(gate, 10) * a3 * i3;
        CFENCE();
    }
    {
        float m0 = -1e30f, m1 = -1e30f, m2 = -1e30f, m3 = -1e30f;
#pragma unroll
        for (int i = 0; i < 8; ++i) { const int j = lane + 64 * i, kp = t - 511 + j;
            float s0 = -1e30f, s1 = -1e30f, s2 = -1e30f, s3 = -1e30f;
            if (kp >= 0) { score4(q, PR + ((size_t)b * T + kp) * NPROJ + C_KW + g * 64, s0, s1, s2, s3); m0 = fmaxf(m0, s0); m1 = fmaxf(m1, s1); m2 = fmaxf(m2, s2); m3 = fmaxf(m3, s3); }
            sc[j] = (f32x4){s0, s1, s2, s3}; }
        m0 = wave_max(m0); m1 = wave_max(m1); m2 = wave_max(m2); m3 = wave_max(m3);
        float l0 = 0.f, l1 = 0.f, l2 = 0.f, l3 = 0.f;
#pragma unroll
        for (int i = 0; i < 8; ++i) { const int j = lane + 64 * i; const bool ok = (t - 511 + j) >= 0; f32x4 s = sc[j];
            s.x = ok ? __builtin_amdgcn_exp2f(s.x - m0) : 0.f; s.y = ok ? __builtin_amdgcn_exp2f(s.y - m1) : 0.f; s.z = ok ? __builtin_amdgcn_exp2f(s.z - m2) : 0.f; s.w = ok ? __builtin_amdgcn_exp2f(s.w - m3) : 0.f;
            sc[j] = s; l0 += s.x; l1 += s.y; l2 += s.z; l3 += s.w; }
        const float i0 = 1.f / wave_sum(l0), i1 = 1.f / wave_sum(l1), i2 = 1.f / wave_sum(l2), i3 = 1.f / wave_sum(l3);
        CFENCE();
        float a0 = 0.f, a1 = 0.f, a2 = 0.f, a3 = 0.f;
        const int j0 = (t >= 511) ? 0 : (511 - t); const bf16* vp = PR + ((size_t)b * T + (t - 511)) * NPROJ + C_VW + g * 64 + lane;
        for (int j = j0; j < 512; ++j) { const f32x4 p = sc[j]; const float v = bf2f(vp[(ptrdiff_t)j * NPROJ]); a0 += p.x * v; a1 += p.y * v; a2 += p.z * v; a3 += p.w * v; }
        oacc[0] += __shfl(gate, 2) * a0 * i0; oacc[1] += __shfl(gate, 5) * a1 * i1; oacc[2] += __shfl(gate, 8) * a2 * i2; oacc[3] += __shfl(gate, 11) * a3 * i3;
        CFENCE();
    }
    bf16* OC = (bf16*)(C.ws + WS_OCAT) + row * D + g * 256 + lane;
#pragma unroll
    for (int h = 0; h < 4; ++h) OC[h * 64] = (bf16)f2bf(oacc[h]);
}
__device__ __forceinline__ void sb_query(const Ctx& C, int b, int t, int h, LAS unsigned char* wl) {
    const int lane = C.lane; const bf16* PR = (const bf16*)(C.ws + WS_PR); const size_t row = (size_t)b * T + t;
    LAS float* ab = (LAS float*)wl; LAS unsigned* qd = (LAS unsigned*)(wl + 16384);
    { const GAS unsigned* qsrc = (const GAS unsigned*)(PR + row * NPROJ + C_QS + h * 64); if (lane < 32) qd[lane] = qsrc[lane]; }
    CFENCE();
    unsigned q[32];
#pragma unroll
    for (int i = 0; i < 8; ++i) { const v4u tq = ((const LAS v4u*)qd)[i]; q[4 * i] = tq.x; q[4 * i + 1] = tq.y; q[4 * i + 2] = tq.z; q[4 * i + 3] = tq.w; }
    float o = 0.f, carry = 0.f;
    for (int base = t - 1; base >= 0; base -= 64) {
        const int key = base - lane; const bool valid = key >= 0; const int kc = valid ? key : 0;
        const bf16* kp = PR + ((size_t)b * T + kc) * NPROJ + C_KSB + h * 64;
        float z = 0.f;
#pragma unroll
        for (int cch = 0; cch < 8; ++cch) { const v4u kv = ((const GAS v4u*)kp)[cch]; z = dot2(kv.x, q[4 * cch], z); z = dot2(kv.y, q[4 * cch + 1], z); z = dot2(kv.z, q[4 * cch + 2], z); z = dot2(kv.w, q[4 * cch + 3], z); }
        const float L = __builtin_amdgcn_logf(1.f + __builtin_amdgcn_exp2f(-fabsf(z)));
        const float lk = valid ? -(fmaxf(z, 0.f) + L) : 0.f;
        const float ls = fminf(z, 0.f) - L;
        float inc = lk;
#pragma unroll
        for (int d = 1; d < 64; d <<= 1) { const float tv = __shfl_up(inc, d); if (lane >= d) inc += tv; }
        const float a = valid ? __builtin_amdgcn_exp2f(ls + carry + (inc - lk)) : 0.f;
        CFENCE(); ab[lane] = a; CFENCE();
        const int nv = (base + 1 < 64) ? (base + 1) : 64; const bf16* vp = PR + ((size_t)b * T + base) * NPROJ + C_VSB + h * 64 + lane;
        for (int j = 0; j < nv; ++j) o += ab[j] * bf2f(vp[-(ptrdiff_t)j * NPROJ]);
        carry += __shfl(inc, 63);
        if (carry < -60.f) break;
    }
    ((bf16*)(C.ws + WS_OCAT))[row * D + 512 + h * 64 + lane] = (bf16)f2bf(o);
}
__device__ __forceinline__ void hybrid_attention_phase(const Ctx& C) {
    LAS unsigned char* wl = C.lds + C.wave * WAVE_LDS;
    const int gw = C.vcu * NWAVES + C.wave, NGW = C.G * NWAVES;
    for (int tk = gw; tk < BATCH * 2 * T; tk += NGW) { const int t = tk & (T - 1), g = (tk >> 13) & 1, b = tk >> 14; nsa_query(C, b, t, g, wl); }
    for (int tk = gw; tk < BATCH * 8 * T; tk += NGW) { const int t = tk & (T - 1), h = (tk >> 13) & 7, b = tk >> 16; sb_query(C, b, t, h, wl); }
}
namespace hyb {
using attn_body::bf16x8; using attn_body::s16x4; using attn_body::f32x16; using attn_body::u32x4; using attn_body::crow; using attn_body::glds16; using attn_body::cvtpk_s;
typedef attn_body::bf16 hb;
constexpr int SLOT_BYTES = 16384, H_SLOT0 = 0, H_WSF = 32768, H_OST = 34816  , H_IMP = 100352, H_SELM = 134144, H_WUN = 135168, H_FLAG = 135296, H_END = 135360;
constexpr int IMP_LD = 132;
static_assert(H_IMP + 8 * 8 * IMP_LD * 4 <= H_SELM && H_END <= MISC_OFF, "hyb LDS map");
constexpr float NEGF = -1e30f;
#define HWAIT_BAR() asm volatile("s_waitcnt vmcnt(0) lgkmcnt(0)\n\ts_barrier" ::: "memory")
__device__ __forceinline__ void dma_k(const hb* base, int pitch, unsigned lds_k, int lane, int wid) { glds16(base + (long)lane * pitch + wid * 8, (unsigned)__builtin_amdgcn_readfirstlane(lds_k + wid * 1024)); }
__device__ __forceinline__ void dma_v(const hb* base, int pitch, unsigned lds_v, int lane, int wid) { glds16(base + (long)(16 * (wid & 3) + (lane >> 2)) * pitch + (wid >> 2) * 32 + (lane & 3) * 8, (unsigned)__builtin_amdgcn_readfirstlane(lds_v + wid * 1024)); }
__device__ __forceinline__ void qkt0(f32x16& p0, f32x16& p1, const char* Kslot, const bf16x8 (&qr)[4], int r32, int hi) {
    const char* kb = Kslot + hi * 1024 + r32 * 16; const f32x16 z = {};
#pragma unroll
    for (int d0 = 0; d0 < 4; ++d0) {
        const bf16x8 b0 = *reinterpret_cast<const bf16x8*>(kb + d0 * 2048), b1 = *reinterpret_cast<const bf16x8*>(kb + d0 * 2048 + 512);
        if (d0 == 0) { p0 = __builtin_amdgcn_mfma_f32_32x32x16_bf16(b0, qr[0], z, 0, 0, 0); p1 = __builtin_amdgcn_mfma_f32_32x32x16_bf16(b1, qr[0], z, 0, 0, 0); }
        else { p0 = __builtin_amdgcn_mfma_f32_32x32x16_bf16(b0, qr[d0], p0, 0, 0, 0); p1 = __builtin_amdgcn_mfma_f32_32x32x16_bf16(b1, qr[d0], p1, 0, 0, 0); } }
}
__device__ __forceinline__ void pv_tile(f32x16 (&o)[2], int vb, const f32x16& p0, const f32x16& p1) {
    u32x4 w0, w1, w2, w3;
    w0 = (u32x4){cvtpk_s(p0[0], p0[1]), cvtpk_s(p0[2], p0[3]), cvtpk_s(p0[4], p0[5]), cvtpk_s(p0[6], p0[7])};
    w1 = (u32x4){cvtpk_s(p0[8], p0[9]), cvtpk_s(p0[10], p0[11]), cvtpk_s(p0[12], p0[13]), cvtpk_s(p0[14], p0[15])};
    w2 = (u32x4){cvtpk_s(p1[0], p1[1]), cvtpk_s(p1[2], p1[3]), cvtpk_s(p1[4], p1[5]), cvtpk_s(p1[6], p1[7])};
    w3 = (u32x4){cvtpk_s(p1[8], p1[9]), cvtpk_s(p1[10], p1[11]), cvtpk_s(p1[12], p1[13]), cvtpk_s(p1[14], p1[15])};
    attn_body::pv(o, vb, __builtin_bit_cast(bf16x8, w0), __builtin_bit_cast(bf16x8, w1), __builtin_bit_cast(bf16x8, w2), __builtin_bit_cast(bf16x8, w3));
}
__device__ __forceinline__ float xhalf(float v) {
    auto rr = __builtin_amdgcn_permlane32_swap(__float_as_uint(v), __float_as_uint(v), false, false);
    return (threadIdx.x & 32) ? __uint_as_float(rr[0]) : __uint_as_float(rr[1]);
}
__device__ __forceinline__ float rowmax32(const f32x16& p0, const f32x16& p1) {
    float a = fmaxf(p0[0], p1[0]);
#pragma unroll
    for (int r = 1; r < 16; ++r) a = fmaxf(a, fmaxf(p0[r], p1[r]));
    return fmaxf(a, xhalf(a));
}
__device__ __forceinline__ void softmax_step(f32x16& p0, f32x16& p1, float& m, float& l, f32x16 (&o)[2], float* wsf, int r32, int hi) {
    const float mn = fmaxf(m, rowmax32(p0, p1));
    const float alpha = __builtin_amdgcn_exp2f(m - mn);
    m = mn; float sum = 0.f;
#pragma unroll
    for (int r = 0; r < 16; ++r) { const float e0 = (p0[r] > -1e29f) ? __builtin_amdgcn_exp2f(p0[r] - mn) : 0.f, e1 = (p1[r] > -1e29f) ? __builtin_amdgcn_exp2f(p1[r] - mn) : 0.f; p0[r] = e0; p1[r] = e1; sum += e0 + e1; }
    l = l * alpha + sum;
    if (!__all(alpha == 1.f)) {
        CFENCE(); if (hi == 0) wsf[r32] = alpha; CFENCE();
#pragma unroll
        for (int r = 0; r < 16; ++r) { const float f = wsf[crow(r, hi)]; o[0][r] *= f; o[1][r] *= f; }
        CFENCE();
    }
}
template <bool FIRST> __device__ __forceinline__ void acc_scaled(float* stage, const f32x16 (&o)[2], float w, float* wsf, int r32, int hi) {
    CFENCE(); if (hi == 0) wsf[r32] = w; CFENCE();
#pragma unroll
    for (int r = 0; r < 16; ++r) { const int row = crow(r, hi); const float f = wsf[row]; float* p = stage + row * 64 + r32;
        if (FIRST) { p[0] = o[0][r] * f; p[32] = o[1][r] * f; } else { p[0] += o[0][r] * f; p[32] += o[1][r] * f; } }
    CFENCE();
}
template <class RowOff> __device__ __forceinline__ void store_stage(const float* stage, hb* dst, RowOff rowoff, int lane) {
    CFENCE(); asm volatile("s_waitcnt lgkmcnt(0)" ::: "memory");
#pragma unroll
    for (int i = 0; i < 4; ++i) { const int row = i * 8 + (lane >> 3), ch = lane & 7;
        const float4 a = *(const float4*)(stage + row * 64 + ch * 8), bq = *(const float4*)(stage + row * 64 + ch * 8 + 4);
        const u32x4 v = (u32x4){cvtpk_s(a.x, a.y), cvtpk_s(a.z, a.w), cvtpk_s(bq.x, bq.y), cvtpk_s(bq.z, bq.w)};
        *(u32x4*)(dst + rowoff(row) + ch * 8) = v; }
    CFENCE(); asm volatile("s_waitcnt lgkmcnt(0)" ::: "memory");
}
template <class RowOff> __device__ __forceinline__ void store_o(const f32x16 (&o)[2], hb* stg, hb* dst, RowOff rowoff, int lane, int r32, int hi) {
#pragma unroll
    for (int r = 0; r < 16; ++r) { const int orow = crow(r, hi); stg[orow * 64 + r32] = __float2bfloat16(o[0][r]); stg[orow * 64 + 32 + r32] = __float2bfloat16(o[1][r]); }
    CFENCE(); asm volatile("s_waitcnt lgkmcnt(0)" ::: "memory");
#pragma unroll
    for (int i = 0; i < 4; ++i) { const int row = i * 8 + (lane >> 3), ch = lane & 7; const u32x4 v = *(const u32x4*)(stg + row * 64 + ch * 8); *(u32x4*)(dst + rowoff(row) + ch * 8) = v; }
    CFENCE(); asm volatile("s_waitcnt lgkmcnt(0)" ::: "memory");
}

__device__ __forceinline__ void sb_unit(const Ctx& C, int b, int h, int qb, char* shm) {
    const int tid = threadIdx.x, lane = tid & 63, r32 = lane & 31, hi = lane >> 5; const int wid = __builtin_amdgcn_readfirstlane(tid >> 6);
    const hb* PR = (const hb*)(C.ws + WS_PR) + (size_t)b * T * NPROJ; const int q0 = qb * 256, tw0 = q0 + 32 * wid, t = tw0 + r32;
    const unsigned lds0 = (unsigned)(uintptr_t)shm; float* wsf = (float*)(shm + H_WSF) + wid * 64; volatile int* flags = (volatile int*)(shm + H_FLAG);
    const int vbl = ((lane >> 4) & 1) * 32 + (lane & 3) * 8 + (4 * hi + ((lane & 15) >> 2)) * 64;
    bf16x8 qr[4];
#pragma unroll
    for (int d0 = 0; d0 < 4; ++d0) qr[d0] = *reinterpret_cast<const bf16x8*>(PR + (size_t)t * NPROJ + C_QS + h * 64 + d0 * 16 + hi * 8);
    f32x16 o[2]; o[0] = f32x16{}; o[1] = f32x16{};
    float carry = 0.f; bool done = false;
    if (lane == 0) { flags[wid] = 0; flags[8 + wid] = 0; }
    const int kt_hi = (q0 + 254) >> 6;
    const hb* Kb = PR + C_KSB + h * 64; const hb* Vb = PR + C_VSB + h * 64;
    dma_k(Kb + (size_t)kt_hi * 64 * NPROJ, NPROJ, lds0, lane, wid); dma_v(Vb + (size_t)kt_hi * 64 * NPROJ, NPROJ, lds0 + 8192, lane, wid);
    for (int i = 0; i <= kt_hi; ++i) {
        const int kt = kt_hi - i, sl = (i & 1) * SLOT_BYTES;
        HWAIT_BAR();
        if (i > 0) { int alld = 1;
#pragma unroll
          for (int w = 0; w < 8; ++w) alld &= flags[((i - 1) & 1) * 8 + w];
          if (alld) break; }
        if (kt > 0) { const int sn = ((i + 1) & 1) * SLOT_BYTES; dma_k(Kb + (size_t)(kt - 1) * 64 * NPROJ, NPROJ, lds0 + sn, lane, wid); dma_v(Vb + (size_t)(kt - 1) * 64 * NPROJ, NPROJ, lds0 + sn + 8192, lane, wid); }
        if (!done && 64 * kt < tw0 + 31) {
            f32x16 p0, p1; qkt0(p0, p1, shm + sl, qr, r32, hi);
            const bool diag = (64 * kt + 63 >= tw0);
            float own[8]; f32x16 ls0, ls1;
#pragma unroll
            for (int r = 0; r < 16; ++r) {
                { const float z = p0[r]; const float L = __builtin_amdgcn_logf(1.f + __builtin_amdgcn_exp2f(-fabsf(z))); float lk = -(fmaxf(z, 0.f) + L); ls0[r] = fminf(z, 0.f) - L;
                  if (diag && (64 * kt + crow(r, hi) >= t)) { lk = 0.f; ls0[r] = NEGF; } p0[r] = lk; }
                { const float z = p1[r]; const float L = __builtin_amdgcn_logf(1.f + __builtin_amdgcn_exp2f(-fabsf(z))); float lk = -(fmaxf(z, 0.f) + L); ls1[r] = fminf(z, 0.f) - L;
                  if (diag && (64 * kt + 32 + crow(r, hi) >= t)) { lk = 0.f; ls1[r] = NEGF; } p1[r] = lk; }
            }
#pragma unroll
            for (int s = 0; s < 4; ++s) { own[s] = (p0[4 * s] + p0[4 * s + 1]) + (p0[4 * s + 2] + p0[4 * s + 3]); own[4 + s] = (p1[4 * s] + p1[4 * s + 1]) + (p1[4 * s + 2] + p1[4 * s + 3]); }
            float suf[8]; float run = 0.f;
#pragma unroll
            for (int s = 7; s >= 0; --s) { const float oth = xhalf(own[s]); const float go = hi ? own[s] : oth, ge = hi ? oth : own[s];
                const float sodd = run; run += go; const float seven = run; run += ge; suf[s] = hi ? sodd : seven; }
#pragma unroll
            for (int s = 0; s < 4; ++s) {
                { const float base = carry + suf[s]; const float k3 = p0[4 * s + 3], k2 = p0[4 * s + 2], k1 = p0[4 * s + 1];
                  p0[4 * s + 3] = (ls0[4 * s + 3] > -1e29f) ? __builtin_amdgcn_exp2f(ls0[4 * s + 3] + base) : 0.f;
                  p0[4 * s + 2] = (ls0[4 * s + 2] > -1e29f) ? __builtin_amdgcn_exp2f(ls0[4 * s + 2] + base + k3) : 0.f;
                  p0[4 * s + 1] = (ls0[4 * s + 1] > -1e29f) ? __builtin_amdgcn_exp2f(ls0[4 * s + 1] + base + (k3 + k2)) : 0.f;
                  p0[4 * s] = (ls0[4 * s] > -1e29f) ? __builtin_amdgcn_exp2f(ls0[4 * s] + base + ((k3 + k2) + k1)) : 0.f; }
                { const float base = carry + suf[4 + s]; const float k3 = p1[4 * s + 3], k2 = p1[4 * s + 2], k1 = p1[4 * s + 1];
                  p1[4 * s + 3] = (ls1[4 * s + 3] > -1e29f) ? __builtin_amdgcn_exp2f(ls1[4 * s + 3] + base) : 0.f;
                  p1[4 * s + 2] = (ls1[4 * s + 2] > -1e29f) ? __builtin_amdgcn_exp2f(ls1[4 * s + 2] + base + k3) : 0.f;
                  p1[4 * s + 1] = (ls1[4 * s + 1] > -1e29f) ? __builtin_amdgcn_exp2f(ls1[4 * s + 1] + base + (k3 + k2)) : 0.f;
                  p1[4 * s] = (ls1[4 * s] > -1e29f) ? __builtin_amdgcn_exp2f(ls1[4 * s] + base + ((k3 + k2) + k1)) : 0.f; }
            }
            carry += run;
            pv_tile(o, (int)(lds0 + sl + 8192) + vbl, p0, p1);
            if (__all(carry < -60.f)) done = true;
        }
        if (kt == 0) done = true;
        if (lane == 0) flags[(i & 1) * 8 + wid] = done ? 1 : 0;
    }
    HWAIT_BAR();
    hb* stg = (hb*)(shm + H_OST + wid * 8192); hb* dst = (hb*)(C.ws + WS_OCAT) + ((size_t)b * T + tw0) * D + 512 + h * 64;
    store_o(o, stg, dst, [](int row) { return (size_t)row * D; }, lane, r32, hi);
    HWAIT_BAR();
}

__device__ __forceinline__ void nsa_unit(const Ctx& C, int b, int g, int qblk, char* shm) {
    const int tid = threadIdx.x, lane = tid & 63, r32 = lane & 31, hi = lane >> 5; const int wid = __builtin_amdgcn_readfirstlane(tid >> 6);
    const hb* PR = (const hb*)(C.ws + WS_PR) + (size_t)b * T * NPROJ; const int q0 = qblk * 64, cur = qblk, tq0 = q0 + 8 * wid, t = tq0 + (r32 >> 2), dt = t - q0;
    const unsigned lds0 = (unsigned)(uintptr_t)shm; float* wsf = (float*)(shm + H_WSF) + wid * 64; float* imp = (float*)(shm + H_IMP) + wid * 8 * IMP_LD;
    unsigned* selm = (unsigned*)(shm + H_SELM); unsigned* wun = (unsigned*)(shm + H_WUN);
    const int vbl = ((lane >> 4) & 1) * 32 + (lane & 3) * 8 + (4 * hi + ((lane & 15) >> 2)) * 64;
    bf16x8 qr[4];
    { const hb* qp = PR + (size_t)t * NPROJ + C_QN + (g * 4 + (r32 & 3)) * 64;
#pragma unroll
      for (int d0 = 0; d0 < 4; ++d0) qr[d0] = *reinterpret_cast<const bf16x8*>(qp + d0 * 16 + hi * 8); }
    float gt[3];
    { const hb* gp = PR + (size_t)t * NPROJ + C_GL + (g * 4 + (r32 & 3)) * 3;
#pragma unroll
      for (int j = 0; j < 3; ++j) gt[j] = 1.f / (1.f + __expf(-__bfloat162float(gp[j]))); }
    for (int i = lane; i < 8 * IMP_LD; i += 64) imp[i] = 0.f;
    float* stage = (float*)(shm + H_OST + wid * 8192);
    f32x16 o[2];
    {
        const hb* KC = (const hb*)(C.ws + WS_KCMP) + (size_t)((b * 2 + g) * 512) * 64; const hb* VC = (const hb*)(C.ws + WS_VCMP) + (size_t)((b * 2 + g) * 512) * 64;
        const int ntile = (((q0 + 32) >> 4) >> 6) + 1;
        const int cmax = (t >= 31) ? ((t - 31) >> 4) : -1;
        const int cmax_w = (tq0 + 7 >= 31) ? ((tq0 + 7 - 31) >> 4) : -1;
        float m = NEGF, l = 0.f;
        dma_k(KC, 64, lds0, lane, wid);
        for (int i = 0; i < ntile; ++i) {
            const int sl = (i & 1) * SLOT_BYTES;
            HWAIT_BAR();
            if (i + 1 < ntile) dma_k(KC + (size_t)(i + 1) * 64 * 64, 64, lds0 + ((i + 1) & 1) * SLOT_BYTES, lane, wid);
            if (64 * i <= cmax_w) {
                f32x16 p0, p1; qkt0(p0, p1, shm + sl, qr, r32, hi);
#pragma unroll
                for (int r = 0; r < 16; ++r) { const int c = 64 * i + crow(r, hi); if (c > cmax) p0[r] = NEGF; if (c + 32 > cmax) p1[r] = NEGF; }
                const float mn = fmaxf(m, rowmax32(p0, p1)); float sum = 0.f;
#pragma unroll
                for (int r = 0; r < 16; ++r) sum += ((p0[r] > -1e29f) ? __builtin_amdgcn_exp2f(p0[r] - mn) : 0.f) + ((p1[r] > -1e29f) ? __builtin_amdgcn_exp2f(p1[r] - mn) : 0.f);
                l = l * __builtin_amdgcn_exp2f(m - mn) + sum; m = mn;
            }
        }
        l += xhalf(l);
        const float inv = (l > 0.f) ? 1.f / l : 0.f;
        o[0] = f32x16{}; o[1] = f32x16{};
        HWAIT_BAR();
        dma_k(KC, 64, lds0, lane, wid); dma_v(VC, 64, lds0 + 8192, lane, wid);
        for (int i = 0; i < ntile; ++i) {
            const int sl = (i & 1) * SLOT_BYTES;
            HWAIT_BAR();
            if (i + 1 < ntile) { const int sn = ((i + 1) & 1) * SLOT_BYTES; dma_k(KC + (size_t)(i + 1) * 64 * 64, 64, lds0 + sn, lane, wid); dma_v(VC + (size_t)(i + 1) * 64 * 64, 64, lds0 + sn + 8192, lane, wid); }
            if (64 * i <= cmax_w) {
                f32x16 p0, p1; qkt0(p0, p1, shm + sl, qr, r32, hi);
#pragma unroll
                for (int r = 0; r < 16; ++r) { const int c = 64 * i + crow(r, hi);
                    p0[r] = (c <= cmax) ? __builtin_amdgcn_exp2f(p0[r] - m) * inv : 0.f; p1[r] = (c + 32 <= cmax) ? __builtin_amdgcn_exp2f(p1[r] - m) * inv : 0.f; }
                float* impq = imp + (r32 >> 2) * IMP_LD;
#pragma unroll
                for (int s = 0; s < 4; ++s) {
                    float g0 = (p0[4 * s] + p0[4 * s + 1]) + (p0[4 * s + 2] + p0[4 * s + 3]), e0 = p0[4 * s + 3], g1 = (p1[4 * s] + p1[4 * s + 1]) + (p1[4 * s + 2] + p1[4 * s + 3]), e1 = p1[4 * s + 3];
                    g0 += __shfl_xor(g0, 1); g0 += __shfl_xor(g0, 2); e0 += __shfl_xor(e0, 1); e0 += __shfl_xor(e0, 2); g1 += __shfl_xor(g1, 1); g1 += __shfl_xor(g1, 2); e1 += __shfl_xor(e1, 1); e1 += __shfl_xor(e1, 2);
                    if ((r32 & 3) == 0) { const int nb = 16 * i + 2 * s + hi; atomicAdd(impq + nb, g0); atomicAdd(impq + nb + 1, e0); atomicAdd(impq + nb + 8, g1); atomicAdd(impq + nb + 9, e1); }
                }
                pv_tile(o, (int)(lds0 + sl + 8192) + vbl, p0, p1);
            }
        }
        acc_scaled<true>(stage, o, gt[0], wsf, r32, hi);
    }
    {
        CFENCE(); asm volatile("s_waitcnt lgkmcnt(0)" ::: "memory");
        const int qi = lane >> 3, j = lane & 7; const float* impq = imp + qi * IMP_LD + 16 * j;
        float v[16];
#pragma unroll
        for (int i = 0; i < 16; ++i) { const int nb = 16 * j + i; const bool forced = (nb == 0) || (nb == cur) || (nb == cur - 1); v[i] = forced ? 1e9f : ((nb <= cur) ? impq[i] : -1e9f); }
        unsigned mask16 = 0u;
#pragma unroll 1
        for (int it = 0; it < 16; ++it) {
            float bv = v[0]; int bi = 0;
#pragma unroll
            for (int i = 1; i < 16; ++i) if (v[i] > bv) { bv = v[i]; bi = i; }
            int gi = 16 * j + bi;
#pragma unroll
            for (int off = 1; off < 8; off <<= 1) { const float ov = __shfl_xor(bv, off); const int oi = __shfl_xor(gi, off); if (ov > bv || (ov == bv && oi < gi)) { bv = ov; gi = oi; } }
            if ((gi >> 4) == j) { const int w = gi & 15; mask16 |= 1u << w;
#pragma unroll
                for (int i = 0; i < 16; ++i) if (i == w) v[i] = -3e38f; }
        }
        { const int lim = cur - 16 * j; const unsigned keep = (lim >= 15) ? 0xFFFFu : ((lim < 0) ? 0u : ((1u << (lim + 1)) - 1u)); mask16 &= keep; }
        const unsigned other = __shfl_xor(mask16, 1);
        if ((j & 1) == 0) selm[(8 * wid + qi) * 4 + (j >> 1)] = mask16 | (other << 16);
        CFENCE(); asm volatile("s_waitcnt lgkmcnt(0)" ::: "memory");
    }
    unsigned selw[4]; unsigned wu[4];
    {
#pragma unroll
        for (int k = 0; k < 4; ++k) { selw[k] = selm[(8 * wid + (r32 >> 2)) * 4 + k]; unsigned u = selw[k];
#pragma unroll
            for (int off = 1; off < 64; off <<= 1) u |= __shfl_xor(u, off);
            wu[k] = __builtin_amdgcn_readfirstlane(u); }
        if (lane < 4) wun[wid * 4 + lane] = (lane == 0) ? wu[0] : (lane == 1) ? wu[1] : (lane == 2) ? wu[2] : wu[3];
    }
    HWAIT_BAR();
    unsigned bu[4];
#pragma unroll
    for (int k = 0; k < 4; ++k) { unsigned u = 0u;
#pragma unroll
        for (int w = 0; w < 8; ++w) u |= wun[w * 4 + k];
        bu[k] = __builtin_amdgcn_readfirstlane(u); }
    {
        float m = NEGF, l = 0.f; o[0] = f32x16{}; o[1] = f32x16{};
        const hb* Kb = PR + C_KS + g * 64; const hb* Vb = PR + C_VS + g * 64;
        int k_it = 0; unsigned wcur = bu[0];
#define NEXT_BLK(dst_) do { while (wcur == 0u && k_it < 3) { ++k_it; wcur = (k_it == 1) ? bu[1] : (k_it == 2) ? bu[2] : bu[3]; } \
        if (wcur == 0u) { dst_ = -1; } else { const int bit_ = __builtin_ctz(wcur); wcur &= wcur - 1u; dst_ = 32 * k_it + bit_; } } while (0)
        int nb; NEXT_BLK(nb);
        if (nb >= 0) { dma_k(Kb + (size_t)nb * 64 * NPROJ, NPROJ, lds0, lane, wid); dma_v(Vb + (size_t)nb * 64 * NPROJ, NPROJ, lds0 + 8192, lane, wid); }
        for (int i = 0; nb >= 0; ++i) {
            const int sl = (i & 1) * SLOT_BYTES; int nn; NEXT_BLK(nn);
            HWAIT_BAR();
            if (nn >= 0) { const int sn = ((i + 1) & 1) * SLOT_BYTES; dma_k(Kb + (size_t)nn * 64 * NPROJ, NPROJ, lds0 + sn, lane, wid); dma_v(Vb + (size_t)nn * 64 * NPROJ, NPROJ, lds0 + sn + 8192, lane, wid); }
            const unsigned wword = (nb < 32) ? wu[0] : (nb < 64) ? wu[1] : (nb < 96) ? wu[2] : wu[3];
            if ((wword >> (nb & 31)) & 1u) {
                const unsigned sword = (nb < 32) ? selw[0] : (nb < 64) ? selw[1] : (nb < 96) ? selw[2] : selw[3];
                const bool rowsel = ((sword >> (nb & 31)) & 1u) != 0u;
                f32x16 p0, p1; qkt0(p0, p1, shm + sl, qr, r32, hi);
                const int lim = (nb == cur) ? dt : 64;
#pragma unroll
                for (int r = 0; r < 16; ++r) { const int k = crow(r, hi); if (!rowsel || k > lim) p0[r] = NEGF; if (!rowsel || k + 32 > lim) p1[r] = NEGF; }
                softmax_step(p0, p1, m, l, o, wsf, r32, hi);
                pv_tile(o, (int)(lds0 + sl + 8192) + vbl, p0, p1);
            }
            nb = nn;
        }
#undef NEXT_BLK
        l += xhalf(l);
        acc_scaled<false>(stage, o, (l > 0.f) ? gt[1] / l : 0.f, wsf, r32, hi);
        HWAIT_BAR();
    }
    {
        float m = NEGF, l = 0.f; o[0] = f32x16{}; o[1] = f32x16{};
        const hb* Kb = PR + C_KW + g * 64; const hb* Vb = PR + C_VW + g * 64;
        const int kt0 = (cur >= 8) ? cur - 8 : 0, nt = cur - kt0 + 1;
        dma_k(Kb + (size_t)kt0 * 64 * NPROJ, NPROJ, lds0, lane, wid); dma_v(Vb + (size_t)kt0 * 64 * NPROJ, NPROJ, lds0 + 8192, lane, wid);
        for (int i = 0; i < nt; ++i) {
            const int kt = kt0 + i, sl = (i & 1) * SLOT_BYTES;
            HWAIT_BAR();
            if (i + 1 < nt) { const int sn = ((i + 1) & 1) * SLOT_BYTES; dma_k(Kb + (size_t)(kt + 1) * 64 * NPROJ, NPROJ, lds0 + sn, lane, wid); dma_v(Vb + (size_t)(kt + 1) * 64 * NPROJ, NPROJ, lds0 + sn + 8192, lane, wid); }
            f32x16 p0, p1; qkt0(p0, p1, shm + sl, qr, r32, hi);
            if (kt == cur) {
#pragma unroll
                for (int r = 0; r < 16; ++r) { const int k = crow(r, hi); if (k > dt) p0[r] = NEGF; if (k + 32 > dt) p1[r] = NEGF; }
            } else if (kt == cur - 8) {
#pragma unroll
                for (int r = 0; r < 16; ++r) { const int k = crow(r, hi); if (k <= dt) p0[r] = NEGF; if (k + 32 <= dt) p1[r] = NEGF; }
            }
            softmax_step(p0, p1, m, l, o, wsf, r32, hi);
            pv_tile(o, (int)(lds0 + sl + 8192) + vbl, p0, p1);
        }
        l += xhalf(l);
        acc_scaled<false>(stage, o, (l > 0.f) ? gt[2] / l : 0.f, wsf, r32, hi);
    }
    { hb* dst = (hb*)(C.ws + WS_OCAT) + ((size_t)b * T + tq0) * D + g * 256;
      store_stage(stage, dst, [](int row) { return (size_t)(row >> 2) * D + (row & 3) * 64; }, lane); }
    HWAIT_BAR();
}
__device__ __forceinline__ void hybrid_phase(const Ctx& C, char* shm) {
#pragma unroll 1
    for (int L = C.vcu; L < 512; L += C.G) { const int p = L >> 1, combo = p >> 6, s = p & 63; nsa_unit(C, combo >> 1, combo & 1, (L & 1) ? 127 - s : s, shm); }
#pragma unroll 1
    for (int L = C.vcu; L < 512; L += C.G) { const int p = L >> 1, combo = p >> 4, s = p & 15; sb_unit(C, combo >> 3, combo & 7, (L & 1) ? 31 - s : s, shm); }
}
#undef HWAIT_BAR
}
#ifndef HYB_MFMA
#define HYB_MFMA 1
#endif
#ifndef PH_MASK
#define PH_MASK 0xFFFFFFu
#endif
struct Args { const void* in[28]; float* out; unsigned char* ws; int ph_lo, ph_hi; };
enum Phase { P_PROLOG = 0, P_NORM0A, P_INPROJ, P_CMP, P_ATT0, P_OUT0, P_NORM0B, P_GATE0, P_UP0, P_DOWN0, P_NORM1A, P_QKV1, P_ATT1, P_COMB1, P_OUT1, P_NORM1B, P_GATE1, P_UP1, P_DOWN1, P_FINAL, N_PHASES };

__global__ void __launch_bounds__(NTHREADS, 2) mega_fwd(Args args) {
    extern __shared__ __attribute__((aligned(16))) unsigned char lds[];
    Ctx C;
    C.lds = (LAS unsigned char*)lds; C.tid = threadIdx.x; C.lane = C.tid & 63; C.wave = __builtin_amdgcn_readfirstlane(C.tid >> 6);
    C.G = gridDim.x; { const int bx = blockIdx.x; C.vcu = (C.G % 8 == 0) ? (bx % 8) * (C.G / 8) + bx / 8 : bx; }
    C.x = (const float*)args.in[0]; C.c = (const float*)args.in[1]; C.positions = (const int*)args.in[2]; C.mod_w = (const float*)args.in[3]; C.mod_b = (const float*)args.in[4];
    C.norm_mix = (const float*)args.in[5]; C.norm_ffn = (const float*)args.in[6]; C.w_gate = (const float*)args.in[7]; C.w_up = (const float*)args.in[8]; C.conv_w = (const float*)args.in[9];
    C.conv_b = (const float*)args.in[10]; C.w_down = (const float*)args.in[11]; C.hyb_w_in = (const float*)args.in[12]; C.pos_k = (const float*)args.in[13]; C.pos_v = (const float*)args.in[14];
    C.ck_w1 = (const float*)args.in[15]; C.ck_w2 = (const float*)args.in[16]; C.cv_w1 = (const float*)args.in[17]; C.cv_w2 = (const float*)args.in[18]; C.hyb_w_out = (const float*)args.in[19];
    C.diff_w_qkv = (const float*)args.in[20]; C.lq1 = (const float*)args.in[21]; C.lk1 = (const float*)args.in[22]; C.lq2 = (const float*)args.in[23]; C.lk2 = (const float*)args.in[24];
    C.subln = (const float*)args.in[25]; C.diff_w_out = (const float*)args.in[26]; C.norm_f = (const float*)args.in[27];
    C.out = args.out; C.ws = args.ws;
    unsigned char* ws = args.ws;
    volatile LAS unsigned* MISC = (volatile LAS unsigned*)(C.lds + MISC_OFF);
    for (int u = C.tid; u < 64; u += NTHREADS) MISC[u] = 0u;
    __syncthreads();
    const int lo = args.ph_lo, hi = args.ph_hi;
    const bool one_launch = (hi - lo) > 1;
    XcdBarrier bar; bar.bar = (unsigned*)(ws + WS_CTL) + CW_BAR; bar.x = 0; bar.st = nullptr;
    if (one_launch) bar = xcd_barrier_post((unsigned*)(ws + WS_CTL) + CW_BAR, MISC + 8);
#define IN(k) (((PH_MASK >> (k)) & 1u) && lo <= (k) && (k) < hi)
#define SEAM(k) do { if (IN(k) && IN((k) + 1)) xcd_barrier(bar); } while (0)
    const float* MODV = (const float*)(ws + WS_MODV);
    const float* CS = (const float*)(ws + WS_CS);
    bf16* XN = (bf16*)(ws + WS_XN);

    if (IN(P_PROLOG)) { p0_prologue(C); } SEAM(P_PROLOG);
    if (IN(P_NORM0A)) { norm_mod_rows(C, C.x, C.norm_mix, MODV + 0, MODV + 1024, XN); } SEAM(P_NORM0A);
    if (IN(P_INPROJ)) {
        pg8::Gemm g{XN, (const bf16*)(ws + WS_WIN0), M, NPROJ, D}; pg8::StaticOrder S; S.init(M, NPROJ, C.G, (int)blockIdx.x);
        pg8::EpiProj E{(bf16*)(ws + WS_PR), NPROJ, CS, 0xFu | (1u << 6) | (1u << 8), 0xFu | (0xFu << 10), QSCALE};
        pg8::gemm_phase<pg8::EpiProj, pg8::StaticOrder, true, true>(C.lds, g, S, E);
    } SEAM(P_INPROJ);
    if (IN(P_CMP)) { for (int u = blockIdx.x; u < 128; u += C.G) compress_unit(C, u); } SEAM(P_CMP);
    #if HYB_MFMA
    if (IN(P_ATT0)) { hyb::hybrid_phase(C, (char*)lds); } SEAM(P_ATT0);
#else
    if (IN(P_ATT0)) { hybrid_attention_phase(C); } SEAM(P_ATT0);
#endif
    if (IN(P_OUT0)) {
        pg8::Gemm g{(const bf16*)(ws + WS_OCAT), (const bf16*)(ws + WS_WOUT0), M, D, D}; pg8::StaticOrder S; S.init(M, D, C.G, (int)blockIdx.x);
        pg8::EpiRes E{C.x, C.out, D, MODV + 2048, 6144};
        pg8::gemm_phase<pg8::EpiRes, pg8::StaticOrder, true, true>(C.lds, g, S, E);
    } SEAM(P_OUT0);
    if (IN(P_NORM0B)) { norm_mod_rows(C, C.out, C.norm_ffn, MODV + 3072, MODV + 4096, XN); } SEAM(P_NORM0B);
    if (IN(P_GATE0)) {
        pg8::Gemm g{XN, (const bf16*)(ws + WS_WG0), M, DFF, D}; pg8::StaticOrder S; S.init(M, DFF, C.G, (int)blockIdx.x);
        pg8::EpiProj E{(bf16*)(ws + WS_G), DFF, CS, 0u, 0u, 1.f};
        pg8::gemm_phase<pg8::EpiProj, pg8::StaticOrder, true, true>(C.lds, g, S, E);
    } SEAM(P_GATE0);
    if (IN(P_UP0)) {
        pg8::Gemm g{XN, (const bf16*)(ws + WS_WU0), M, DFF, D}; pg8::StaticOrder S; S.init(M, DFF, C.G, (int)blockIdx.x);
        pg8::EpiAct E{(bf16*)(ws + WS_ACT), (const bf16*)(ws + WS_G), DFF, C.conv_w, C.conv_b};
        pg8::gemm_phase<pg8::EpiAct, pg8::StaticOrder, true, true>(C.lds, g, S, E);
    } SEAM(P_UP0);
    if (IN(P_DOWN0)) {
        pg8::Gemm g{(const bf16*)(ws + WS_ACT), (const bf16*)(ws + WS_WD0), M, D, DFF}; pg8::StaticOrder S; S.init(M, D, C.G, (int)blockIdx.x);
        pg8::EpiRes E{C.out, C.out, D, MODV + 5120, 6144};
        pg8::gemm_phase<pg8::EpiRes, pg8::StaticOrder, true, true>(C.lds, g, S, E);
    } SEAM(P_DOWN0);
    const float* MODV1 = MODV + 2 * 6144;
    if (IN(P_NORM1A)) { norm_mod_rows(C, C.out, C.norm_mix + D, MODV1 + 0, MODV1 + 1024, XN); } SEAM(P_NORM1A);
    if (IN(P_QKV1)) {
        pg8::Gemm g{XN, (const bf16*)(ws + WS_WQKV1), M, NPROJ, D}; pg8::StaticOrder S; S.init(M, NPROJ, C.G, (int)blockIdx.x);
        pg8::EpiProj E{(bf16*)(ws + WS_PR1), NPROJ, CS, 0xFFFFu, 0xFFu, QSCALE};
        pg8::gemm_phase<pg8::EpiProj, pg8::StaticOrder, true, true>(C.lds, g, S, E);
    } SEAM(P_QKV1);
    if (IN(P_ATT1)) { const attn_body::StaticOrder S(C.vcu); attn_body::diff_attn_phase<NPROJ, D>((char*)lds, (const attn_body::bf16*)(ws + WS_PR1), (attn_body::bf16*)(ws + WS_O1), (attn_body::bf16*)(ws + WS_O2), S); } SEAM(P_ATT1);
    if (IN(P_COMB1)) { diff_combine_rows(C, (const bf16*)(ws + WS_O1), (const bf16*)(ws + WS_O2), XN); } SEAM(P_COMB1);
    if (IN(P_OUT1)) {
        pg8::Gemm g{XN, (const bf16*)(ws + WS_WOUT1), M, D, D}; pg8::StaticOrder S; S.init(M, D, C.G, (int)blockIdx.x);
        pg8::EpiRes E{C.out, C.out, D, MODV1 + 2048, 6144};
        pg8::gemm_phase<pg8::EpiRes, pg8::StaticOrder, true, true>(C.lds, g, S, E);
    } SEAM(P_OUT1);
    if (IN(P_NORM1B)) { norm_mod_rows(C, C.out, C.norm_ffn + D, MODV1 + 3072, MODV1 + 4096, XN); } SEAM(P_NORM1B);
    if (IN(P_GATE1)) {
        pg8::Gemm g{XN, (const bf16*)(ws + WS_WG1), M, DFF, D}; pg8::StaticOrder S; S.init(M, DFF, C.G, (int)blockIdx.x);
        pg8::EpiProj E{(bf16*)(ws + WS_G), DFF, CS, 0u, 0u, 1.f};
        pg8::gemm_phase<pg8::EpiProj, pg8::StaticOrder, true, true>(C.lds, g, S, E);
    } SEAM(P_GATE1);
    if (IN(P_UP1)) {
        pg8::Gemm g{XN, (const bf16*)(ws + WS_WU1), M, DFF, D}; pg8::StaticOrder S; S.init(M, DFF, C.G, (int)blockIdx.x);
        pg8::EpiAct E{(bf16*)(ws + WS_ACT), (const bf16*)(ws + WS_G), DFF, C.conv_w + 3 * DFF, C.conv_b + DFF};
        pg8::gemm_phase<pg8::EpiAct, pg8::StaticOrder, true, true>(C.lds, g, S, E);
    } SEAM(P_UP1);
    if (IN(P_DOWN1)) {
        pg8::Gemm g{(const bf16*)(ws + WS_ACT), (const bf16*)(ws + WS_WD1), M, D, DFF}; pg8::StaticOrder S; S.init(M, D, C.G, (int)blockIdx.x);
        pg8::EpiRes E{C.out, C.out, D, MODV1 + 5120, 6144};
        pg8::gemm_phase<pg8::EpiRes, pg8::StaticOrder, true, true>(C.lds, g, S, E);
    } SEAM(P_DOWN1);
    if (IN(P_FINAL)) { final_norm_rows(C, C.out, C.norm_f); }
#undef IN
#undef SEAM
}

#ifndef MK_PER_PHASE
#define MK_PER_PHASE 0
#endif
extern "C" void kernel_launch(void* const* d_in, const int* in_sizes, int n_in, void* d_out, int out_size, void* d_ws, size_t ws_size, hipStream_t stream) {
    static int grid = 0;
    if (grid == 0) {
        if (n_in != 28 || in_sizes[0] != M * D || out_size != M * D || ws_size < WS_END) { fprintf(stderr, "kernel_launch: unexpected problem (n_in %d, in0 %d, out %d, ws %zu; need ws >= %zu); nothing launched\n", n_in, n_in > 0 ? in_sizes[0] : -1, out_size, ws_size, (size_t)WS_END); grid = -1; return; }
        int dev = 0, cus = 0, per_cu = 0;
        if (hipGetDevice(&dev) != hipSuccess || hipDeviceGetAttribute(&cus, hipDeviceAttributeMultiprocessorCount, dev) != hipSuccess) { fprintf(stderr, "kernel_launch: device query failed\n"); grid = -1; return; }
        if (hipFuncSetAttribute((const void*)mega_fwd, hipFuncAttributeMaxDynamicSharedMemorySize, LDS_BYTES) != hipSuccess) { fprintf(stderr, "kernel_launch: hipFuncSetAttribute failed\n"); grid = -1; return; }
        if (hipOccupancyMaxActiveBlocksPerMultiprocessor(&per_cu, (const void*)mega_fwd, NTHREADS, LDS_BYTES) != hipSuccess || per_cu < 1) { fprintf(stderr, "kernel_launch: occupancy query reports %d workgroups per CU\n", per_cu); per_cu = 1; }
        (void)hipGetLastError();
        grid = cus;
        if (grid % 8 != 0 || grid > 256) { grid = (grid > 256) ? 256 : (grid / 8) * 8; }
        fprintf(stderr, "kernel_launch: grid %d (cus %d, occupancy %d/CU)\n", grid, cus, per_cu);
    }
    if (grid <= 0) return;
    (void)hipMemsetAsync((char*)d_ws + WS_CTL, 0, CTL_ZERO_BYTES, stream);
    Args a{};
    for (int i = 0; i < 28; ++i) a.in[i] = d_in[i];
    a.out = (float*)d_out; a.ws = (unsigned char*)d_ws;
#if MK_PER_PHASE
    for (int p = 0; p < N_PHASES; ++p) { a.ph_lo = p; a.ph_hi = p + 1; hipLaunchKernelGGL(mega_fwd, dim3(grid), dim3(NTHREADS), LDS_BYTES, stream, a); }
#else
    a.ph_lo = 0; a.ph_hi = N_PHASES; hipLaunchKernelGGL(mega_fwd, dim3(grid), dim3(NTHREADS), LDS_BYTES, stream, a);
#endif
    const hipError_t le = hipPeekAtLastError();
    if (le != hipSuccess) fprintf(stderr, "kernel_launch: launch failed: %s\n", hipGetErrorName(le));
}
```

```cpp
#include <hip/hip_runtime.h>
#include <hip/hip_bf16.h>
#include <cstdio>
#include <cstdint>
#include <cmath>
namespace pg8 {
#define PG8_LAS __attribute__((address_space(3)))
typedef unsigned short bf16_t;
typedef short bf16x8 __attribute__((ext_vector_type(8)));
typedef float f32x4 __attribute__((ext_vector_type(4)));
typedef unsigned u32x4 __attribute__((ext_vector_type(4)));
constexpr int BM = 256, BK = 64, HALF = 128, HTB = HALF * BK * 2  , STAGE_BYTES = 8 * HTB, NXCD = 8, WGM = 8;

__host__ __device__ __forceinline__ int lds_byte(int r, int c) { const int st = (r >> 4) * 2 + (c >> 5), rr = r & 15, cc = c & 31, ob = rr * 64 + cc * 2; return st * 1024 + (ob ^ (((ob >> 9) & 1) << 5)); }
__host__ __device__ __forceinline__ void stage_rc(int b, int& R, int& C) { const int st = b / 1024, sb = b % 1024, swz = sb ^ (((sb >> 9) & 1) << 5); R = (st >> 1) * 16 + swz / 64; C = (st & 1) * 32 + (swz % 64) / 2; }
__host__ __device__ __forceinline__ int perm32(int rho) { const int n = rho >> 4, i = rho & 15; return 8 * (i >> 2) + 4 * n + (i & 3); }

struct Unit { int pm, pn; };
struct Gemm { const bf16_t* A; const bf16_t* Bt; int M, N, K; };

struct StaticOrder {
    int nM, nN, nwg, G, c;
    __host__ __device__ void init(int M, int N, int G_, int c_) { nM = M / BM; nN = N / BM; nwg = nM * nN; G = G_; c = c_; }
    __host__ __device__ bool next(int i, Unit& u) const {
        const long L = (long)i * G + c; if (L >= nwg) return false;
        int wgid = (int)L; { const int q = nwg / NXCD, r = nwg % NXCD, xcd = wgid % NXCD, off = wgid / NXCD; wgid = (xcd < r ? xcd * (q + 1) : r * (q + 1) + (xcd - r) * q) + off; }
        const int nig = WGM * nN, gid = wgid / nig, fm = gid * WGM, gsz = (nM - fm) < WGM ? (nM - fm) : WGM;
        u.pm = fm + ((wgid % nig) % gsz); u.pn = (wgid % nig) / gsz; return true;
    }
    __device__ __forceinline__ void a_ready(const Unit&) const {}
    __device__ __forceinline__ void done(const Unit&) const {}
};

__device__ __forceinline__ unsigned cvt_pk_bf16(float lo, float hi) { unsigned r; asm volatile("v_cvt_pk_bf16_f32 %0, %1, %2" : "=v"(r) : "v"(lo), "v"(hi)); return r; }
typedef float f32x2 __attribute__((ext_vector_type(2)));
__device__ __forceinline__ float bflo(unsigned w) { return __uint_as_float(w << 16); }
__device__ __forceinline__ float bfhi(unsigned w) { return __uint_as_float(w & 0xffff0000u); }
struct EpiProj {
    static constexpr bool PERM = true, AFTER_DRAIN = false;
    bf16_t* O; int ldc; const float* cs; unsigned ropemask, scalemask; float qscale;
    __device__ __forceinline__ void operator()(const f32x4 (&acc)[2][2][4][2], const Unit& u, int wr, int wc, int fr, int fq) const {
        const int row0 = u.pm * BM + wr * 64 + fr, col0 = u.pn * BM + wc * 32 + 8 * fq;
#pragma unroll
        for (int bj = 0; bj < 2; ++bj) {
            const unsigned bit = 1u << (2 * u.pn + bj);
            const float sc = (scalemask & bit) ? qscale : 1.f;
            const bool rope = ((ropemask & bit) != 0u) && ((wc & 1) == 0);
#pragma unroll
            for (int ai = 0; ai < 2; ++ai)
#pragma unroll
                for (int m = 0; m < 4; ++m) {
                    const int row = row0 + ai * HALF + m * 16;
                    f32x4 v0 = acc[ai][bj][m][0] * sc, v1 = acc[ai][bj][m][1] * sc;
                    if (rope) {
                        const float* t = cs + (size_t)row * 16;
                        const f32x4 c0 = *(const f32x4*)t, c1 = *(const f32x4*)(t + 4), s0 = *(const f32x4*)(t + 8), s1 = *(const f32x4*)(t + 12);
                        f32x4 p0, p1;
#pragma unroll
                        for (int j = 0; j < 4; ++j) { p0[j] = __shfl_xor(v0[j], 16); p1[j] = __shfl_xor(v1[j], 16); }
                        if (fq < 2) { const float sg = (fq == 0) ? -1.f : 1.f; v0 = v0 * c0 + p0 * s0 * sg; v1 = v1 * c1 + p1 * s1 * sg; }
                    }
                    u32x4 w; w.x = cvt_pk_bf16(v0[0], v0[1]); w.y = cvt_pk_bf16(v0[2], v0[3]); w.z = cvt_pk_bf16(v1[0], v1[1]); w.w = cvt_pk_bf16(v1[2], v1[3]);
                    *(u32x4*)(O + (size_t)row * ldc + col0 + bj * HALF) = w;
                }
        }
    }
};
struct EpiAct {
    static constexpr bool PERM = true, AFTER_DRAIN = false;
    bf16_t* O; const bf16_t* G; int ldc; const float* cw; const float* cb;
    __device__ __forceinline__ void operator()(const f32x4 (&acc)[2][2][4][2], const Unit& u, int wr, int wc, int fr, int fq) const {
        const int row0 = u.pm * BM + wr * 64 + fr, col0 = u.pn * BM + wc * 32 + 8 * fq;
#pragma unroll
        for (int bj = 0; bj < 2; ++bj) {
            const int col = col0 + bj * HALF;
            f32x4 k0[2], k1[2], k2[2], bb[2];
#pragma unroll
            for (int n = 0; n < 2; ++n) { k0[n] = *(const f32x4*)(cw + col + 4 * n); k1[n] = *(const f32x4*)(cw + ldc + col + 4 * n); k2[n] = *(const f32x4*)(cw + 2 * ldc + col + 4 * n); bb[n] = *(const f32x4*)(cb + col + 4 * n); }
#pragma unroll
            for (int ai = 0; ai < 2; ++ai)
#pragma unroll
                for (int m = 0; m < 4; ++m) {
                    const int row = row0 + ai * HALF + m * 16, t = row & 8191;
                    const bf16_t* gp = G + (size_t)row * ldc + col;
                    const u32x4 g2 = *(const u32x4*)gp;
                    u32x4 g1 = (u32x4){0u, 0u, 0u, 0u}, g0 = (u32x4){0u, 0u, 0u, 0u};
                    if (t >= 1) g1 = *(const u32x4*)(gp - ldc);
                    if (t >= 2) g0 = *(const u32x4*)(gp - 2 * ldc);
                    f32x4 r[2];
#pragma unroll
                    for (int n = 0; n < 2; ++n) {
                        const unsigned a0 = n ? g0.z : g0.x, a1 = n ? g0.w : g0.y, b0 = n ? g1.z : g1.x, b1 = n ? g1.w : g1.y, c0 = n ? g2.z : g2.x, c1 = n ? g2.w : g2.y;
                        f32x4 x0 = (f32x4){bflo(a0), bfhi(a0), bflo(a1), bfhi(a1)}, x1 = (f32x4){bflo(b0), bfhi(b0), bflo(b1), bfhi(b1)}, x2 = (f32x4){bflo(c0), bfhi(c0), bflo(c1), bfhi(c1)};
                        f32x4 cv = k0[n] * x0 + k1[n] * x1 + k2[n] * x2 + bb[n];
#pragma unroll
                        for (int j = 0; j < 4; ++j) { const float e = __builtin_amdgcn_exp2f(-1.4426950408889634f * cv[j]); cv[j] = cv[j] * __builtin_amdgcn_rcpf(1.f + e); }
                        r[n] = cv * acc[ai][bj][m][n];
                    }
                    u32x4 w; w.x = cvt_pk_bf16(r[0][0], r[0][1]); w.y = cvt_pk_bf16(r[0][2], r[0][3]); w.z = cvt_pk_bf16(r[1][0], r[1][1]); w.w = cvt_pk_bf16(r[1][2], r[1][3]);
                    *(u32x4*)(O + (size_t)row * ldc + col) = w;
                }
        }
    }
};
struct EpiRes {
    static constexpr bool PERM = false, AFTER_DRAIN = false;
    const float* base; float* out; int ldc; const float* gate; int gstride;
    __device__ __forceinline__ void operator()(const f32x4 (&acc)[2][2][4][2], const Unit& u, int wr, int wc, int fr, int fq) const {
        const int col0 = u.pn * BM + wc * 32 + 4 * fq; const float* gp = gate + (size_t)((u.pm * BM) >> 13) * gstride;
        f32x4 gv[2][2];
#pragma unroll
        for (int bj = 0; bj < 2; ++bj)
#pragma unroll
            for (int n = 0; n < 2; ++n) gv[bj][n] = *(const f32x4*)(gp + col0 + bj * HALF + n * 16);
#pragma unroll
        for (int ai = 0; ai < 2; ++ai)
#pragma unroll
            for (int m = 0; m < 4; ++m) { const size_t off = (size_t)(u.pm * BM + ai * HALF + wr * 64 + m * 16 + fr) * ldc + col0;
#pragma unroll
                for (int bj = 0; bj < 2; ++bj)
#pragma unroll
                    for (int n = 0; n < 2; ++n) { const f32x4 bs = *(const f32x4*)(base + off + bj * HALF + n * 16); *(f32x4*)(out + off + bj * HALF + n * 16) = bs + gv[bj][n] * acc[ai][bj][m][n]; }
                if (m & 1) asm volatile("" ::: "memory"); }
    }
};
template <class Epi, class Sched, bool ALIGN_EPI = false, bool SP2 = false>
__device__ __forceinline__ void gemm_phase(PG8_LAS unsigned char* lds, const Gemm g, const Sched& S, const Epi& E) {
    const int tid = threadIdx.x, wid = __builtin_amdgcn_readfirstlane(tid >> 6), lane = tid & 63, wr = wid >> 2, wc = wid & 3, fr = lane & 15, fq = lane >> 4;
    const int K = g.K, nt = K / BK;
    unsigned voffA[2], voffB[2];
#pragma unroll
    for (int i = 0; i < 2; ++i) { int R, C; stage_rc(tid * 16 + i * 8192, R, C); const int Rb = Epi::PERM ? ((R & ~31) + perm32(R & 31)) : R;
        voffA[i] = (unsigned)(R * K + C) * 2u; voffB[i] = (unsigned)(Rb * K + C) * 2u; }
    const size_t kstep = (size_t)(BK * 2);
    const size_t hstep = (size_t)HALF * K * 2;
    const size_t tstep = 2 * hstep;
    const unsigned ldsw = (unsigned)wid * 1024u;
    const int aoff = lds_byte(wr * 64 + fr, fq * 8), boff = lds_byte(wc * 32 + fr, fq * 8);
#define PG8_SA(b, h) (((b) * 2 + (h)) * HTB)
#define PG8_SB(b, h) ((4 + (b) * 2 + (h)) * HTB)
#define PG8_STAGE(bufoff, gbase, voff) do { _Pragma("unroll") for (int _i = 0; _i < 2; ++_i) \
        __builtin_amdgcn_global_load_lds((const unsigned*)((const char*)(gbase) + (voff)[_i]), (PG8_LAS unsigned*)(lds + (bufoff) + ldsw + _i * 8192), 16, 0, 0); } while (0)
#define PG8_LDA(dst, b, h) do { _Pragma("unroll") for (int m = 0; m < 4; ++m) _Pragma("unroll") for (int k = 0; k < 2; ++k) dst[m][k] = *(const PG8_LAS bf16x8*)(lds + PG8_SA(b, h) + aoff + m * 2048 + k * 1024); } while (0)
#define PG8_LDB(dst, b, h) do { _Pragma("unroll") for (int n = 0; n < 2; ++n) _Pragma("unroll") for (int k = 0; k < 2; ++k) dst[n][k] = *(const PG8_LAS bf16x8*)(lds + PG8_SB(b, h) + boff + n * 2048 + k * 1024); } while (0)
#define PG8_MMA(ai, bj, At, Bt) do { __builtin_amdgcn_s_setprio(1); _Pragma("unroll") for (int m = 0; m < 4; ++m) _Pragma("unroll") for (int n = 0; n < 2; ++n) _Pragma("unroll") for (int k = 0; k < 2; ++k) \
        acc[ai][bj][m][n] = __builtin_amdgcn_mfma_f32_16x16x32_bf16(Bt[n][k], At[m][k], acc[ai][bj][m][n], 0, 0, 0); __builtin_amdgcn_s_setprio(0); } while (0)
#define PG8_WAIT_V(n) asm volatile("s_waitcnt vmcnt(" #n ")" ::: "memory")
#define PG8_WAIT_L(n) asm volatile("s_waitcnt lgkmcnt(" #n ")" ::: "memory")
#define PG8_BAR __builtin_amdgcn_s_barrier()
#define PG8_SCHED __builtin_amdgcn_sched_barrier(0)
    Unit cur, nxt; int ui = 0;
    if (!S.next(0, cur)) return;
    f32x4 acc[2][2][4][2];
#pragma unroll
    for (int a = 0; a < 2; ++a)
#pragma unroll
        for (int b = 0; b < 2; ++b)
#pragma unroll
            for (int m = 0; m < 4; ++m)
#pragma unroll
                for (int n = 0; n < 2; ++n) acc[a][b][m][n] = (f32x4){0.f, 0.f, 0.f, 0.f};
    bf16x8 At[4][2], B0[2][2], B1[2][2];
    const char* cA = (const char*)g.A + (size_t)cur.pm * tstep; const char* cB = (const char*)g.Bt + (size_t)cur.pn * tstep;
    S.a_ready(cur);
    if constexpr (SP2) {
        PG8_STAGE(PG8_SB(0, 0), cB, voffB); PG8_STAGE(PG8_SB(0, 1), cB + hstep, voffB); PG8_STAGE(PG8_SA(0, 0), cA, voffA); PG8_STAGE(PG8_SA(0, 1), cA + hstep, voffA);
        if (wr == 1) PG8_BAR;
        PG8_WAIT_V(2); PG8_BAR;
        PG8_STAGE(PG8_SB(1, 0), cB + kstep, voffB); PG8_STAGE(PG8_SA(1, 0), cA + kstep, voffA); PG8_STAGE(PG8_SB(1, 1), cB + hstep + kstep, voffB);
        PG8_WAIT_V(6); PG8_BAR;
    } else {
        PG8_STAGE(PG8_SB(0, 0), cB, voffB); PG8_STAGE(PG8_SA(0, 0), cA, voffA); PG8_STAGE(PG8_SB(0, 1), cB + hstep, voffB); PG8_STAGE(PG8_SA(0, 1), cA + hstep, voffA);
        if (wr == 1) PG8_BAR;
        PG8_WAIT_V(4); PG8_BAR;
        PG8_STAGE(PG8_SB(1, 0), cB + kstep, voffB); PG8_STAGE(PG8_SA(1, 0), cA + kstep, voffA); PG8_STAGE(PG8_SB(1, 1), cB + hstep + kstep, voffB);
        PG8_WAIT_V(6); PG8_BAR;
    }
    for (;;) {
        const bool has_next = S.next(ui + 1, nxt);
        const char* nA = has_next ? (const char*)g.A + (size_t)nxt.pm * tstep : cA; const char* nB = has_next ? (const char*)g.Bt + (size_t)nxt.pn * tstep : cB;
        for (int t = 0; t < nt; t += 2) {
            const bool last = (t == nt - 2);
            const char* a1 = cA + (size_t)(t + 1) * kstep;
            const char* a2 = last ? nA : cA + (size_t)(t + 2) * kstep; const char* b2 = last ? nB : cB + (size_t)(t + 2) * kstep;
            const char* a3 = a2 + kstep; const char* b3 = b2 + kstep;
            if (last && has_next) S.a_ready(nxt);
            if constexpr (SP2) {
            PG8_LDB(B0, 0, 0); PG8_LDB(B1, 0, 1); PG8_SCHED; PG8_LDA(At, 0, 0); PG8_STAGE(PG8_SA(1, 1), a1 + hstep, voffA);
            PG8_WAIT_V(8); PG8_WAIT_L(0); PG8_BAR; PG8_MMA(0, 0, At, B0); PG8_MMA(0, 1, At, B1); PG8_BAR; PG8_SCHED;
            PG8_LDA(At, 0, 1); PG8_STAGE(PG8_SB(0, 0), b2, voffB); PG8_STAGE(PG8_SB(0, 1), b2 + hstep, voffB); PG8_STAGE(PG8_SA(0, 0), a2, voffA);
            PG8_WAIT_V(8); PG8_WAIT_L(0); PG8_BAR; PG8_MMA(1, 0, At, B0); PG8_MMA(1, 1, At, B1); PG8_BAR; PG8_SCHED;
            PG8_LDB(B0, 1, 0); PG8_LDB(B1, 1, 1); PG8_SCHED; PG8_LDA(At, 1, 0); PG8_STAGE(PG8_SA(0, 1), a2 + hstep, voffA);
            PG8_WAIT_V(8); PG8_WAIT_L(0); PG8_BAR; PG8_MMA(0, 0, At, B0); PG8_MMA(0, 1, At, B1); PG8_BAR; PG8_SCHED;
            PG8_LDA(At, 1, 1); PG8_STAGE(PG8_SB(1, 0), b3, voffB); PG8_STAGE(PG8_SB(1, 1), b3 + hstep, voffB); PG8_STAGE(PG8_SA(1, 0), a3, voffA);
            PG8_WAIT_V(8); PG8_WAIT_L(0); PG8_BAR; PG8_MMA(1, 0, At, B0); PG8_MMA(1, 1, At, B1); PG8_BAR; PG8_SCHED;
            } else {
            PG8_LDB(B0, 0, 0); PG8_SCHED; PG8_LDA(At, 0, 0); PG8_STAGE(PG8_SA(1, 1), a1 + hstep, voffA);
            PG8_WAIT_L(8); PG8_BAR; PG8_WAIT_L(0); PG8_MMA(0, 0, At, B0); PG8_BAR; PG8_SCHED;
            PG8_LDB(B1, 0, 1); PG8_STAGE(PG8_SB(0, 0), b2, voffB);
            PG8_BAR; PG8_WAIT_L(0); PG8_MMA(0, 1, At, B1); PG8_BAR;
            PG8_LDA(At, 0, 1); PG8_STAGE(PG8_SA(0, 0), a2, voffA);
            PG8_BAR; PG8_WAIT_L(0); PG8_MMA(1, 0, At, B0); PG8_BAR; PG8_SCHED;
            PG8_STAGE(PG8_SB(0, 1), b2 + hstep, voffB);
            PG8_WAIT_V(6); PG8_BAR; PG8_MMA(1, 1, At, B1); PG8_BAR;
            PG8_LDB(B0, 1, 0); PG8_SCHED; PG8_LDA(At, 1, 0); PG8_STAGE(PG8_SA(0, 1), a2 + hstep, voffA);
            PG8_WAIT_L(8); PG8_BAR; PG8_WAIT_L(0); PG8_MMA(0, 0, At, B0); PG8_BAR; PG8_SCHED;
            PG8_LDB(B1, 1, 1); PG8_STAGE(PG8_SB(1, 0), b3, voffB);
            PG8_BAR; PG8_WAIT_L(0); PG8_MMA(0, 1, At, B1); PG8_BAR;
            PG8_LDA(At, 1, 1); PG8_STAGE(PG8_SA(1, 0), a3, voffA);
            PG8_BAR; PG8_WAIT_L(0); PG8_MMA(1, 0, At, B0); PG8_BAR; PG8_SCHED;
            PG8_STAGE(PG8_SB(1, 1), b3 + hstep, voffB);
            PG8_WAIT_V(6); PG8_BAR; PG8_MMA(1, 1, At, B1); PG8_BAR;
            }
        }
        if constexpr (ALIGN_EPI) { if (wr == 0) PG8_BAR; }
        if constexpr (!Epi::AFTER_DRAIN) { E(acc, cur, wr, wc, fr, fq); S.done(cur); }
        if (!has_next) break;
#pragma unroll
        for (int a = 0; a < 2; ++a)
#pragma unroll
            for (int b = 0; b < 2; ++b)
#pragma unroll
                for (int m = 0; m < 4; ++m)
#pragma unroll
                    for (int n = 0; n < 2; ++n) acc[a][b][m][n] = (f32x4){0.f, 0.f, 0.f, 0.f};
        cur = nxt; cA = nA; cB = nB; ++ui;
        if constexpr (ALIGN_EPI) { if (wr == 1) PG8_BAR; }
    }
    PG8_WAIT_V(0);
    if constexpr (!ALIGN_EPI) { if (wr == 0) PG8_BAR; }
    PG8_BAR;
    if constexpr (Epi::AFTER_DRAIN) { E.fused(acc, cur, wr, wc, fr, fq, lds, wid, lane); S.done(cur); }
#undef PG8_SA
#undef PG8_SB
#undef PG8_STAGE
#undef PG8_LDA
#undef PG8_LDB
#undef PG8_MMA
#undef PG8_WAIT_V
#undef PG8_WAIT_L
#undef PG8_BAR
#undef PG8_SCHED
}
}
#include <hip/hip_bf16.h>
#include <cmath>
namespace attn_body {
using bf16=__hip_bfloat16;
using bf16x8=__attribute__((ext_vector_type(8)))short;
using s16x4=__attribute__((ext_vector_type(4)))short;
using f32x16=__attribute__((ext_vector_type(16)))float;
using u32x4=__attribute__((ext_vector_type(4)))unsigned;
constexpr int SEQ=8192,D=64;
constexpr int NW=8,QBLK=32,QB=QBLK*NW,KVBLK=64,NQB=SEQ/QB;
constexpr int ATTN_UNIT_ROWS=QB;
__device__ __forceinline__ int crow(int r,int hi){return (r&3)+8*(r>>2)+4*hi;}
#define SBAR() __builtin_amdgcn_sched_barrier(0)
__device__ __forceinline__ void cmask(f32x16&p0,f32x16&p1,int jb,int qrel,int hi){
  const float NEG=-INFINITY; int kb=64*jb+4*hi;
  #pragma unroll
  for(int r=0;r<16;++r){int kv=kb+(r&3)+8*(r>>2); if(kv>qrel)p0[r]=NEG; if(kv+32>qrel)p1[r]=NEG;}
}

constexpr int NSLOT=3, SLOTB=8192;
constexpr int LDS_K=0, LDS_V=NSLOT*SLOTB, LDS_WS=2*NSLOT*SLOTB, LDS_OST=LDS_WS+NW*64*4, LDS_BYTES=LDS_OST+NW*4096;
constexpr float C2=0.125f*1.4426950408889634f;
__device__ __forceinline__ void glds16(const void*gsrc,unsigned lds_dst){unsigned keep;
  asm volatile("s_mov_b32 %0, m0\n\ts_mov_b32 m0, %2\n\ts_nop 0\n\tglobal_load_lds_dwordx4 %1, off\n\ts_mov_b32 m0, %0":"=&s"(keep):"v"(gsrc),"s"(lds_dst):"memory");}
__device__ __forceinline__ float max3f(float a,float b,float c){float r;asm("v_max3_f32 %0, %1, %2, %3":"=v"(r):"v"(a),"v"(b),"v"(c));return r;}
__device__ __forceinline__ float max2f(float a,float b){float r;asm("v_max_f32_e32 %0, %1, %2":"=v"(r):"v"(a),"v"(b));return r;}
__device__ __forceinline__ float fadd_s(float a,float b){float r;asm("v_add_f32_e32 %0, %1, %2":"=v"(r):"v"(a),"v"(b));return r;}
__device__ __forceinline__ float fsub_s(float a,float b){float r;asm("v_sub_f32_e32 %0, %1, %2":"=v"(r):"v"(a),"v"(b));return r;}
typedef float f32x2_t __attribute__((ext_vector_type(2))); typedef __bf16 bf16x2_t __attribute__((ext_vector_type(2)));
__device__ __forceinline__ unsigned cvtpk_s(float lo,float hi){f32x2_t v={lo,hi};bf16x2_t b=__builtin_convertvector(v,bf16x2_t);return __builtin_bit_cast(unsigned,b);}
#define WAIT_BAR(N) asm volatile("s_waitcnt vmcnt(" #N ") lgkmcnt(0)\n\ts_barrier":::"memory")

__device__ __forceinline__ void qkt(f32x16&p0,f32x16&p1,const char*Kslot,const bf16x8*qr,const f32x16&negm,int r32,int hi){
  const char*kb=Kslot+hi*1024+r32*16;
  #pragma unroll
  for(int d0=0;d0<4;++d0){
    const bf16x8 b0=*reinterpret_cast<const bf16x8*>(kb+d0*2048);
    const bf16x8 b1=*reinterpret_cast<const bf16x8*>(kb+d0*2048+512);
    if(d0==0){p0=__builtin_amdgcn_mfma_f32_32x32x16_bf16(b0,qr[0],negm,0,0,0);p1=__builtin_amdgcn_mfma_f32_32x32x16_bf16(b1,qr[0],negm,0,0,0);}
    else{p0=__builtin_amdgcn_mfma_f32_32x32x16_bf16(b0,qr[d0],p0,0,0,0);p1=__builtin_amdgcn_mfma_f32_32x32x16_bf16(b1,qr[d0],p1,0,0,0);}}
}
typedef __attribute__((address_space(3))) const char* lds_cptr;
typedef short v4i16_t __attribute__((ext_vector_type(4)));
__device__ __forceinline__ void kload8(bf16x8*kf,lds_cptr kp){
  kf[0]=*(const __attribute__((address_space(3))) bf16x8*)(kp);      kf[1]=*(const __attribute__((address_space(3))) bf16x8*)(kp+512);
  kf[2]=*(const __attribute__((address_space(3))) bf16x8*)(kp+2048); kf[3]=*(const __attribute__((address_space(3))) bf16x8*)(kp+2560);
  kf[4]=*(const __attribute__((address_space(3))) bf16x8*)(kp+4096); kf[5]=*(const __attribute__((address_space(3))) bf16x8*)(kp+4608);
  kf[6]=*(const __attribute__((address_space(3))) bf16x8*)(kp+6144); kf[7]=*(const __attribute__((address_space(3))) bf16x8*)(kp+6656);
}
__device__ __forceinline__ void kload2(bf16x8*kf,lds_cptr kp,int j){ kf[2*j]=*(const __attribute__((address_space(3))) bf16x8*)(kp+j*2048); kf[2*j+1]=*(const __attribute__((address_space(3))) bf16x8*)(kp+j*2048+512); }
__device__ __forceinline__ s16x4 vtr(lds_cptr p){ return __builtin_bit_cast(s16x4,__builtin_amdgcn_ds_read_tr16_b64_v4i16((__attribute__((address_space(3))) v4i16_t*)p)); }
__device__ __forceinline__ float rowmax(const f32x16&p0,const f32x16&p1){
  float a=max3f(p0[0],p0[1],p1[0]),b=max3f(p0[2],p0[3],p1[1]);a=max3f(a,p1[2],p1[3]);
  #pragma unroll
  for(int r=4;r<16;r+=4){a=max3f(a,p0[r],p0[r+1]);b=max3f(b,p0[r+2],p0[r+3]);a=max3f(a,p1[r],p1[r+1]);b=max3f(b,p1[r+2],p1[r+3]);}
  const float m=max2f(a,b);
  auto rr=__builtin_amdgcn_permlane32_swap(__float_as_uint(m),__float_as_uint(m),false,false);
  return max2f(__uint_as_float(rr[0]),__uint_as_float(rr[1]));
}
__device__ __forceinline__ void pv(f32x16*o,int vb,bf16x8 pa0,bf16x8 pa1,bf16x8 pa2,bf16x8 pa3){
  #pragma unroll
  for(int d0=0;d0<2;++d0){s16x4 lo[4],hi[4];
    #pragma unroll
    for(int ks=0;ks<4;++ks){
      asm volatile("ds_read_b64_tr_b16 %0,%1 offset:%c2":"=&v"(lo[ks]):"v"(vb),"i"(d0*4096+ks*1024):"memory");
      asm volatile("ds_read_b64_tr_b16 %0,%1 offset:%c2":"=&v"(hi[ks]):"v"(vb),"i"(d0*4096+ks*1024+512):"memory");}
    asm volatile("s_waitcnt lgkmcnt(0)":::"memory");SBAR();
    #define PK(k) (bf16x8){lo[k][0],lo[k][1],lo[k][2],lo[k][3],hi[k][0],hi[k][1],hi[k][2],hi[k][3]}
    o[d0]=__builtin_amdgcn_mfma_f32_32x32x16_bf16(pa0,PK(0),o[d0],0,0,0);
    o[d0]=__builtin_amdgcn_mfma_f32_32x32x16_bf16(pa1,PK(1),o[d0],0,0,0);
    o[d0]=__builtin_amdgcn_mfma_f32_32x32x16_bf16(pa2,PK(2),o[d0],0,0,0);
    o[d0]=__builtin_amdgcn_mfma_f32_32x32x16_bf16(pa3,PK(3),o[d0],0,0,0);
    #undef PK
  }
}

#ifndef ATTN_STORE16
#define ATTN_STORE16(p,v) (*(u32x4*)(p)=(v))
#endif
template<int THRL,int PIN,int POUT> __device__ __forceinline__ void attn_unit(int b,int h,int qb,const bf16*Q,const bf16*__restrict__ K,const bf16*__restrict__ V,bf16*O,char*shm){
  const int tid=threadIdx.x,lane=tid&63,r32=lane&31,hi=lane>>5; const int wid=__builtin_amdgcn_readfirstlane(tid>>6);
  const long rowbase=(long)b*SEQ; const int q0=qb*QB;
  const bf16*Qw=Q+(rowbase+q0+wid*QBLK)*PIN+h*D;
  const bf16*Kh=K+rowbase*PIN+h*D,*Vh=V+rowbase*PIN+h*D;
  const unsigned lds0=(unsigned)(uintptr_t)shm;
  float*wsf=(float*)(shm+LDS_WS)+wid*64;
  const bf16*ksrc=Kh+(long)lane*PIN+wid*8;
  const bf16*vsrc=Vh+(long)(16*(wid&3)+(lane>>2))*PIN+(wid>>2)*32+(lane&3)*8;
  const unsigned kdst=lds0+LDS_K+wid*1024, vdst=lds0+LDS_V+wid*1024;
  #define DMA_K(t,slot) glds16(ksrc+(long)(t)*KVBLK*PIN,(unsigned)__builtin_amdgcn_readfirstlane(kdst+(slot)))
  #define DMA_V(t,slot) glds16(vsrc+(long)(t)*KVBLK*PIN,(unsigned)__builtin_amdgcn_readfirstlane(vdst+(slot)))
  const int vb0=(int)(lds0+LDS_V)+((lane>>4)&1)*32+(lane&3)*8+(4*hi+((lane&15)>>2))*64;
  const char*Kbase=shm+LDS_K; bf16x8 kf[8];
  const lds_cptr shm3=(lds_cptr)shm; const lds_cptr kp0=shm3+LDS_K+hi*1024+r32*16; const lds_cptr vp0=shm3+LDS_V+((lane>>4)&1)*32+(lane&3)*8+(4*hi+((lane&15)>>2))*64;
  const int NT=(q0+QB)/KVBLK;
  DMA_K(0,0);DMA_V(0,0);DMA_K(1,SLOTB);
  bf16x8 qr[4];
  #pragma unroll
  for(int d0=0;d0<4;++d0)qr[d0]=*reinterpret_cast<const bf16x8*>(&Qw[(long)r32*PIN+d0*16+hi*8]);
  float mhat=0.f,l_reg=0.f;f32x16 o[2];o[0]=f32x16{};o[1]=f32x16{};f32x16 negm=f32x16{};asm volatile("":"+v"(negm));
  const int qrel=wid*QBLK+r32;
  #define CMASK(P0,P1,t) do{int jb_=(t)-(NT-4); if(jb_>=0)cmask(P0,P1,jb_,qrel,hi);}while(0)
  bool resc=false;
  #define START(P0,P1) do{ const float rm=rowmax(P0,P1); resc=false; \
    { const float dl=rm; mhat=fadd_s(mhat,dl); \
      _Pragma("unroll") for(int r=0;r<16;++r){P0[r]=fsub_s(P0[r],dl);P1[r]=fsub_s(P1[r],dl);} \
      _Pragma("unroll") for(int r=0;r<16;++r)negm[r]=-mhat; asm volatile("":"+v"(negm)); } \
    _Pragma("unroll") for(int r=0;r<16;++r)P0[r]=__builtin_amdgcn_exp2f(P0[r]); }while(0)
  #define RESC() do{ if(resc){ asm volatile("s_waitcnt lgkmcnt(0)":::"memory"); \
      _Pragma("unroll") for(int d_=0;d_<2;++d_) _Pragma("unroll") for(int r=0;r<16;++r)o[d_][r]*=wsf[crow(r,hi)]; } }while(0)
  f32x16 pA0,pA1,pB0,pB1;
  int sl_prev=0,sl_cur=0,sl_next=SLOTB;
  #define ROT() do{sl_prev=sl_cur;sl_cur=sl_next;sl_next=(sl_next==(NSLOT-1)*SLOTB)?0:sl_next+SLOTB;}while(0)
  DMA_K(2,2*SLOTB);
  WAIT_BAR(3);
  qkt(pA0,pA1,Kbase,qr,negm,r32,hi);asm volatile("s_nop 15\n\ts_nop 7":"+v"(pA0),"+v"(pA1));CMASK(pA0,pA1,0);
  START(pA0,pA1);
  _Pragma("unroll") for(int r=0;r<16;++r)pA1[r]=__builtin_amdgcn_exp2f(pA1[r]);
  WAIT_BAR(0);
  DMA_K(3,0);DMA_V(1,SLOTB);
  ROT();
  kload8(kf,kp0+sl_cur);
  WAIT_BAR(2);
  s16x4 vlo[8],vhi[8]; u32x4 pw0,pw1,pw2,pw3;
  #define PKW(P,B) cvtpk_s(P[B],P[B+1])
  #define PAF(k) __builtin_bit_cast(bf16x8,pw##k)
  #define VFR(i) (bf16x8){vlo[i][0],vlo[i][1],vlo[i][2],vlo[i][3],vhi[i][0],vhi[i][1],vhi[i][2],vhi[i][3]}
  #define PIN(x) asm volatile("":"+v"(x))
  #define MX3(a,b,c) __builtin_fmaxf(__builtin_fmaxf((a),(b)),(c))
  #define GAPA(MF,A0,A1,A2,A3,W0,W1,PW) do{ MF; sacc+=A0; sacc+=A1; sacc+=A2; sacc+=A3; PIN(sacc); W0; W1; PIN(PW); SBAR(); }while(0)
  #define EX(v) __builtin_amdgcn_exp2f(v)
  #define GAPB(MF,X,B) do{ MF; X[B]=EX(X[B]); X[B+1]=EX(X[B+1]); X[B+2]=EX(X[B+2]); X[B+3]=EX(X[B+3]); PIN(X); SBAR(); }while(0)
  #define VRD(i) do{ vlo[i]=vtr(vp_+(((i)>>2)*4096+((i)&3)*1024)); vhi[i]=vtr(vp_+(((i)>>2)*4096+((i)&3)*1024+512)); }while(0)
  #define KRD(G,j) do{ if(G){ kload2(kf,kp0+sl_next,j); SBAR(); } }while(0)
  #define STEP(C0,C1,P0,P1,t,GK,GV,GL) do{ SBAR(); \
    const lds_cptr vp_=vp0+sl_prev; \
    VRD(0); SBAR(); float sacc=(P0[0]+P0[1]); \
    GAPA(C0=__builtin_amdgcn_mfma_f32_32x32x16_bf16(kf[0],qr[0],negm,0,0,0), P0[2],P0[3],P0[4],P0[5],     pw0[0]=PKW(P0,0), pw0[1]=PKW(P0,2), pw0); \
    VRD(4); SBAR(); GAPA(C1=__builtin_amdgcn_mfma_f32_32x32x16_bf16(kf[1],qr[0],negm,0,0,0), P0[6],P0[7],P0[8],P0[9],     pw0[2]=PKW(P0,4), pw0[3]=PKW(P0,6), pw0); \
    VRD(1); SBAR(); GAPA(C0=__builtin_amdgcn_mfma_f32_32x32x16_bf16(kf[2],qr[1],C0,0,0,0),   P0[10],P0[11],P0[12],P0[13], pw1[0]=PKW(P0,8), pw1[1]=PKW(P0,10), pw1); \
    VRD(5); SBAR(); GAPA(C1=__builtin_amdgcn_mfma_f32_32x32x16_bf16(kf[3],qr[1],C1,0,0,0),   P0[14],P0[15],P1[0],P1[1],   pw1[2]=PKW(P0,12),pw1[3]=PKW(P0,14), pw1); \
    VRD(2); SBAR(); GAPA(C0=__builtin_amdgcn_mfma_f32_32x32x16_bf16(kf[4],qr[2],C0,0,0,0),   P1[2],P1[3],P1[4],P1[5],     pw2[0]=PKW(P1,0), pw2[1]=PKW(P1,2), pw2); \
    VRD(6); SBAR(); GAPA(C1=__builtin_amdgcn_mfma_f32_32x32x16_bf16(kf[5],qr[2],C1,0,0,0),   P1[6],P1[7],P1[8],P1[9],     pw2[2]=PKW(P1,4), pw2[3]=PKW(P1,6), pw2); \
    VRD(3); SBAR(); GAPA(C0=__builtin_amdgcn_mfma_f32_32x32x16_bf16(kf[6],qr[3],C0,0,0,0),   P1[10],P1[11],P1[12],P1[13], pw3[0]=PKW(P1,8), pw3[1]=PKW(P1,10), pw3); \
    VRD(7); SBAR(); GAPA(C1=__builtin_amdgcn_mfma_f32_32x32x16_bf16(kf[7],qr[3],C1,0,0,0),   P1[14],P1[15],0.f,0.f,       pw3[2]=PKW(P1,12),pw3[3]=PKW(P1,14), pw3); \
    l_reg+=sacc; \
    if(GK){DMA_K((t)+3,sl_cur);} if(GV){DMA_V((t)+1,sl_next);} \
    CMASK(C0,C1,t); \
    { float a=MX3(C0[0],C0[1],C1[0]),b=MX3(C0[2],C0[3],C1[1]); a=MX3(a,C1[2],C1[3]); \
      _Pragma("unroll") for(int r=4;r<16;r+=4){a=MX3(a,C0[r],C0[r+1]);b=MX3(b,C0[r+2],C0[r+3]);a=MX3(a,C1[r],C1[r+1]);b=MX3(b,C1[r+2],C1[r+3]);} \
      float rm=__builtin_fmaxf(a,b); { auto rr=__builtin_amdgcn_permlane32_swap(__float_as_uint(rm),__float_as_uint(rm),false,false); rm=__builtin_fmaxf(__uint_as_float(rr[0]),__uint_as_float(rr[1])); } \
      resc=false; \
      if(__builtin_expect(__any(rm>(float)THRL),0)){ const float dl=__builtin_fmaxf(rm,0.f); mhat+=dl; \
        _Pragma("unroll") for(int r=0;r<16;++r){C0[r]-=dl;C1[r]-=dl;} \
        _Pragma("unroll") for(int r=0;r<16;++r)negm[r]=-mhat; asm volatile("":"+v"(negm)); \
        const float f=__builtin_amdgcn_exp2f(-dl); l_reg*=f; if(hi==0)wsf[r32]=f; resc=true; } } \
    SBAR(); \
    GAPB(o[0]=__builtin_amdgcn_mfma_f32_32x32x16_bf16(PAF(0),VFR(0),o[0],0,0,0), C0,0); \
    GAPB(o[1]=__builtin_amdgcn_mfma_f32_32x32x16_bf16(PAF(0),VFR(4),o[1],0,0,0), C0,4); \
    KRD(GL,0); GAPB(o[0]=__builtin_amdgcn_mfma_f32_32x32x16_bf16(PAF(1),VFR(1),o[0],0,0,0), C0,8); \
    KRD(GL,1); GAPB(o[1]=__builtin_amdgcn_mfma_f32_32x32x16_bf16(PAF(1),VFR(5),o[1],0,0,0), C0,12); \
    KRD(GL,2); GAPB(o[0]=__builtin_amdgcn_mfma_f32_32x32x16_bf16(PAF(2),VFR(2),o[0],0,0,0), C1,0); \
    KRD(GL,3); GAPB(o[1]=__builtin_amdgcn_mfma_f32_32x32x16_bf16(PAF(2),VFR(6),o[1],0,0,0), C1,4); \
    GAPB(o[0]=__builtin_amdgcn_mfma_f32_32x32x16_bf16(PAF(3),VFR(3),o[0],0,0,0), C1,8); \
    GAPB(o[1]=__builtin_amdgcn_mfma_f32_32x32x16_bf16(PAF(3),VFR(7),o[1],0,0,0), C1,12); \
    }while(0)
  int t=1;
  #undef CMASK
  #define CMASK(P0,P1,t) do{}while(0)
  for(;t+5<NT;t+=2){
    STEP(pB0,pB1,pA0,pA1,t,true,true,true);     WAIT_BAR(2); RESC(); ROT();
    STEP(pA0,pA1,pB0,pB1,t+1,true,true,true);   WAIT_BAR(2); RESC(); ROT();
  }
  #undef CMASK
  #define CMASK(P0,P1,t) do{int jb_=(t)-(NT-4); if(jb_>=0)cmask(P0,P1,jb_,qrel,hi);}while(0)
  #define ENDW(tt) do{ if((tt)+3<NT){WAIT_BAR(2);} else if((tt)+2<NT){WAIT_BAR(1);} else {WAIT_BAR(0);} }while(0)
  for(;t+1<NT;t+=2){
    STEP(pB0,pB1,pA0,pA1,t,(t+3<NT),(t+1<NT),(t+1<NT));       ENDW(t);   RESC(); ROT();
    STEP(pA0,pA1,pB0,pB1,t+1,(t+4<NT),(t+2<NT),(t+2<NT));     ENDW(t+1); RESC(); ROT();
  }
  STEP(pB0,pB1,pA0,pA1,NT-1,false,false,false); RESC();
  { float sacc=pB0[0]+pB0[1]; _Pragma("unroll") for(int r=2;r<16;++r)sacc+=pB0[r]; _Pragma("unroll") for(int r=0;r<16;++r)sacc+=pB1[r]; l_reg+=sacc;
    pw0=(u32x4){PKW(pB0,0),PKW(pB0,2),PKW(pB0,4),PKW(pB0,6)};pw1=(u32x4){PKW(pB0,8),PKW(pB0,10),PKW(pB0,12),PKW(pB0,14)};pw2=(u32x4){PKW(pB1,0),PKW(pB1,2),PKW(pB1,4),PKW(pB1,6)};pw3=(u32x4){PKW(pB1,8),PKW(pB1,10),PKW(pB1,12),PKW(pB1,14)};
    SBAR(); pv(o,vb0+sl_cur,PAF(0),PAF(1),PAF(2),PAF(3)); }
  #undef PKW
  #undef PAF
  #undef VFR
  #undef PIN
  #undef MX3
  #undef GAPA
  #undef GAPB
  #undef EX
  #undef VRD
  #undef KRD
  #undef STEP
  #undef ENDW
  {auto rr=__builtin_amdgcn_permlane32_swap(__float_as_uint(l_reg),__float_as_uint(l_reg),false,false);l_reg=__uint_as_float(rr[0])+__uint_as_float(rr[1]);}
  if(hi==0)wsf[32+r32]=l_reg;asm volatile("s_waitcnt lgkmcnt(0)":::"memory");
  float rli[16];
  #pragma unroll
  for(int r=0;r<16;++r)rli[r]=__builtin_amdgcn_rcpf(wsf[32+crow(r,hi)]);
  bf16*Ow=O+(rowbase+q0+wid*QBLK)*POUT+h*D;
  { bf16*stg=(bf16*)(shm+LDS_OST)+wid*2048;
    #pragma unroll
    for(int r=0;r<16;++r){const int orow=crow(r,hi);
      #pragma unroll
      for(int d0=0;d0<2;++d0)stg[orow*64+d0*32+r32]=__float2bfloat16(o[d0][r]*rli[r]);}
    asm volatile("s_waitcnt lgkmcnt(0)":::"memory");
    #pragma unroll
    for(int i=0;i<4;++i){const int row=i*8+(lane>>3),ch=lane&7; const u32x4 v=*(const u32x4*)(stg+row*64+ch*8); ATTN_STORE16(Ow+(long)row*POUT+ch*8,v);} }
  asm volatile("s_waitcnt lgkmcnt(0)\n\ts_barrier":::"memory");
  #undef DMA_K
  #undef DMA_V
  #undef CMASK
  #undef START
  #undef RESC
  #undef ROT
}
constexpr int ATTN_LDS_BYTES=LDS_BYTES;
struct AttnUnit { int bh; int qb; };
struct StaticOrder {
  int vcu;
  __device__ __forceinline__ explicit StaticOrder(int v):vcu(v){}
  __device__ __forceinline__ bool next(int i,AttnUnit&u)const{ if(i>=8)return false; const int s=vcu&7; u.bh=(vcu>>3)+32*(i>>2); const int ii=i&3; u.qb=(ii==0)?s:(ii==1)?15-s:(ii==2)?16+s:31-s; return true; }
};
template<int PIN,int POUT,int THRL=8> __device__ __forceinline__ void diff_attn_phase(char*lds,const bf16*PRJ,bf16*O1,bf16*O2,const StaticOrder&S){
  AttnUnit u;
  _Pragma("unroll 1") for(int i=0;S.next(i,u);++i){ const int rest=u.bh%32, h=rest>>2, wi=(rest>>1)&1, half=rest&1;
    attn_unit<THRL,PIN,POUT>(u.bh/32,0,u.qb,PRJ+(2*h+wi)*64,PRJ+1024+(2*h+wi)*64,PRJ+2048+h*128+half*64,(wi?O2:O1)+h*128+half*64,lds); }
}
#undef SBAR
#undef WAIT_BAR
}
constexpr int NWAVES = 8, NTHREADS = NWAVES * 64;
constexpr int BATCH = 2, T = 8192, D = 1024, M = BATCH * T, DFF = 2816, NPROJ = 3072;
constexpr float RMS_EPS = 1e-6f;
constexpr float QSCALE = 0.18033688011112042f;
constexpr float LAMBDA_INIT = 0.35550906759096934f;
constexpr int C_QN = 0, C_KC = 512, C_VC = 640, C_KS = 768, C_VS = 896, C_KW = 1024, C_VW = 1152, C_QS = 1280, C_KSB = 1792, C_VSB = 2304, C_GL = 2816;
constexpr int C1_Q = 0, C1_K = 1024, C1_V = 2048;

constexpr size_t MiB = 1u << 20, KiB = 1u << 10;
constexpr size_t WS_CTL = 0, CTL_ZERO_BYTES = 64 * KiB;
constexpr size_t WS_MODV = 1 * MiB;
constexpr size_t WS_CB1  = 1 * MiB + 128 * KiB;
constexpr size_t WS_KCMP = 1 * MiB + 256 * KiB;
constexpr size_t WS_VCMP = 1 * MiB + 512 * KiB;
constexpr size_t WS_CW2T = 1 * MiB + 768 * KiB;
constexpr size_t WS_CS   = 2 * MiB;
constexpr size_t WS_WQKV1 = 4 * MiB, WS_WOUT1 = 10 * MiB, WS_WG1 = 12 * MiB, WS_WU1 = WS_WG1 + 5632 * KiB, WS_WD1 = WS_WU1 + 5632 * KiB;
constexpr size_t WS_WG0 = WS_WD1 + 5632 * KiB, WS_WU0 = WS_WG0 + 5632 * KiB, WS_WD0 = WS_WU0 + 5632 * KiB;
constexpr size_t WS_XN = 45 * MiB;
constexpr size_t WS_R = 77 * MiB;
constexpr size_t WS_WIN0 = WS_R, WS_WOUT0 = WS_R + 6 * MiB, WS_CW1T = WS_R + 8 * MiB  , WS_PR = WS_R + 11 * MiB  , WS_OCAT = WS_PR + 96 * MiB;
constexpr size_t WS_G = WS_R, WS_ACT = WS_R + 88 * MiB;
constexpr size_t WS_PR1 = WS_R, WS_O1 = WS_R + 96 * MiB, WS_O2 = WS_O1 + 32 * MiB;
constexpr size_t WS_END = WS_ACT + 88 * MiB;
static_assert(WS_WD0 + 5632 * KiB == WS_XN && WS_OCAT + 32 * MiB <= WS_END && WS_O2 + 32 * MiB <= WS_END && WS_END <= 256 * MiB, "d_ws map");
constexpr int CW_BAR = 4096;

constexpr int LDS_BYTES = 163840;
constexpr int MISC_OFF = LDS_BYTES - 256;
constexpr int WAVE_LDS = 18432;
static_assert(NWAVES * WAVE_LDS <= MISC_OFF, "LDS map");
#define GAS __attribute__((address_space(1)))
#define LAS __attribute__((address_space(3)))
typedef unsigned short bf16;
typedef unsigned v4u __attribute__((ext_vector_type(4)));
typedef float f32x4 __attribute__((ext_vector_type(4)));
typedef short bf16x8 __attribute__((ext_vector_type(8)));
typedef GAS unsigned gu32;
typedef GAS unsigned long long gu64;
#define RLX_AGENT __ATOMIC_RELAXED, __HIP_MEMORY_SCOPE_AGENT
#define LDS_WAIT() asm volatile("s_waitcnt lgkmcnt(0)" ::: "memory")
#define VM_WAIT() asm volatile("s_waitcnt vmcnt(0)" ::: "memory")
__device__ __forceinline__ unsigned long long rt() { return __builtin_amdgcn_s_memrealtime(); }
__device__ __forceinline__ unsigned f2bf(float f) { unsigned u = __builtin_bit_cast(unsigned, f); return (u + 0x7fffu + ((u >> 16) & 1u)) >> 16; }
__device__ __forceinline__ unsigned pk2(float lo, float hi) { return f2bf(lo) | (f2bf(hi) << 16); }

#define XB_TMO      128
#define XB_XCNT(j)  (256  + 64 * (j))
#define XB_XSUB(j)  (1280 + 64 * (j))
#define XB_XGEN(j)  (2304 + 64 * (j))
#define XB_TOP      3328
#define XB_TOPGEN   3392
#define XCD_BAR_WORDS 3456
#define XB_SPIN_CAP (1u << 18)

__device__ __forceinline__ unsigned xb_ld(unsigned* p)              { return __hip_atomic_load(p, __ATOMIC_RELAXED, __HIP_MEMORY_SCOPE_AGENT); }
__device__ __forceinline__ unsigned xb_add(unsigned* p, unsigned v) { return __hip_atomic_fetch_add(p, v, __ATOMIC_RELAXED, __HIP_MEMORY_SCOPE_AGENT); }
__device__ __forceinline__ unsigned xb_xcc_id() { return (unsigned)__builtin_amdgcn_s_getreg((3 << 11) | 20) & 0xFu; }
#define XB_SPIN(cond, bar) do { unsigned _sp = 0; while (cond) { __builtin_amdgcn_s_sleep(1); \
    if ((++_sp & 255u) == 0u) { if (xb_ld(&(bar)[XB_TMO])) break; if (_sp > XB_SPIN_CAP) { atomicAdd(&(bar)[XB_TMO], 1u); break; } } } } while (0)

struct XcdBarrier {
    unsigned* bar; unsigned x;
    volatile LAS unsigned* st;
};

__device__ __forceinline__ XcdBarrier xcd_barrier_post(unsigned* bar, volatile LAS unsigned* st) {
    XcdBarrier b; b.bar = bar; b.x = xb_xcc_id(); b.st = st;
    if (threadIdx.x == 0) (void)xb_add(&bar[XB_XCNT(b.x)], 1u);
    return b;
}
__device__ __forceinline__ void xcd_barrier_complete(unsigned* bar, unsigned x, unsigned& nloc, unsigned& nx) {
    const unsigned G = gridDim.x * gridDim.y * gridDim.z;
    unsigned sum, cnt, mine, sp = 0u;
    for (;;) {
        sum = 0u; cnt = 0u; mine = 0u;
#pragma unroll
        for (unsigned j = 0; j < 16; ++j) { const unsigned c = xb_ld(&bar[XB_XCNT(j)]); sum += c; cnt += (c > 0u) ? 1u : 0u; mine = (j == x) ? c : mine; }
        if (sum == G) break;
        __builtin_amdgcn_s_sleep(1);
        if ((++sp & 255u) == 0u) { if (xb_ld(&bar[XB_TMO])) break; if (sp > XB_SPIN_CAP) { atomicAdd(&bar[XB_TMO], 1u); break; } }
    }
    nloc = mine > 0u ? mine : 1u; nx = cnt > 0u ? cnt : 1u;
}

__device__ __forceinline__ void xcd_barrier(const XcdBarrier& b) {
    asm volatile("s_waitcnt vmcnt(0)" ::: "memory");
    __syncthreads();
    if (threadIdx.x == 0) {
        unsigned* bar = b.bar;
        __builtin_amdgcn_s_waitcnt(0);
        unsigned nloc = b.st[0], nx = b.st[1];
        if (nloc == 0u) { xcd_barrier_complete(bar, b.x, nloc, nx); b.st[0] = nloc; b.st[1] = nx; }
        const unsigned old = xb_add(&bar[XB_XSUB(b.x)], 1u);
        const unsigned gen = old / nloc;
        if (old + 1u == (gen + 1u) * nloc) {
            __builtin_amdgcn_fence(__ATOMIC_RELEASE, "agent");
            asm volatile("s_waitcnt vmcnt(0)" ::: "memory");
            const unsigned og = xb_add(&bar[XB_TOP], 1u);
            const unsigned tg = og / nx;
            if (og + 1u == (tg + 1u) * nx) xb_add(&bar[XB_TOPGEN], 1u);
            else XB_SPIN(xb_ld(&bar[XB_TOPGEN]) == tg, bar);
            __builtin_amdgcn_fence(__ATOMIC_ACQUIRE, "agent");
            xb_add(&bar[XB_XGEN(b.x)], 1u);
            asm volatile("s_waitcnt vmcnt(0)" ::: "memory");
        } else {
            XB_SPIN(xb_ld(&bar[XB_XGEN(b.x)]) == gen, bar);
            __builtin_amdgcn_fence(__ATOMIC_ACQUIRE, "agent");
            asm volatile("s_waitcnt vmcnt(0)" ::: "memory");
        }
    }
    __syncthreads();
}
struct Ctx {
    LAS unsigned char* lds; int tid, lane, wave, vcu, G;
    const float *x, *c; const int* positions; const float *mod_w, *mod_b, *norm_mix, *norm_ffn, *w_gate, *w_up, *conv_w, *conv_b, *w_down, *hyb_w_in, *pos_k, *pos_v, *ck_w1, *ck_w2, *cv_w1, *cv_w2, *hyb_w_out,
        *diff_w_qkv, *lq1, *lk1, *lq2, *lk2, *subln, *diff_w_out, *norm_f;
    float* out; unsigned char* ws;
};
__device__ __forceinline__ void fill_inputs(Ctx& C) {
    typedef const char __attribute__((address_space(4)))* kptr_t;
    kptr_t kp = (kptr_t)__builtin_amdgcn_kernarg_segment_ptr();
    asm volatile("" : "+s"(kp));
#define KLD(T, i) (*(T const __attribute__((address_space(4)))*)(kp + 8 * (i)))
    C.x = KLD(const float*, 0); C.c = KLD(const float*, 1); C.positions = KLD(const int*, 2); C.mod_w = KLD(const float*, 3); C.mod_b = KLD(const float*, 4);
    C.norm_mix = KLD(const float*, 5); C.norm_ffn = KLD(const float*, 6); C.w_gate = KLD(const float*, 7); C.w_up = KLD(const float*, 8); C.conv_w = KLD(const float*, 9);
    C.conv_b = KLD(const float*, 10); C.w_down = KLD(const float*, 11); C.hyb_w_in = KLD(const float*, 12); C.pos_k = KLD(const float*, 13); C.pos_v = KLD(const float*, 14);
    C.ck_w1 = KLD(const float*, 15); C.ck_w2 = KLD(const float*, 16); C.cv_w1 = KLD(const float*, 17); C.cv_w2 = KLD(const float*, 18); C.hyb_w_out = KLD(const float*, 19);
    C.diff_w_qkv = KLD(const float*, 20); C.lq1 = KLD(const float*, 21); C.lk1 = KLD(const float*, 22); C.lq2 = KLD(const float*, 23); C.lk2 = KLD(const float*, 24);
    C.subln = KLD(const float*, 25); C.diff_w_out = KLD(const float*, 26); C.norm_f = KLD(const float*, 27);
    C.out = KLD(float*, 28); C.ws = KLD(unsigned char*, 29);
#undef KLD
}
__device__ __forceinline__ float wave_sum(float v) {
#pragma unroll
    for (int o = 1; o < 64; o <<= 1) v += __shfl_xor(v, o);
    return v;
}
__device__ __forceinline__ float wave_max(float v) {
#pragma unroll
    for (int o = 1; o < 64; o <<= 1) v = fmaxf(v, __shfl_xor(v, o));
    return v;
}
__device__ __forceinline__ float bf2f(bf16 h) { return __uint_as_float((unsigned)h << 16); }
__device__ __forceinline__ float dot2(unsigned k, unsigned q, float acc) { typedef __bf16 bf16x2_t __attribute__((ext_vector_type(2))); return __builtin_amdgcn_fdot2_f32_bf16(__builtin_bit_cast(bf16x2_t, k), __builtin_bit_cast(bf16x2_t, q), acc, false); }
#define CFENCE() asm volatile("" ::: "memory")

__device__ __forceinline__ void p0_transpose_item(const float* W, int K, int N, int c0, int w, bf16* WT, int row_off, LAS float* scr, int item, int lane) {
    const int nblk = (w + 31) / 32, kb = item / nblk, nb = item % nblk, k0 = 64 * kb, n0 = 32 * nb;
    const bool okc = (n0 + (lane & 31)) < w;
#pragma unroll 8
    for (int i = 0; i < 32; ++i) { const int kk = 2 * i + (lane >> 5); scr[kk * 33 + (lane & 31)] = okc ? W[(size_t)(k0 + kk) * N + c0 + n0 + (lane & 31)] : 0.f; }
    LDS_WAIT(); CFENCE();
    const int c = lane & 7;
#pragma unroll
    for (int j = 0; j < 4; ++j) { const int n = (lane >> 3) + 8 * j; const LAS float* s = scr + (8 * c) * 33 + n;
        v4u o; o.x = pk2(s[0 * 33], s[1 * 33]); o.y = pk2(s[2 * 33], s[3 * 33]); o.z = pk2(s[4 * 33], s[5 * 33]); o.w = pk2(s[6 * 33], s[7 * 33]);
        if (n0 + n < w) *(GAS v4u*)(WT + (size_t)(row_off + n0 + n) * K + k0 + 8 * c) = o; }
    LDS_WAIT(); CFENCE();
}
constexpr int tj_items(int K, int w) { return (K / 64) * ((w + 31) / 32); }
__device__ __forceinline__ void p0_prologue(const Ctx& C) {
    unsigned char* ws = C.ws;
    {
        LAS float* cond = (LAS float*)C.lds;
        LAS float* part = (LAS float*)(C.lds + 8192);
        LAS float* posl = (LAS float*)(C.lds + 16384);
        for (int i = C.tid; i < 2048; i += NTHREADS) { const float v = C.c[i]; cond[i] = v / (1.f + __expf(-v)); }
        __syncthreads();
        for (int tk = blockIdx.x; tk < 392; tk += C.G) {
            float acc = 0.f;
            if (tk < 384) {
                const int layer = tk / 192, cg = tk % 192, col = 32 * cg + (C.lane & 31), bb = C.lane >> 5;
                const float* wp = C.mod_w + (size_t)layer * D * 6144 + (size_t)(128 * C.wave) * 6144 + col; const LAS float* cp = cond + bb * 1024 + 128 * C.wave;
#pragma unroll 16
                for (int k = 0; k < 128; ++k) acc += cp[k] * wp[(size_t)k * 6144];
            } else {
                const int which = (tk - 384) >> 2, n = 64 * ((tk - 384) & 3) + C.lane; const float* pe = which ? C.pos_v : C.pos_k; const float* w1 = which ? C.cv_w1 : C.ck_w1;
                for (int i = C.tid; i < 2048; i += NTHREADS) posl[i] = pe[i];
                __syncthreads();
                const float* wp = w1 + (size_t)(256 * C.wave) * 256 + n; const LAS float* pp = posl + 256 * C.wave;
#pragma unroll 16
                for (int k = 0; k < 256; ++k) acc += pp[k] * wp[(size_t)k * 256];
            }
            part[C.wave * 64 + C.lane] = acc;
            __syncthreads();
            if (C.wave == 0) {
                float s = 0.f;
#pragma unroll
                for (int w = 0; w < 8; ++w) s += part[w * 64 + C.lane];
                if (tk < 384) { const int layer = tk / 192, cg = tk % 192, col = 32 * cg + (C.lane & 31), bb = C.lane >> 5;
                    ((float*)(ws + WS_MODV))[(size_t)(layer * 2 + bb) * 6144 + col] = s + C.mod_b[layer * 6144 + col]; }
                else { const int which = (tk - 384) >> 2, n = 64 * ((tk - 384) & 3) + C.lane; ((float*)(ws + WS_CB1))[which * 256 + n] = s; }
            }
            __syncthreads();
        }
    }
    LAS float* scr = (LAS float*)(C.lds + C.wave * 16384);
    const int gw = C.vcu * NWAVES + C.wave, NGW = C.G * NWAVES;
    constexpr int NITEMS = tj_items(D, 1280) + tj_items(D, 1536) + tj_items(D, 24) + tj_items(D, D) + 2 * tj_items(D, DFF) + tj_items(DFF, D) + tj_items(D, 3072) + tj_items(D, D) + 2 * tj_items(D, DFF) + tj_items(DFF, D)
        + 2 * tj_items(2048, 256) + 2 * tj_items(256, 64);
    __syncthreads();
    for (int it = gw; it < NITEMS; it += NGW) {
        int r = it;
#define TJ(Wp, K_, N_, c0_, w_, WT_, r0_) { constexpr int cnt_ = tj_items(K_, w_); if (r < cnt_) { p0_transpose_item(Wp, K_, N_, c0_, w_, (bf16*)(WT_), r0_, scr, r, C.lane); continue; } r -= cnt_; }
        TJ(C.hyb_w_in, D, 2840, 0, 1280, ws + WS_WIN0, 0)
        TJ(C.hyb_w_in, D, 2840, 1304, 1536, ws + WS_WIN0, 1280)
        TJ(C.hyb_w_in, D, 2840, 1280, 24, ws + WS_WIN0, 2816)
        TJ(C.hyb_w_out, D, D, 0, D, ws + WS_WOUT0, 0)
        TJ(C.w_gate, D, DFF, 0, DFF, ws + WS_WG0, 0)
        TJ(C.w_up, D, DFF, 0, DFF, ws + WS_WU0, 0)
        TJ(C.w_down, DFF, D, 0, D, ws + WS_WD0, 0)
        TJ(C.diff_w_qkv, D, 3072, 0, 3072, ws + WS_WQKV1, 0)
        TJ(C.diff_w_out, D, D, 0, D, ws + WS_WOUT1, 0)
        TJ(C.w_gate + (size_t)D * DFF, D, DFF, 0, DFF, ws + WS_WG1, 0)
        TJ(C.w_up + (size_t)D * DFF, D, DFF, 0, DFF, ws + WS_WU1, 0)
        TJ(C.w_down + (size_t)D * DFF, DFF, D, 0, D, ws + WS_WD1, 0)
        TJ(C.ck_w1, 2048, 256, 0, 256, ws + WS_CW1T, 0)
        TJ(C.cv_w1, 2048, 256, 0, 256, ws + WS_CW1T + 1 * MiB, 0)
        TJ(C.ck_w2, 256, 64, 0, 64, ws + WS_CW2T, 0)
        TJ(C.cv_w2, 256, 64, 0, 64, ws + WS_CW2T + 32 * KiB, 0)
#undef TJ
    }
    { GAS v4u* z = (GAS v4u*)(ws + WS_WIN0 + (size_t)2840 * D * 2); const int n16 = (3072 - 2840) * D * 2 / 16;
      for (int i = C.vcu * NTHREADS + C.tid; i < n16; i += C.G * NTHREADS) z[i] = (v4u){0u, 0u, 0u, 0u}; }
    { float* cs = (float*)(ws + WS_CS);
      for (int e = C.vcu * NTHREADS + C.tid; e < M * 8; e += C.G * NTHREADS) {
          const int m = e >> 3, i = e & 7;
          const double inv = (i == 0) ? 1.0 : (i == 1) ? 0.19392274474868576 : (i == 2) ? 0.03760603093086393 : (i == 3) ? 0.007292664737217109 : (i == 4) ? 0.001414213562373095 : (i == 5) ? 0.0002742481756762073
                              : (i == 6) ? 5.318295896944988e-05 : 1.031338537721246e-05;
          const double rev = (double)C.positions[m] * inv * 0.15915494309189535; const float fr = (float)(rev - floor(rev));
          cs[(size_t)m * 16 + i] = __builtin_amdgcn_cosf(fr); cs[(size_t)m * 16 + 8 + i] = __builtin_amdgcn_sinf(fr); } }
}

__device__ __forceinline__ void norm_mod_rows(const Ctx& C, const float* X, const float* gain, const float* shv, const float* scv, bf16* XN) {
    const int gw = C.vcu * NWAVES + C.wave, NGW = C.G * NWAVES;
    for (int m = gw; m < M; m += NGW) {
        const int b = m >> 13; const GAS f32x4* xr = (const GAS f32x4*)(X + (size_t)m * D) + C.lane;
        f32x4 v[4]; float s = 0.f;
#pragma unroll
        for (int j = 0; j < 4; ++j) { v[j] = xr[64 * j]; s += (v[j].x * v[j].x + v[j].y * v[j].y) + (v[j].z * v[j].z + v[j].w * v[j].w); }
        const float rs = 1.0f / sqrtf(wave_sum(s) * (1.f / D) + RMS_EPS);
        GAS unsigned long long* o8 = (GAS unsigned long long*)(XN + (size_t)m * D) + C.lane;
#pragma unroll
        for (int j = 0; j < 4; ++j) { const int col = 4 * (64 * j + C.lane);
            const f32x4 g4 = *(const GAS f32x4*)(gain + col), sh4 = *(const GAS f32x4*)(shv + (size_t)b * 6144 + col), sc4 = *(const GAS f32x4*)(scv + (size_t)b * 6144 + col);
            const f32x4 h = v[j] * rs * g4 * (sc4 + 1.0f) + sh4;
            o8[64 * j] = (unsigned long long)pk2(h.x, h.y) | ((unsigned long long)pk2(h.z, h.w) << 32); }
    }
}
__device__ __forceinline__ void final_norm_rows(const Ctx& C, float* X, const float* gain) {
    const int gw = C.vcu * NWAVES + C.wave, NGW = C.G * NWAVES;
    for (int m = gw; m < M; m += NGW) {
        GAS f32x4* xr = (GAS f32x4*)(X + (size_t)m * D) + C.lane;
        f32x4 v[4]; float s = 0.f;
#pragma unroll
        for (int j = 0; j < 4; ++j) { v[j] = xr[64 * j]; s += (v[j].x * v[j].x + v[j].y * v[j].y) + (v[j].z * v[j].z + v[j].w * v[j].w); }
        const float rs = 1.0f / sqrtf(wave_sum(s) * (1.f / D) + RMS_EPS);
#pragma unroll
        for (int j = 0; j < 4; ++j) { const f32x4 g4 = *(const GAS f32x4*)(gain + 4 * (64 * j + C.lane)); xr[64 * j] = v[j] * rs * g4; }
    }
}
__device__ __forceinline__ void diff_combine_rows(const Ctx& C, const bf16* O1, const bf16* O2, bf16* OC) {
    const int gw = C.vcu * NWAVES + C.wave, NGW = C.G * NWAVES;
    const float lam = __expf(wave_sum(C.lq1[C.lane] * C.lk1[C.lane])) - __expf(wave_sum(C.lq2[C.lane] * C.lk2[C.lane])) + LAMBDA_INIT;
    float sl[16];
#pragma unroll
    for (int i = 0; i < 16; ++i) sl[i] = C.subln[(16 * C.lane + i) & 127] * (1.0f - LAMBDA_INIT);
    for (int m = gw; m < M; m += NGW) {
        const GAS v4u* p1 = (const GAS v4u*)(O1 + (size_t)m * D + 16 * C.lane); const GAS v4u* p2 = (const GAS v4u*)(O2 + (size_t)m * D + 16 * C.lane);
        float o[16]; float ss = 0.f;
#pragma unroll
        for (int h = 0; h < 2; ++h) { const v4u a = p1[h], bq = p2[h];
#pragma unroll
            for (int e = 0; e < 4; ++e) { const unsigned ua = e == 0 ? a.x : e == 1 ? a.y : e == 2 ? a.z : a.w, ub = e == 0 ? bq.x : e == 1 ? bq.y : e == 2 ? bq.z : bq.w;
                o[8 * h + 2 * e] = __uint_as_float(ua << 16) - lam * __uint_as_float(ub << 16); o[8 * h + 2 * e + 1] = __uint_as_float(ua & 0xffff0000u) - lam * __uint_as_float(ub & 0xffff0000u); } }
#pragma unroll
        for (int i = 0; i < 16; ++i) ss += o[i] * o[i];
        ss += __shfl_xor(ss, 1); ss += __shfl_xor(ss, 2); ss += __shfl_xor(ss, 4);
        const float rs = 1.0f / sqrtf(ss * (1.f / 128.f) + RMS_EPS);
        v4u w0, w1;
        w0.x = pk2(o[0] * rs * sl[0], o[1] * rs * sl[1]); w0.y = pk2(o[2] * rs * sl[2], o[3] * rs * sl[3]); w0.z = pk2(o[4] * rs * sl[4], o[5] * rs * sl[5]); w0.w = pk2(o[6] * rs * sl[6], o[7] * rs * sl[7]);
        w1.x = pk2(o[8] * rs * sl[8], o[9] * rs * sl[9]); w1.y = pk2(o[10] * rs * sl[10], o[11] * rs * sl[11]); w1.z = pk2(o[12] * rs * sl[12], o[13] * rs * sl[13]); w1.w = pk2(o[14] * rs * sl[14], o[15] * rs * sl[15]);
        GAS v4u* q = (GAS v4u*)(OC + (size_t)m * D + 16 * C.lane); q[0] = w0; q[1] = w1;
    }
}

__device__ __forceinline__ void compress_unit(const Ctx& C, int unit) {
    typedef float f32x16 __attribute__((ext_vector_type(16)));
    const int which = unit >> 6, b = (unit >> 5) & 1, g = (unit >> 4) & 1, cb = unit & 15;
    const int lane = C.lane, n = lane & 31, hi = lane >> 5, w = C.wave;
    const bf16* PR = (const bf16*)(C.ws + WS_PR); const bf16* W1T = (const bf16*)(C.ws + WS_CW1T + (size_t)which * MiB); const bf16* W2T = (const bf16*)(C.ws + WS_CW2T + (size_t)which * 32 * KiB);
    const float* cb1 = (const float*)(C.ws + WS_CB1) + which * 256;
    LAS bf16* H = (LAS bf16*)C.lds;
    int c = 32 * cb + n; if (c > 510) c = 510;
    const bf16* ap = PR + ((size_t)(b * T + 16 * c)) * NPROJ + (which ? C_VC : C_KC) + g * 64 + 8 * hi;
    const bf16* bp = W1T + (size_t)(32 * w + n) * 2048 + 8 * hi;
    f32x16 acc = {};
#pragma unroll 4
    for (int ks = 0; ks < 128; ++ks) {
        const bf16x8 a = *(const GAS bf16x8*)(ap + (size_t)(ks >> 2) * NPROJ + (ks & 3) * 16);
        const bf16x8 bb = *(const GAS bf16x8*)(bp + ks * 16);
        acc = __builtin_amdgcn_mfma_f32_32x32x16_bf16(a, bb, acc, 0, 0, 0);
    }
    { const float bias = cb1[32 * w + n];
#pragma unroll
      for (int r = 0; r < 16; ++r) { const int row = (r & 3) + 8 * (r >> 2) + 4 * hi; float v = acc[r] + bias; v = v / (1.f + __expf(-v)); H[row * 256 + 32 * w + n] = (bf16)f2bf(v); } }
    __syncthreads();
    if (w < 2) {
        f32x16 a2 = {};
#pragma unroll
        for (int ks = 0; ks < 16; ++ks) {
            const bf16x8 a = *(const LAS bf16x8*)(H + n * 256 + ks * 16 + 8 * hi);
            const bf16x8 bb = *(const GAS bf16x8*)(W2T + (size_t)(32 * w + n) * 256 + ks * 16 + 8 * hi);
            a2 = __builtin_amdgcn_mfma_f32_32x32x16_bf16(a, bb, a2, 0, 0, 0);
        }
        bf16* OUT = (bf16*)(C.ws + (which ? WS_VCMP : WS_KCMP)) + (size_t)((b * 2 + g) * 512) * 64;
        const float* cs = (const float*)(C.ws + WS_CS);
#pragma unroll
        for (int r = 0; r < 16; ++r) {
            const int row = (r & 3) + 8 * (r >> 2) + 4 * hi, cc = 32 * cb + row;
            float v = a2[r];
            if (which == 0 && w == 0) {
                const float pv = __shfl_xor(v, 8);
                if (n < 16) { const int cq = cc > 510 ? 510 : cc; const float* t = cs + ((size_t)(b * T + 16 * cq + 31)) * 16; const float co = t[n & 7], si = t[8 + (n & 7)];
                    v = (n < 8) ? (v * co - pv * si) : (v * co + pv * si); }
            }
            if (cc > 510) v = 0.f;
            OUT[(size_t)cc * 64 + 32 * w + n] = (bf16)f2bf(v);
        }
    }
    __syncthreads();
}

__device__ __forceinline__ void score4(const unsigned (&q)[4][32], const bf16* kp, float& s0, float& s1, float& s2, float& s3) {
    s0 = s1 = s2 = s3 = 0.f;
#pragma unroll
    for (int cch = 0; cch < 8; ++cch) { const v4u kv = ((const GAS v4u*)kp)[cch];
#pragma unroll
        for (int e = 0; e < 4; ++e) { const unsigned kw = e == 0 ? kv.x : e == 1 ? kv.y : e == 2 ? kv.z : kv.w;
            s0 = dot2(kw, q[0][4 * cch + e], s0); s1 = dot2(kw, q[1][4 * cch + e], s1); s2 = dot2(kw, q[2][4 * cch + e], s2); s3 = dot2(kw, q[3][4 * cch + e], s3); } }
}
__device__ __forceinline__ void nsa_query(const Ctx& C, int b, int t, int g, LAS unsigned char* wl) {
    const int lane = C.lane; const bf16* PR = (const bf16*)(C.ws + WS_PR); const size_t row = (size_t)b * T + t;
    LAS f32x4* sc = (LAS f32x4*)wl; LAS unsigned* qd = (LAS unsigned*)(wl + 16384);
    { const GAS unsigned* qsrc = (const GAS unsigned*)(PR + row * NPROJ + C_QN + g * 256); qd[lane] = qsrc[lane]; qd[lane + 64] = qsrc[lane + 64]; }
    CFENCE();
    unsigned q[4][32];
#pragma unroll
    for (int h = 0; h < 4; ++h)
#pragma unroll
        for (int i = 0; i < 8; ++i) { const v4u tq = ((const LAS v4u*)qd)[h * 8 + i]; q[h][4 * i] = tq.x; q[h][4 * i + 1] = tq.y; q[h][4 * i + 2] = tq.z; q[h][4 * i + 3] = tq.w; }
    float gate; { float glv = 0.f; if (lane < 12) glv = bf2f(PR[row * NPROJ + C_GL + g * 12 + lane]); gate = 1.f / (1.f + __expf(-glv)); }
    float oacc[4] = {0.f, 0.f, 0.f, 0.f};
    const int cur = t >> 6;
    const int nvalid = (t >= 31) ? (((t - 31) >> 4) + 1) : 0;
    float imp0 = 0.f, imp1 = 0.f;
    if (nvalid > 0) {
        const bf16* KC = (const bf16*)(C.ws + WS_KCMP) + (size_t)((b * 2 + g) * 512) * 64; const bf16* VC = (const bf16*)(C.ws + WS_VCMP) + (size_t)((b * 2 + g) * 512) * 64;
        float m0 = -1e30f, m1 = -1e30f, m2 = -1e30f, m3 = -1e30f;
        for (int cc = lane; cc < nvalid; cc += 64) { float s0, s1, s2, s3; score4(q, KC + (size_t)cc * 64, s0, s1, s2, s3); sc[cc] = (f32x4){s0, s1, s2, s3}; m0 = fmaxf(m0, s0); m1 = fmaxf(m1, s1); m2 = fmaxf(m2, s2); m3 = fmaxf(m3, s3); }
        m0 = wave_max(m0); m1 = wave_max(m1); m2 = wave_max(m2); m3 = wave_max(m3);
        float l0 = 0.f, l1 = 0.f, l2 = 0.f, l3 = 0.f;
        for (int cc = lane; cc < nvalid; cc += 64) { f32x4 s = sc[cc]; s.x = __builtin_amdgcn_exp2f(s.x - m0); s.y = __builtin_amdgcn_exp2f(s.y - m1); s.z = __builtin_amdgcn_exp2f(s.z - m2); s.w = __builtin_amdgcn_exp2f(s.w - m3); sc[cc] = s; l0 += s.x; l1 += s.y; l2 += s.z; l3 += s.w; }
        const float i0 = 1.f / wave_sum(l0), i1 = 1.f / wave_sum(l1), i2 = 1.f / wave_sum(l2), i3 = 1.f / wave_sum(l3);
        CFENCE();
#pragma unroll
        for (int half = 0; half < 2; ++half) { const int nb = lane + 64 * half; float a = 0.f;
            for (int cc = 4 * nb - 1; cc <= 4 * nb + 3; ++cc) if (cc >= 0 && cc < nvalid) { const f32x4 p = sc[cc]; a += p.x * i0 + p.y * i1 + p.z * i2 + p.w * i3; }
            if (half == 0) imp0 = a; else imp1 = a; }
        float a0 = 0.f, a1 = 0.f, a2 = 0.f, a3 = 0.f;
        for (int cc = 0; cc < nvalid; ++cc) { const f32x4 p = sc[cc]; const float v = bf2f(VC[(size_t)cc * 64 + lane]); a0 += p.x * v; a1 += p.y * v; a2 += p.z * v; a3 += p.w * v; }
        oacc[0] += __shfl(gate, 0) * a0 * i0; oacc[1] += __shfl(gate, 3) * a1 * i1; oacc[2] += __shfl(gate, 6) * a2 * i2; oacc[3] += __shfl(gate, 9) * a3 * i3;
        CFENCE();
    }
    int sel[16];
    {
        float v0, v1;
        { const int nb = lane; const bool forced = (nb == 0) || (nb == cur) || (nb == cur - 1); v0 = forced ? 1e9f : (nb <= cur ? imp0 : -1e9f); }
        { const int nb = lane + 64; const bool forced = (nb == cur) || (nb == cur - 1); v1 = forced ? 1e9f : (nb <= cur ? imp1 : -1e9f); }
#pragma unroll
        for (int i = 0; i < 16; ++i) {
            float bv; int bi; if (v0 >= v1) { bv = v0; bi = lane; } else { bv = v1; bi = lane + 64; }
#pragma unroll
            for (int off = 32; off >= 1; off >>= 1) { const float ov = __shfl_xor(bv, off); const int oi = __shfl_xor(bi, off); if (ov > bv || (ov == bv && oi < bi)) { bv = ov; bi = oi; } }
            sel[i] = bi; if (bi == lane) v0 = -3e38f; if (bi == lane + 64) v1 = -3e38f;
        }
    }
    {
        float m0 = -1e30f, m1 = -1e30f, m2 = -1e30f, m3 = -1e30f;
#pragma unroll
        for (int i = 0; i < 16; ++i) {
            const int blk = __builtin_amdgcn_readfirstlane(sel[i]);
            if (blk <= cur) { const int tok = blk * 64 + lane; float s0, s1, s2, s3; score4(q, PR + ((size_t)b * T + tok) * NPROJ + C_KS + g * 64, s0, s1, s2, s3);
                if (tok <= t) { m0 = fmaxf(m0, s0); m1 = fmaxf(m1, s1); m2 = fmaxf(m2, s2); m3 = fmaxf(m3, s3); } else { s0 = s1 = s2 = s3 = -1e30f; }
                sc[i * 64 + lane] = (f32x4){s0, s1, s2, s3}; }
        }
        m0 = wave_max(m0); m1 = wave_max(m1); m2 = wave_max(m2); m3 = wave_max(m3);
        float l0 = 0.f, l1 = 0.f, l2 = 0.f, l3 = 0.f;
#pragma unroll
        for (int i = 0; i < 16; ++i) {
            const int blk = __builtin_amdgcn_readfirstlane(sel[i]);
            if (blk <= cur) { f32x4 s = sc[i * 64 + lane]; const bool ok = (blk * 64 + lane) <= t;
                s.x = ok ? __builtin_amdgcn_exp2f(s.x - m0) : 0.f; s.y = ok ? __builtin_amdgcn_exp2f(s.y - m1) : 0.f; s.z = ok ? __builtin_amdgcn_exp2f(s.z - m2) : 0.f; s.w = ok ? __builtin_amdgcn_exp2f(s.w - m3) : 0.f;
                sc[i * 64 + lane] = s; l0 += s.x; l1 += s.y; l2 += s.z; l3 += s.w; }
        }
        const float i0 = 1.f / wave_sum(l0), i1 = 1.f / wave_sum(l1), i2 = 1.f / wave_sum(l2), i3 = 1.f / wave_sum(l3);
        CFENCE();
        float a0 = 0.f, a1 = 0.f, a2 = 0.f, a3 = 0.f;
#pragma unroll
        for (int i = 0; i < 16; ++i) {
            const int blk = __builtin_amdgcn_readfirstlane(sel[i]);
            if (blk <= cur) { int nj = t - blk * 64 + 1; if (nj > 64) nj = 64; const bf16* vp = PR + ((size_t)b * T + blk * 64) * NPROJ + C_VS + g * 64 + lane;
                for (int j = 0; j < nj; ++j) { const f32x4 p = sc[i * 64 + j]; const float v = bf2f(vp[(size_t)j * NPROJ]); a0 += p.x * v; a1 += p.y * v; a2 += p.z * v; a3 += p.w * v; } }
        }
        oacc[0] += __shfl(gate, 1) * a0 * i0; oacc[1] += __shfl(gate, 4) * a1 * i1; oacc[2] += __shfl(gate, 7) * a2 * i2; oacc[3] += __shfl(gate, 10) * a3 * i3;
        CFENCE();
    }
    {
        float m0 = -1e30f, m1 = -1e30f, m2 = -1e30f, m3 = -1e30f;
#pragma unroll
        for (int i = 0; i < 8; ++i) { const int j = lane + 64 * i, kp = t - 511 + j;
            float s0 = -1e30f, s1 = -1e30f, s2 = -1e30f, s3 = -1e30f;
            if (kp >= 0) { score4(q, PR + ((size_t)b * T + kp) * NPROJ + C_KW + g * 64, s0, s1, s2, s3); m0 = fmaxf(m0, s0); m1 = fmaxf(m1, s1); m2 = fmaxf(m2, s2); m3 = fmaxf(m3, s3); }
            sc[j] = (f32x4){s0, s1, s2, s3}; }
        m0 = wave_max(m0); m1 = wave_max(m1); m2 = wave_max(m2); m3 = wave_max(m3);
        float l0 = 0.f, l1 = 0.f, l2 = 0.f, l3 = 0.f;
#pragma unroll
        for (int i = 0; i < 8; ++i) { const int j = lane + 64 * i; const bool ok = (t - 511 + j) >= 0; f32x4 s = sc[j];
            s.x = ok ? __builtin_amdgcn_exp2f(s.x - m0) : 0.f; s.y = ok ? __builtin_amdgcn_exp2f(s.y - m1) : 0.f; s.z = ok ? __builtin_amdgcn_exp2f(s.z - m2) : 0.f; s.w = ok ? __builtin_amdgcn_exp2f(s.w - m3) : 0.f;
            sc[j] = s; l0 += s.x; l1 += s.y; l2 += s.z; l3 += s.w; }
        const float i0 = 1.f / wave_sum(l0), i1 = 1.f / wave_sum(l1), i2 = 1.f / wave_sum(l2), i3 = 1.f / wave_sum(l3);
        CFENCE();
        float a0 = 0.f, a1 = 0.f, a2 = 0.f, a3 = 0.f;
        const int j0 = (t >= 511) ? 0 : (511 - t); const bf16* vp = PR + ((size_t)b * T + (t - 511)) * NPROJ + C_VW + g * 64 + lane;
        for (int j = j0; j < 512; ++j) { const f32x4 p = sc[j]; const float v = bf2f(vp[(ptrdiff_t)j * NPROJ]); a0 += p.x * v; a1 += p.y * v; a2 += p.z * v; a3 += p.w * v; }
        oacc[0] += __shfl(gate, 2) * a0 * i0; oacc[1] += __shfl(gate, 5) * a1 * i1; oacc[2] += __shfl(gate, 8) * a2 * i2; oacc[3] += __shfl(gate, 11) * a3 * i3;
        CFENCE();
    }
    bf16* OC = (bf16*)(C.ws + WS_OCAT) + row * D + g * 256 + lane;
#pragma unroll
    for (int h = 0; h < 4; ++h) OC[h * 64] = (bf16)f2bf(oacc[h]);
}
__device__ __forceinline__ void sb_query(const Ctx& C, int b, int t, int h, LAS unsigned char* wl) {
    const int lane = C.lane; const bf16* PR = (const bf16*)(C.ws + WS_PR); const size_t row = (size_t)b * T + t;
    LAS float* ab = (LAS float*)wl; LAS unsigned* qd = (LAS unsigned*)(wl + 16384);
    { const GAS unsigned* qsrc = (const GAS unsigned*)(PR + row * NPROJ + C_QS + h * 64); if (lane < 32) qd[lane] = qsrc[lane]; }
    CFENCE();
    unsigned q[32];
#pragma unroll
    for (int i = 0; i < 8; ++i) { const v4u tq = ((const LAS v4u*)qd)[i]; q[4 * i] = tq.x; q[4 * i + 1] = tq.y; q[4 * i + 2] = tq.z; q[4 * i + 3] = tq.w; }
    float o = 0.f, carry = 0.f;
    for (int base = t - 1; base >= 0; base -= 64) {
        const int key = base - lane; const bool valid = key >= 0; const int kc = valid ? key : 0;
        const bf16* kp = PR + ((size_t)b * T + kc) * NPROJ + C_KSB + h * 64;
        float z = 0.f;
#pragma unroll
        for (int cch = 0; cch < 8; ++cch) { const v4u kv = ((const GAS v4u*)kp)[cch]; z = dot2(kv.x, q[4 * cch], z); z = dot2(kv.y, q[4 * cch + 1], z); z = dot2(kv.z, q[4 * cch + 2], z); z = dot2(kv.w, q[4 * cch + 3], z); }
        const float L = __builtin_amdgcn_logf(1.f + __builtin_amdgcn_exp2f(-fabsf(z)));
        const float lk = valid ? -(fmaxf(z, 0.f) + L) : 0.f;
        const float ls = fminf(z, 0.f) - L;
        float inc = lk;
#pragma unroll
        for (int d = 1; d < 64; d <<= 1) { const float tv = __shfl_up(inc, d); if (lane >= d) inc += tv; }
        const float a = valid ? __builtin_amdgcn_exp2f(ls + carry + (inc - lk)) : 0.f;
        CFENCE(); ab[lane] = a; CFENCE();
        const int nv = (base + 1 < 64) ? (base + 1) : 64; const bf16* vp = PR + ((size_t)b * T + base) * NPROJ + C_VSB + h * 64 + lane;
        for (int j = 0; j < nv; ++j) o += ab[j] * bf2f(vp[-(ptrdiff_t)j * NPROJ]);
        carry += __shfl(inc, 63);
        if (carry < -60.f) break;
    }
    ((bf16*)(C.ws + WS_OCAT))[row * D + 512 + h * 64 + lane] = (bf16)f2bf(o);
}
__device__ __forceinline__ void hybrid_attention_phase(const Ctx& C) {
    LAS unsigned char* wl = C.lds + C.wave * WAVE_LDS;
    const int gw = C.vcu * NWAVES + C.wave, NGW = C.G * NWAVES;
    for (int tk = gw; tk < BATCH * 2 * T; tk += NGW) { const int t = tk & (T - 1), g = (tk >> 13) & 1, b = tk >> 14; nsa_query(C, b, t, g, wl); }
    for (int tk = gw; tk < BATCH * 8 * T; tk += NGW) { const int t = tk & (T - 1), h = (tk >> 13) & 7, b = tk >> 16; sb_query(C, b, t, h, wl); }
}
namespace hyb {
using attn_body::bf16x8; using attn_body::s16x4; using attn_body::f32x16; using attn_body::u32x4; using attn_body::crow; using attn_body::glds16; using attn_body::cvtpk_s;
typedef attn_body::bf16 hb;
constexpr int SLOT_BYTES = 16384, H_SLOT0 = 0, H_WSF = 32768, H_OST = 34816  , H_IMP = 100352, H_SELM = 134144, H_WUN = 135168, H_FLAG = 135296, H_END = 135360;
constexpr int IMP_LD = 132;
static_assert(H_IMP + 8 * 8 * IMP_LD * 4 <= H_SELM && H_END <= MISC_OFF, "hyb LDS map");
constexpr float NEGF = -1e30f;
#define HWAIT_BAR() asm volatile("s_waitcnt vmcnt(0) lgkmcnt(0)\n\ts_barrier" ::: "memory")
__device__ __forceinline__ void dma_k(const hb* base, int pitch, unsigned lds_k, int lane, int wid) { glds16(base + (long)lane * pitch + wid * 8, (unsigned)__builtin_amdgcn_readfirstlane(lds_k + wid * 1024)); }
__device__ __forceinline__ void dma_v(const hb* base, int pitch, unsigned lds_v, int lane, int wid) { glds16(base + (long)(16 * (wid & 3) + (lane >> 2)) * pitch + (wid >> 2) * 32 + (lane & 3) * 8, (unsigned)__builtin_amdgcn_readfirstlane(lds_v + wid * 1024)); }
__device__ __forceinline__ void qkt0(f32x16& p0, f32x16& p1, const char* Kslot, const bf16x8 (&qr)[4], int r32, int hi) {
    const char* kb = Kslot + hi * 1024 + r32 * 16; const f32x16 z = {};
#pragma unroll
    for (int d0 = 0; d0 < 4; ++d0) {
        const bf16x8 b0 = *reinterpret_cast<const bf16x8*>(kb + d0 * 2048), b1 = *reinterpret_cast<const bf16x8*>(kb + d0 * 2048 + 512);
        if (d0 == 0) { p0 = __builtin_amdgcn_mfma_f32_32x32x16_bf16(b0, qr[0], z, 0, 0, 0); p1 = __builtin_amdgcn_mfma_f32_32x32x16_bf16(b1, qr[0], z, 0, 0, 0); }
        else { p0 = __builtin_amdgcn_mfma_f32_32x32x16_bf16(b0, qr[d0], p0, 0, 0, 0); p1 = __builtin_amdgcn_mfma_f32_32x32x16_bf16(b1, qr[d0], p1, 0, 0, 0); } }
}
__device__ __forceinline__ void pv_tile(f32x16 (&o)[2], int vb, const f32x16& p0, const f32x16& p1) {
    u32x4 w0, w1, w2, w3;
    w0 = (u32x4){cvtpk_s(p0[0], p0[1]), cvtpk_s(p0[2], p0[3]), cvtpk_s(p0[4], p0[5]), cvtpk_s(p0[6], p0[7])};
    w1 = (u32x4){cvtpk_s(p0[8], p0[9]), cvtpk_s(p0[10], p0[11]), cvtpk_s(p0[12], p0[13]), cvtpk_s(p0[14], p0[15])};
    w2 = (u32x4){cvtpk_s(p1[0], p1[1]), cvtpk_s(p1[2], p1[3]), cvtpk_s(p1[4], p1[5]), cvtpk_s(p1[6], p1[7])};
    w3 = (u32x4){cvtpk_s(p1[8], p1[9]), cvtpk_s(p1[10], p1[11]), cvtpk_s(p1[12], p1[13]), cvtpk_s(p1[14], p1[15])};
    attn_body::pv(o, vb, __builtin_bit_cast(bf16x8, w0), __builtin_bit_cast(bf16x8, w1), __builtin_bit_cast(bf16x8, w2), __builtin_bit_cast(bf16x8, w3));
}
__device__ __forceinline__ float xhalf(float v) {
    auto rr = __builtin_amdgcn_permlane32_swap(__float_as_uint(v), __float_as_uint(v), false, false);
    return (threadIdx.x & 32) ? __uint_as_float(rr[0]) : __uint_as_float(rr[1]);
}
__device__ __forceinline__ float rowmax32(const f32x16& p0, const f32x16& p1) {
    float a = fmaxf(p0[0], p1[0]);
#pragma unroll
    for (int r = 1; r < 16; ++r) a = fmaxf(a, fmaxf(p0[r], p1[r]));
    return fmaxf(a, xhalf(a));
}
__device__ __forceinline__ void softmax_step(f32x16& p0, f32x16& p1, float& m, float& l, f32x16 (&o)[2], float* wsf, int r32, int hi) {
    const float mn = fmaxf(m, rowmax32(p0, p1));
    const float alpha = __builtin_amdgcn_exp2f(m - mn);
    m = mn; float sum = 0.f;
#pragma unroll
    for (int r = 0; r < 16; ++r) { const float e0 = (p0[r] > -1e29f) ? __builtin_amdgcn_exp2f(p0[r] - mn) : 0.f, e1 = (p1[r] > -1e29f) ? __builtin_amdgcn_exp2f(p1[r] - mn) : 0.f; p0[r] = e0; p1[r] = e1; sum += e0 + e1; }
    l = l * alpha + sum;
    if (!__all(alpha == 1.f)) {
        CFENCE(); if (hi == 0) wsf[r32] = alpha; CFENCE();
#pragma unroll
        for (int r = 0; r < 16; ++r) { const float f = wsf[crow(r, hi)]; o[0][r] *= f; o[1][r] *= f; }
        CFENCE();
    }
}
constexpr float R_INIT = -2000.f, THR_L2 = 8.f;
template <int CTRL> __device__ __forceinline__ float dppf(float x) { return __builtin_bit_cast(float, __builtin_amdgcn_mov_dpp(__builtin_bit_cast(int, x), CTRL, 0xf, 0xf, true)); }
__device__ __forceinline__ void qktc(f32x16& p0, f32x16& p1, const char* Kslot, const bf16x8 (&qr)[4], const f32x16& cinit, int r32, int hi) {
    const char* kb = Kslot + hi * 1024 + r32 * 16;
#pragma unroll
    for (int d0 = 0; d0 < 4; ++d0) {
        const bf16x8 b0 = *reinterpret_cast<const bf16x8*>(kb + d0 * 2048), b1 = *reinterpret_cast<const bf16x8*>(kb + d0 * 2048 + 512);
        if (d0 == 0) { p0 = __builtin_amdgcn_mfma_f32_32x32x16_bf16(b0, qr[0], cinit, 0, 0, 0); p1 = __builtin_amdgcn_mfma_f32_32x32x16_bf16(b1, qr[0], cinit, 0, 0, 0); }
        else { p0 = __builtin_amdgcn_mfma_f32_32x32x16_bf16(b0, qr[d0], p0, 0, 0, 0); p1 = __builtin_amdgcn_mfma_f32_32x32x16_bf16(b1, qr[d0], p1, 0, 0, 0); } }
}
template <bool HAS_O> __device__ __forceinline__ void sm_lean(f32x16& x0, f32x16& x1, float& ref, f32x16& negm, float& l, f32x16 (&o)[2], float* wsf, int r32, int hi) {
    const float rm = rowmax32(x0, x1);
    if (__any(rm > THR_L2)) {
        const float delta = fmaxf(rm, 0.f); ref += delta;
#pragma unroll
        for (int r = 0; r < 16; ++r) { x0[r] -= delta; x1[r] -= delta; negm[r] = -ref; }
        const float f = __builtin_amdgcn_exp2f(-delta); l *= f;
        if (HAS_O) {
            CFENCE(); if (hi == 0) wsf[r32] = f; CFENCE();
#pragma unroll
            for (int r = 0; r < 16; ++r) { const float g = wsf[crow(r, hi)]; o[0][r] *= g; o[1][r] *= g; }
            CFENCE();
        }
    }
    float s0 = 0.f, s1 = 0.f;
#pragma unroll
    for (int r = 0; r < 16; ++r) { x0[r] = __builtin_amdgcn_exp2f(x0[r]); x1[r] = __builtin_amdgcn_exp2f(x1[r]); s0 += x0[r]; s1 += x1[r]; }
    l += s0 + s1;
}
template <bool FIRST> __device__ __forceinline__ void acc_scaled(float* stage, const f32x16 (&o)[2], float w, float* wsf, int r32, int hi) {
    CFENCE(); if (hi == 0) wsf[r32] = w; CFENCE();
#pragma unroll
    for (int r = 0; r < 16; ++r) { const int row = crow(r, hi); const float f = wsf[row]; float* p = stage + row * 64 + r32;
        if (FIRST) { p[0] = o[0][r] * f; p[32] = o[1][r] * f; } else { p[0] += o[0][r] * f; p[32] += o[1][r] * f; } }
    CFENCE();
}
template <class RowOff> __device__ __forceinline__ void store_stage(const float* stage, hb* dst, RowOff rowoff, int lane) {
    asm volatile("" : "+v"(lane));
    CFENCE(); asm volatile("s_waitcnt lgkmcnt(0)" ::: "memory");
#pragma unroll
    for (int i = 0; i < 4; ++i) { const int row = i * 8 + (lane >> 3), ch = lane & 7;
        const float4 a = *(const float4*)(stage + row * 64 + ch * 8), bq = *(const float4*)(stage + row * 64 + ch * 8 + 4);
        const u32x4 v = (u32x4){cvtpk_s(a.x, a.y), cvtpk_s(a.z, a.w), cvtpk_s(bq.x, bq.y), cvtpk_s(bq.z, bq.w)};
        *(u32x4*)(dst + rowoff(row) + ch * 8) = v; }
    CFENCE(); asm volatile("s_waitcnt lgkmcnt(0)" ::: "memory");
}
template <class RowOff> __device__ __forceinline__ void store_o(const f32x16 (&o)[2], hb* stg, hb* dst, RowOff rowoff, int lane, int r32, int hi) {
    asm volatile("" : "+v"(lane));
#pragma unroll
    for (int r = 0; r < 16; ++r) { const int orow = crow(r, hi); stg[orow * 64 + r32] = __float2bfloat16(o[0][r]); stg[orow * 64 + 32 + r32] = __float2bfloat16(o[1][r]); }
    CFENCE(); asm volatile("s_waitcnt lgkmcnt(0)" ::: "memory");
#pragma unroll
    for (int i = 0; i < 4; ++i) { const int row = i * 8 + (lane >> 3), ch = lane & 7; const u32x4 v = *(const u32x4*)(stg + row * 64 + ch * 8); *(u32x4*)(dst + rowoff(row) + ch * 8) = v; }
    CFENCE(); asm volatile("s_waitcnt lgkmcnt(0)" ::: "memory");
}

__device__ __forceinline__ void sb_unit(const Ctx& C, int b, int h, int qb, char* shm) {
    const int tid = threadIdx.x, lane = tid & 63, r32 = lane & 31, hi = lane >> 5; const int wid = __builtin_amdgcn_readfirstlane(tid >> 6);
    const hb* PR = (const hb*)(C.ws + WS_PR) + (size_t)b * T * NPROJ; const int q0 = qb * 256, tw0 = q0 + 32 * wid, t = tw0 + r32;
    const unsigned lds0 = (unsigned)(uintptr_t)shm; float* wsf = (float*)(shm + H_WSF) + wid * 64; volatile int* flags = (volatile int*)(shm + H_FLAG);
    const int vbl = ((lane >> 4) & 1) * 32 + (lane & 3) * 8 + (4 * hi + ((lane & 15) >> 2)) * 64;
    bf16x8 qr[4];
#pragma unroll
    for (int d0 = 0; d0 < 4; ++d0) qr[d0] = *reinterpret_cast<const bf16x8*>(PR + (size_t)t * NPROJ + C_QS + h * 64 + d0 * 16 + hi * 8);
    f32x16 o[2]; o[0] = f32x16{}; o[1] = f32x16{};
    float carry = 0.f; bool done = false;
    if (lane == 0) { flags[wid] = 0; flags[8 + wid] = 0; }
    const int kt_hi = (q0 + 254) >> 6;
    const hb* Kb = PR + C_KSB + h * 64; const hb* Vb = PR + C_VSB + h * 64;
    dma_k(Kb + (size_t)kt_hi * 64 * NPROJ, NPROJ, lds0, lane, wid); dma_v(Vb + (size_t)kt_hi * 64 * NPROJ, NPROJ, lds0 + 8192, lane, wid);
    for (int i = 0; i <= kt_hi; ++i) {
        const int kt = kt_hi - i, sl = (i & 1) * SLOT_BYTES;
        HWAIT_BAR();
        if (i > 0) { int alld = 1;
#pragma unroll
          for (int w = 0; w < 8; ++w) alld &= flags[((i - 1) & 1) * 8 + w];
          if (alld) break; }
        if (kt > 0) { const int sn = ((i + 1) & 1) * SLOT_BYTES; dma_k(Kb + (size_t)(kt - 1) * 64 * NPROJ, NPROJ, lds0 + sn, lane, wid); dma_v(Vb + (size_t)(kt - 1) * 64 * NPROJ, NPROJ, lds0 + sn + 8192, lane, wid); }
        if (!done && 64 * kt < tw0 + 31) {
            f32x16 p0, p1; qkt0(p0, p1, shm + sl, qr, r32, hi);
            const bool diag = (64 * kt + 63 >= tw0);
            float own[8]; f32x16 ls0, ls1;
#pragma unroll
            for (int r = 0; r < 16; ++r) {
                { const float z = p0[r]; const float L = __builtin_amdgcn_logf(1.f + __builtin_amdgcn_exp2f(-fabsf(z))); float lk = -(fmaxf(z, 0.f) + L); ls0[r] = fminf(z, 0.f) - L;
                  if (diag && (64 * kt + crow(r, hi) >= t)) { lk = 0.f; ls0[r] = NEGF; } p0[r] = lk; }
                { const float z = p1[r]; const float L = __builtin_amdgcn_logf(1.f + __builtin_amdgcn_exp2f(-fabsf(z))); float lk = -(fmaxf(z, 0.f) + L); ls1[r] = fminf(z, 0.f) - L;
                  if (diag && (64 * kt + 32 + crow(r, hi) >= t)) { lk = 0.f; ls1[r] = NEGF; } p1[r] = lk; }
            }
#pragma unroll
            for (int s = 0; s < 4; ++s) { own[s] = (p0[4 * s] + p0[4 * s + 1]) + (p0[4 * s + 2] + p0[4 * s + 3]); own[4 + s] = (p1[4 * s] + p1[4 * s + 1]) + (p1[4 * s + 2] + p1[4 * s + 3]); }
            float suf[8]; float run = 0.f;
#pragma unroll
            for (int s = 7; s >= 0; --s) { const float oth = xhalf(own[s]); const float go = hi ? own[s] : oth, ge = hi ? oth : own[s];
                const float sodd = run; run += go; const float seven = run; run += ge; suf[s] = hi ? sodd : seven; }
#pragma unroll
            for (int s = 0; s < 4; ++s) {
                { const float base = carry + suf[s]; const float k3 = p0[4 * s + 3], k2 = p0[4 * s + 2], k1 = p0[4 * s + 1];
                  p0[4 * s + 3] = (ls0[4 * s + 3] > -1e29f) ? __builtin_amdgcn_exp2f(ls0[4 * s + 3] + base) : 0.f;
                  p0[4 * s + 2] = (ls0[4 * s + 2] > -1e29f) ? __builtin_amdgcn_exp2f(ls0[4 * s + 2] + base + k3) : 0.f;
                  p0[4 * s + 1] = (ls0[4 * s + 1] > -1e29f) ? __builtin_amdgcn_exp2f(ls0[4 * s + 1] + base + (k3 + k2)) : 0.f;
                  p0[4 * s] = (ls0[4 * s] > -1e29f) ? __builtin_amdgcn_exp2f(ls0[4 * s] + base + ((k3 + k2) + k1)) : 0.f; }
                { const float base = carry + suf[4 + s]; const float k3 = p1[4 * s + 3], k2 = p1[4 * s + 2], k1 = p1[4 * s + 1];
                  p1[4 * s + 3] = (ls1[4 * s + 3] > -1e29f) ? __builtin_amdgcn_exp2f(ls1[4 * s + 3] + base) : 0.f;
                  p1[4 * s + 2] = (ls1[4 * s + 2] > -1e29f) ? __builtin_amdgcn_exp2f(ls1[4 * s + 2] + base + k3) : 0.f;
                  p1[4 * s + 1] = (ls1[4 * s + 1] > -1e29f) ? __builtin_amdgcn_exp2f(ls1[4 * s + 1] + base + (k3 + k2)) : 0.f;
                  p1[4 * s] = (ls1[4 * s] > -1e29f) ? __builtin_amdgcn_exp2f(ls1[4 * s] + base + ((k3 + k2) + k1)) : 0.f; }
            }
            carry += run;
            pv_tile(o, (int)(lds0 + sl + 8192) + vbl, p0, p1);
            if (__all(carry < -60.f)) done = true;
        }
        if (kt == 0) done = true;
        if (lane == 0) flags[(i & 1) * 8 + wid] = done ? 1 : 0;
    }
    HWAIT_BAR();
    hb* stg = (hb*)(shm + H_OST + wid * 8192); hb* dst = (hb*)(C.ws + WS_OCAT) + ((size_t)b * T + tw0) * D + 512 + h * 64;
    store_o(o, stg, dst, [](int row) { return (size_t)row * D; }, lane, r32, hi);
    HWAIT_BAR();
}

__device__ __forceinline__ void nsa_unit(const Ctx& C, int b, int g, int qblk, char* shm) {
    const int tid = threadIdx.x, lane = tid & 63, r32 = lane & 31, hi = lane >> 5; const int wid = __builtin_amdgcn_readfirstlane(tid >> 6);
    const hb* PR = (const hb*)(C.ws + WS_PR) + (size_t)b * T * NPROJ; const int q0 = qblk * 64, cur = qblk, tq0 = q0 + 8 * wid, t = tq0 + (r32 >> 2), dt = t - q0;
    const unsigned lds0 = (unsigned)(uintptr_t)shm; float* wsf = (float*)(shm + H_WSF) + wid * 64; float* imp = (float*)(shm + H_IMP) + wid * 8 * IMP_LD;
    unsigned* selm = (unsigned*)(shm + H_SELM); unsigned* wun = (unsigned*)(shm + H_WUN);
    const int vbl = ((lane >> 4) & 1) * 32 + (lane & 3) * 8 + (4 * hi + ((lane & 15) >> 2)) * 64;
    const float NINF = -INFINITY;
    bf16x8 qr[4];
    { const hb* qp = PR + (size_t)t * NPROJ + C_QN + (g * 4 + (r32 & 3)) * 64;
#pragma unroll
      for (int d0 = 0; d0 < 4; ++d0) qr[d0] = *reinterpret_cast<const bf16x8*>(qp + d0 * 16 + hi * 8); }
#define GATE(j) (1.f / (1.f + __expf(-__bfloat162float(PR[(size_t)t * NPROJ + C_GL + (g * 4 + (r32 & 3)) * 3 + (j)]))))
    for (int i = lane; i < 8 * IMP_LD; i += 64) imp[i] = 0.f;
    float* stage = (float*)(shm + H_OST + wid * 8192);
    f32x16 o[2]; f32x16 negm;
    {
        const hb* KC = (const hb*)(C.ws + WS_KCMP) + (size_t)((b * 2 + g) * 512) * 64; const hb* VC = (const hb*)(C.ws + WS_VCMP) + (size_t)((b * 2 + g) * 512) * 64;
        const int ntile = (((q0 + 32) >> 4) >> 6) + 1;
        const int cmax = (t >= 31) ? ((t - 31) >> 4) : -1;
        const int cmax_w = (tq0 + 7 >= 31) ? ((tq0 + 7 - 31) >> 4) : -1;
        float ref = R_INIT, l = 0.f;
#pragma unroll
        for (int r = 0; r < 16; ++r) negm[r] = -R_INIT;
        dma_k(KC, 64, lds0, lane, wid);
        for (int i = 0; i < ntile; ++i) {
            const int sl = (i & 1) * SLOT_BYTES;
            HWAIT_BAR();
            if (i + 1 < ntile) dma_k(KC + (size_t)(i + 1) * 64 * 64, 64, lds0 + ((i + 1) & 1) * SLOT_BYTES, lane, wid);
            if (64 * i <= cmax_w) {
                f32x16 p0, p1; qktc(p0, p1, shm + sl, qr, negm, r32, hi);
                if (64 * i + 63 >= cmax_w) {
#pragma unroll
                    for (int r = 0; r < 16; ++r) { const int c = 64 * i + crow(r, hi); if (c > cmax) p0[r] = NINF; if (c + 32 > cmax) p1[r] = NINF; }
                }
                sm_lean<false>(p0, p1, ref, negm, l, o, wsf, r32, hi);
            }
        }
        l += xhalf(l);
        const float inv = (l > 0.f) ? 1.f / l : 0.f;
        o[0] = f32x16{}; o[1] = f32x16{};
        HWAIT_BAR();
        dma_k(KC, 64, lds0, lane, wid); dma_v(VC, 64, lds0 + 8192, lane, wid);
        for (int i = 0; i < ntile; ++i) {
            const int sl = (i & 1) * SLOT_BYTES;
            HWAIT_BAR();
            if (i + 1 < ntile) { const int sn = ((i + 1) & 1) * SLOT_BYTES; dma_k(KC + (size_t)(i + 1) * 64 * 64, 64, lds0 + sn, lane, wid); dma_v(VC + (size_t)(i + 1) * 64 * 64, 64, lds0 + sn + 8192, lane, wid); }
            if (64 * i <= cmax_w) {
                f32x16 p0, p1; qktc(p0, p1, shm + sl, qr, negm, r32, hi);
                if (64 * i + 63 >= cmax_w) {
#pragma unroll
                    for (int r = 0; r < 16; ++r) { const int c = 64 * i + crow(r, hi); if (c > cmax) p0[r] = NINF; if (c + 32 > cmax) p1[r] = NINF; }
                }
#pragma unroll
                for (int r = 0; r < 16; ++r) { p0[r] = __builtin_amdgcn_exp2f(p0[r]) * inv; p1[r] = __builtin_amdgcn_exp2f(p1[r]) * inv; }
                float* impq = imp + (r32 >> 2) * IMP_LD;
#pragma unroll
                for (int s = 0; s < 4; ++s) {
                    float g0 = (p0[4 * s] + p0[4 * s + 1]) + (p0[4 * s + 2] + p0[4 * s + 3]), e0 = p0[4 * s + 3], g1 = (p1[4 * s] + p1[4 * s + 1]) + (p1[4 * s + 2] + p1[4 * s + 3]), e1 = p1[4 * s + 3];
                    g0 += dppf<0xB1>(g0); g0 += dppf<0x4E>(g0); e0 += dppf<0xB1>(e0); e0 += dppf<0x4E>(e0); g1 += dppf<0xB1>(g1); g1 += dppf<0x4E>(g1); e1 += dppf<0xB1>(e1); e1 += dppf<0x4E>(e1);
                    if ((r32 & 3) == 0) { const int nb = 16 * i + 2 * s + hi; atomicAdd(impq + nb, g0); atomicAdd(impq + nb + 1, e0); atomicAdd(impq + nb + 8, g1); atomicAdd(impq + nb + 9, e1); }
                }
                pv_tile(o, (int)(lds0 + sl + 8192) + vbl, p0, p1);
            }
        }
        acc_scaled<true>(stage, o, GATE(0), wsf, r32, hi);
    }
    {
        CFENCE(); asm volatile("s_waitcnt lgkmcnt(0)" ::: "memory");
        const int qi = lane >> 3, j = lane & 7; const float* impq = imp + qi * IMP_LD + 16 * j;
        float v[16];
#pragma unroll
        for (int i = 0; i < 16; ++i) { const int nb = 16 * j + i; const bool forced = (nb == 0) || (nb == cur) || (nb == cur - 1); v[i] = forced ? 1e9f : ((nb <= cur) ? impq[i] : -1e9f); }
        unsigned mask16 = 0u;
#pragma unroll 1
        for (int it = 0; it < 16; ++it) {
            float bv = v[0]; int bi = 0;
#pragma unroll
            for (int i = 1; i < 16; ++i) if (v[i] > bv) { bv = v[i]; bi = i; }
            int gi = 16 * j + bi;
#pragma unroll
            for (int off = 1; off < 8; off <<= 1) { const float ov = __shfl_xor(bv, off); const int oi = __shfl_xor(gi, off); if (ov > bv || (ov == bv && oi < gi)) { bv = ov; gi = oi; } }
            if ((gi >> 4) == j) { const int w = gi & 15; mask16 |= 1u << w;
#pragma unroll
                for (int i = 0; i < 16; ++i) if (i == w) v[i] = -3e38f; }
        }
        { const int lim = cur - 16 * j; const unsigned keep = (lim >= 15) ? 0xFFFFu : ((lim < 0) ? 0u : ((1u << (lim + 1)) - 1u)); mask16 &= keep; }
        const unsigned other = __shfl_xor(mask16, 1);
        if ((j & 1) == 0) selm[(8 * wid + qi) * 4 + (j >> 1)] = mask16 | (other << 16);
        CFENCE(); asm volatile("s_waitcnt lgkmcnt(0)" ::: "memory");
    }
    unsigned wu[4];
    {
#pragma unroll
        for (int k = 0; k < 4; ++k) { unsigned u = selm[(8 * wid + (r32 >> 2)) * 4 + k];
#pragma unroll
            for (int off = 1; off < 64; off <<= 1) u |= __shfl_xor(u, off);
            wu[k] = __builtin_amdgcn_readfirstlane(u); }
        if (lane < 4) wun[wid * 4 + lane] = (lane == 0) ? wu[0] : (lane == 1) ? wu[1] : (lane == 2) ? wu[2] : wu[3];
    }
    HWAIT_BAR();
    unsigned bu[4];
#pragma unroll
    for (int k = 0; k < 4; ++k) { unsigned u = 0u;
#pragma unroll
        for (int w = 0; w < 8; ++w) u |= wun[w * 4 + k];
        bu[k] = __builtin_amdgcn_readfirstlane(u); }
    {
        float ref = R_INIT, l = 0.f; o[0] = f32x16{}; o[1] = f32x16{};
#pragma unroll
        for (int r = 0; r < 16; ++r) negm[r] = -R_INIT;
        const hb* Kb = PR + C_KS + g * 64; const hb* Vb = PR + C_VS + g * 64;
        int k_it = 0; unsigned wcur = bu[0];
#define NEXT_BLK(dst_) do { while (wcur == 0u && k_it < 3) { ++k_it; wcur = (k_it == 1) ? bu[1] : (k_it == 2) ? bu[2] : bu[3]; } \
        if (wcur == 0u) { dst_ = -1; } else { const int bit_ = __builtin_ctz(wcur); wcur &= wcur - 1u; dst_ = 32 * k_it + bit_; } } while (0)
        int nb; NEXT_BLK(nb);
        if (nb >= 0) { dma_k(Kb + (size_t)nb * 64 * NPROJ, NPROJ, lds0, lane, wid); dma_v(Vb + (size_t)nb * 64 * NPROJ, NPROJ, lds0 + 8192, lane, wid); }
        for (int i = 0; nb >= 0; ++i) {
            const int sl = (i & 1) * SLOT_BYTES; int nn; NEXT_BLK(nn);
            HWAIT_BAR();
            if (nn >= 0) { const int sn = ((i + 1) & 1) * SLOT_BYTES; dma_k(Kb + (size_t)nn * 64 * NPROJ, NPROJ, lds0 + sn, lane, wid); dma_v(Vb + (size_t)nn * 64 * NPROJ, NPROJ, lds0 + sn + 8192, lane, wid); }
            const unsigned wword = (nb < 32) ? wu[0] : (nb < 64) ? wu[1] : (nb < 96) ? wu[2] : wu[3];
            if ((wword >> (nb & 31)) & 1u) {
                const unsigned sword = selm[(8 * wid + (r32 >> 2)) * 4 + (nb >> 5)];
                const bool rowsel = ((sword >> (nb & 31)) & 1u) != 0u;
                f32x16 ci;
#pragma unroll
                for (int r = 0; r < 16; ++r) ci[r] = rowsel ? negm[r] : NINF;
                f32x16 p0, p1; qktc(p0, p1, shm + sl, qr, ci, r32, hi);
                if (nb == cur) {
#pragma unroll
                    for (int r = 0; r < 16; ++r) { const int k = crow(r, hi); if (k > dt) p0[r] = NINF; if (k + 32 > dt) p1[r] = NINF; }
                }
                sm_lean<true>(p0, p1, ref, negm, l, o, wsf, r32, hi);
                pv_tile(o, (int)(lds0 + sl + 8192) + vbl, p0, p1);
            }
            nb = nn;
        }
#undef NEXT_BLK
        l += xhalf(l);
        acc_scaled<false>(stage, o, (l > 0.f) ? GATE(1) / l : 0.f, wsf, r32, hi);
        HWAIT_BAR();
    }
    {
        float ref = R_INIT, l = 0.f; o[0] = f32x16{}; o[1] = f32x16{};
#pragma unroll
        for (int r = 0; r < 16; ++r) negm[r] = -R_INIT;
        const hb* Kb = PR + C_KW + g * 64; const hb* Vb = PR + C_VW + g * 64;
        const int kt0 = (cur >= 8) ? cur - 8 : 0, nt = cur - kt0 + 1;
        dma_k(Kb + (size_t)kt0 * 64 * NPROJ, NPROJ, lds0, lane, wid); dma_v(Vb + (size_t)kt0 * 64 * NPROJ, NPROJ, lds0 + 8192, lane, wid);
        for (int i = 0; i < nt; ++i) {
            const int kt = kt0 + i, sl = (i & 1) * SLOT_BYTES;
            HWAIT_BAR();
            if (i + 1 < nt) { const int sn = ((i + 1) & 1) * SLOT_BYTES; dma_k(Kb + (size_t)(kt + 1) * 64 * NPROJ, NPROJ, lds0 + sn, lane, wid); dma_v(Vb + (size_t)(kt + 1) * 64 * NPROJ, NPROJ, lds0 + sn + 8192, lane, wid); }
            f32x16 p0, p1; qktc(p0, p1, shm + sl, qr, negm, r32, hi);
            if (kt == cur) {
#pragma unroll
                for (int r = 0; r < 16; ++r) { const int k = crow(r, hi); if (k > dt) p0[r] = NINF; if (k + 32 > dt) p1[r] = NINF; }
            } else if (kt == cur - 8) {
#pragma unroll
                for (int r = 0; r < 16; ++r) { const int k = crow(r, hi); if (k <= dt) p0[r] = NINF; if (k + 32 <= dt) p1[r] = NINF; }
            }
            sm_lean<true>(p0, p1, ref, negm, l, o, wsf, r32, hi);
            pv_tile(o, (int)(lds0 + sl + 8192) + vbl, p0, p1);
        }
        l += xhalf(l);
        acc_scaled<false>(stage, o, (l > 0.f) ? GATE(2) / l : 0.f, wsf, r32, hi);
#undef GATE
    }
    { hb* dst = (hb*)(C.ws + WS_OCAT) + ((size_t)b * T + tq0) * D + g * 256;
      store_stage(stage, dst, [](int row) { return (size_t)(row >> 2) * D + (row & 3) * 64; }, lane); }
    HWAIT_BAR();
}
__device__ __forceinline__ void hybrid_phase(const Ctx& C, char* shm) {
#pragma unroll 1
    for (int L = C.vcu; L < 512; L += C.G) { const int p = L >> 1, combo = p >> 6, s = p & 63; nsa_unit(C, combo >> 1, combo & 1, (L & 1) ? 127 - s : s, shm); }
#pragma unroll 1
    for (int L = C.vcu; L < 512; L += C.G) { const int p = L >> 1, combo = p >> 4, s = p & 15; sb_unit(C, combo >> 3, combo & 7, (L & 1) ? 31 - s : s, shm); }
}
#undef HWAIT_BAR
}
#ifndef HYB_MFMA
#define HYB_MFMA 1
#endif
#ifndef RPT_MASK
#define RPT_MASK 0u
#endif
#ifndef PH_MASK
#define PH_MASK 0xFFFFFFu
#endif
struct Args { const void* in[28]; float* out; unsigned char* ws; int ph_lo, ph_hi; };
enum Phase { P_PROLOG = 0, P_NORM0A, P_INPROJ, P_CMP, P_ATT0, P_OUT0, P_NORM0B, P_GATE0, P_UP0, P_DOWN0, P_NORM1A, P_QKV1, P_ATT1, P_COMB1, P_OUT1, P_NORM1B, P_GATE1, P_UP1, P_DOWN1, P_FINAL, N_PHASES };

__global__ void __launch_bounds__(NTHREADS, 2) mega_fwd(Args args) {
    extern __shared__ __attribute__((aligned(16))) unsigned char lds[];
    Ctx C;
    C.lds = (LAS unsigned char*)lds; C.tid = threadIdx.x; C.lane = C.tid & 63; C.wave = __builtin_amdgcn_readfirstlane(C.tid >> 6);
    C.G = gridDim.x; { const int bx = blockIdx.x; C.vcu = (C.G % 8 == 0) ? (bx % 8) * (C.G / 8) + bx / 8 : bx; }
    unsigned char* ws0 = args.ws;
    volatile LAS unsigned* MISC = (volatile LAS unsigned*)(C.lds + MISC_OFF);
    for (int u = C.tid; u < 64; u += NTHREADS) MISC[u] = 0u;
    __syncthreads();
    const int lo = args.ph_lo, hi = args.ph_hi;
    const bool one_launch = (hi - lo) > 1;
    XcdBarrier bar; bar.bar = (unsigned*)(ws0 + WS_CTL) + CW_BAR; bar.x = 0; bar.st = nullptr;
    if (one_launch) bar = xcd_barrier_post((unsigned*)(ws0 + WS_CTL) + CW_BAR, MISC + 8);
#define IN(k) (((PH_MASK >> (k)) & 1u) && lo <= (k) && (k) < hi)
#define RPT(k) for (int rpt_ = 0; rpt_ < (((RPT_MASK >> (k)) & 1u) ? 2 : 1); ++rpt_) if (rpt_ == 0 || (__syncthreads(), true))
#define SEAM(k) do { if (IN(k) && IN((k) + 1)) xcd_barrier(bar); } while (0)
#define PHV() fill_inputs(C); unsigned char* ws = C.ws; const float* MODV = (const float*)(ws + WS_MODV); const float* CS = (const float*)(ws + WS_CS); bf16* XN = (bf16*)(ws + WS_XN); const float* MODV1 = MODV + 2 * 6144; (void)CS; (void)XN; (void)MODV1; (void)MODV;

    if (IN(P_PROLOG)) RPT(P_PROLOG) { PHV(); p0_prologue(C); } SEAM(P_PROLOG);
    if (IN(P_NORM0A)) RPT(P_NORM0A) { PHV(); norm_mod_rows(C, C.x, C.norm_mix, MODV + 0, MODV + 1024, XN); } SEAM(P_NORM0A);
    if (IN(P_INPROJ)) RPT(P_INPROJ) { PHV();
        pg8::Gemm g{XN, (const bf16*)(ws + WS_WIN0), M, NPROJ, D}; pg8::StaticOrder S; S.init(M, NPROJ, C.G, (int)blockIdx.x);
        pg8::EpiProj E{(bf16*)(ws + WS_PR), NPROJ, CS, 0xFu | (1u << 6) | (1u << 8), 0xFu | (0xFu << 10), QSCALE};
        pg8::gemm_phase<pg8::EpiProj, pg8::StaticOrder, true, true>(C.lds, g, S, E);
    } SEAM(P_INPROJ);
    if (IN(P_CMP)) RPT(P_CMP) { PHV(); for (int u = blockIdx.x; u < 128; u += C.G) compress_unit(C, u); } SEAM(P_CMP);
    #if HYB_MFMA
    if (IN(P_ATT0)) RPT(P_ATT0) { PHV(); hyb::hybrid_phase(C, (char*)lds); } SEAM(P_ATT0);
#else
    if (IN(P_ATT0)) RPT(P_ATT0) { PHV(); hybrid_attention_phase(C); } SEAM(P_ATT0);
#endif
    if (IN(P_OUT0)) RPT(P_OUT0) { PHV();
        pg8::Gemm g{(const bf16*)(ws + WS_OCAT), (const bf16*)(ws + WS_WOUT0), M, D, D}; pg8::StaticOrder S; S.init(M, D, C.G, (int)blockIdx.x);
        pg8::EpiRes E{C.x, C.out, D, MODV + 2048, 6144};
        pg8::gemm_phase<pg8::EpiRes, pg8::StaticOrder, true, true>(C.lds, g, S, E);
    } SEAM(P_OUT0);
    if (IN(P_NORM0B)) RPT(P_NORM0B) { PHV(); norm_mod_rows(C, C.out, C.norm_ffn, MODV + 3072, MODV + 4096, XN); } SEAM(P_NORM0B);
    if (IN(P_GATE0)) RPT(P_GATE0) { PHV();
        pg8::Gemm g{XN, (const bf16*)(ws + WS_WG0), M, DFF, D}; pg8::StaticOrder S; S.init(M, DFF, C.G, (int)blockIdx.x);
        pg8::EpiProj E{(bf16*)(ws + WS_G), DFF, CS, 0u, 0u, 1.f};
        pg8::gemm_phase<pg8::EpiProj, pg8::StaticOrder, true, true>(C.lds, g, S, E);
    } SEAM(P_GATE0);
    if (IN(P_UP0)) RPT(P_UP0) { PHV();
        pg8::Gemm g{XN, (const bf16*)(ws + WS_WU0), M, DFF, D}; pg8::StaticOrder S; S.init(M, DFF, C.G, (int)blockIdx.x);
        pg8::EpiAct E{(bf16*)(ws + WS_ACT), (const bf16*)(ws + WS_G), DFF, C.conv_w, C.conv_b};
        pg8::gemm_phase<pg8::EpiAct, pg8::StaticOrder, true, true>(C.lds, g, S, E);
    } SEAM(P_UP0);
    if (IN(P_DOWN0)) { PHV();
        pg8::Gemm g{(const bf16*)(ws + WS_ACT), (const bf16*)(ws + WS_WD0), M, D, DFF}; pg8::StaticOrder S; S.init(M, D, C.G, (int)blockIdx.x);
        pg8::EpiRes E{C.out, C.out, D, MODV + 5120, 6144};
        pg8::gemm_phase<pg8::EpiRes, pg8::StaticOrder, true, true>(C.lds, g, S, E);
    } SEAM(P_DOWN0);
    if (IN(P_NORM1A)) RPT(P_NORM1A) { PHV(); norm_mod_rows(C, C.out, C.norm_mix + D, MODV1 + 0, MODV1 + 1024, XN); } SEAM(P_NORM1A);
    if (IN(P_QKV1)) RPT(P_QKV1) { PHV();
        pg8::Gemm g{XN, (const bf16*)(ws + WS_WQKV1), M, NPROJ, D}; pg8::StaticOrder S; S.init(M, NPROJ, C.G, (int)blockIdx.x);
        pg8::EpiProj E{(bf16*)(ws + WS_PR1), NPROJ, CS, 0xFFFFu, 0xFFu, QSCALE};
        pg8::gemm_phase<pg8::EpiProj, pg8::StaticOrder, true, true>(C.lds, g, S, E);
    } SEAM(P_QKV1);
    if (IN(P_ATT1)) RPT(P_ATT1) { PHV(); const attn_body::StaticOrder S(C.vcu); attn_body::diff_attn_phase<NPROJ, D>((char*)lds, (const attn_body::bf16*)(ws + WS_PR1), (attn_body::bf16*)(ws + WS_O1), (attn_body::bf16*)(ws + WS_O2), S); } SEAM(P_ATT1);
    if (IN(P_COMB1)) RPT(P_COMB1) { PHV(); diff_combine_rows(C, (const bf16*)(ws + WS_O1), (const bf16*)(ws + WS_O2), XN); } SEAM(P_COMB1);
    if (IN(P_OUT1)) { PHV();
        pg8::Gemm g{XN, (const bf16*)(ws + WS_WOUT1), M, D, D}; pg8::StaticOrder S; S.init(M, D, C.G, (int)blockIdx.x);
        pg8::EpiRes E{C.out, C.out, D, MODV1 + 2048, 6144};
        pg8::gemm_phase<pg8::EpiRes, pg8::StaticOrder, true, true>(C.lds, g, S, E);
    } SEAM(P_OUT1);
    if (IN(P_NORM1B)) RPT(P_NORM1B) { PHV(); norm_mod_rows(C, C.out, C.norm_ffn + D, MODV1 + 3072, MODV1 + 4096, XN); } SEAM(P_NORM1B);
    if (IN(P_GATE1)) RPT(P_GATE1) { PHV();
        pg8::Gemm g{XN, (const bf16*)(ws + WS_WG1), M, DFF, D}; pg8::StaticOrder S; S.init(M, DFF, C.G, (int)blockIdx.x);
        pg8::EpiProj E{(bf16*)(ws + WS_G), DFF, CS, 0u, 0u, 1.f};
        pg8::gemm_phase<pg8::EpiProj, pg8::StaticOrder, true, true>(C.lds, g, S, E);
    } SEAM(P_GATE1);
    if (IN(P_UP1)) RPT(P_UP1) { PHV();
        pg8::Gemm g{XN, (const bf16*)(ws + WS_WU1), M, DFF, D}; pg8::StaticOrder S; S.init(M, DFF, C.G, (int)blockIdx.x);
        pg8::EpiAct E{(bf16*)(ws + WS_ACT), (const bf16*)(ws + WS_G), DFF, C.conv_w + 3 * DFF, C.conv_b + DFF};
        pg8::gemm_phase<pg8::EpiAct, pg8::StaticOrder, true, true>(C.lds, g, S, E);
    } SEAM(P_UP1);
    if (IN(P_DOWN1)) { PHV();
        pg8::Gemm g{(const bf16*)(ws + WS_ACT), (const bf16*)(ws + WS_WD1), M, D, DFF}; pg8::StaticOrder S; S.init(M, D, C.G, (int)blockIdx.x);
        pg8::EpiRes E{C.out, C.out, D, MODV1 + 5120, 6144};
        pg8::gemm_phase<pg8::EpiRes, pg8::StaticOrder, true, true>(C.lds, g, S, E);
    } SEAM(P_DOWN1);
    if (IN(P_FINAL)) { PHV(); final_norm_rows(C, C.out, C.norm_f); }
#undef IN
#undef SEAM
}

#ifndef MK_PER_PHASE
#define MK_PER_PHASE 0
#endif
extern "C" void kernel_launch(void* const* d_in, const int* in_sizes, int n_in, void* d_out, int out_size, void* d_ws, size_t ws_size, hipStream_t stream) {
    static int grid = 0;
    if (grid == 0) {
        if (n_in != 28 || in_sizes[0] != M * D || out_size != M * D || ws_size < WS_END) { fprintf(stderr, "kernel_launch: unexpected problem (n_in %d, in0 %d, out %d, ws %zu; need ws >= %zu); nothing launched\n", n_in, n_in > 0 ? in_sizes[0] : -1, out_size, ws_size, (size_t)WS_END); grid = -1; return; }
        int dev = 0, cus = 0, per_cu = 0;
        if (hipGetDevice(&dev) != hipSuccess || hipDeviceGetAttribute(&cus, hipDeviceAttributeMultiprocessorCount, dev) != hipSuccess) { fprintf(stderr, "kernel_launch: device query failed\n"); grid = -1; return; }
        if (hipFuncSetAttribute((const void*)mega_fwd, hipFuncAttributeMaxDynamicSharedMemorySize, LDS_BYTES) != hipSuccess) { fprintf(stderr, "kernel_launch: hipFuncSetAttribute failed\n"); grid = -1; return; }
        if (hipOccupancyMaxActiveBlocksPerMultiprocessor(&per_cu, (const void*)mega_fwd, NTHREADS, LDS_BYTES) != hipSuccess || per_cu < 1) { fprintf(stderr, "kernel_launch: occupancy query reports %d workgroups per CU\n", per_cu); per_cu = 1; }
        (void)hipGetLastError();
        grid = cus;
        if (grid % 8 != 0 || grid > 256) { grid = (grid > 256) ? 256 : (grid / 8) * 8; }
        fprintf(stderr, "kernel_launch: grid %d (cus %d, occupancy %d/CU)\n", grid, cus, per_cu);
    }
    if (grid <= 0) return;
    (void)hipMemsetAsync((char*)d_ws + WS_CTL, 0, CTL_ZERO_BYTES, stream);
    Args a{};
    for (int i = 0; i < 28; ++i) a.in[i] = d_in[i];
    a.out = (float*)d_out; a.ws = (unsigned char*)d_ws;
#if MK_PER_PHASE
    for (int p = 0; p < N_PHASES; ++p) { a.ph_lo = p; a.ph_hi = p + 1; hipLaunchKernelGGL(mega_fwd, dim3(grid), dim3(NTHREADS), LDS_BYTES, stream, a); }
#else
    a.ph_lo = 0; a.ph_hi = N_PHASES; hipLaunchKernelGGL(mega_fwd, dim3(grid), dim3(NTHREADS), LDS_BYTES, stream, a);
#endif
    const hipError_t le = hipPeekAtLastError();
    if (le != hipSuccess) fprintf(stderr, "kernel_launch: launch failed: %s\n", hipGetErrorName(le));
}
```
